# Optimizing an MI355X kernel written in HIP

```python
import math
import jax, jax.numpy as jnp
from jax import lax
import numpy as np

D_MODEL = 1024
BATCH = 8
SEQ = 2048
DEPTH = 1
DEC_BATCH = 128
DEC_SEQ = 4
PAST_LEN = 16384
PAGE_SIZE = 128

W_A = D_MODEL // 2
H_A = 8
BW_A = W_A // H_A
CONV_A = 4
C_RG = 8.0
W_B = D_MODEL - W_A
H_B = 4
HD_B = W_B // H_B
CHUNK = 128
MIX_W = W_A + W_B
D_FF = 3 * D_MODEL
CONV_F = 3
PLE_DIM = 256
EPS = 1e-6

kernel_name = "hymba_style_rglru_sgu_convffn_step"


def _rmsnorm(x, g):
    x32 = x.astype(jnp.float32)
    y = x32 * lax.rsqrt(jnp.mean(x32 * x32, axis=-1, keepdims=True) + EPS)
    return y.astype(x.dtype) * g


def _layernorm(x, g, b):
    x32 = x.astype(jnp.float32)
    mu = jnp.mean(x32, axis=-1, keepdims=True)
    xc = x32 - mu
    y = xc * lax.rsqrt(jnp.mean(xc * xc, axis=-1, keepdims=True) + EPS)
    return y.astype(x.dtype) * g + b


def _causal_dwconv(x, buf, w, b):
    k = w.shape[0]
    L = x.shape[1]
    xp = jnp.concatenate([buf.astype(x.dtype), x], axis=1)
    out = b
    for j in range(k):
        out = out + xp[:, j:j + L] * w[j]
    return out, xp[:, xp.shape[1] - (k - 1):]


def _rglru(x, h0, wa, ba, wx, bx, a_param, reset_first):
    B, L, W = x.shape
    xb = x.reshape(B, L, H_A, BW_A)
    r = jax.nn.sigmoid(jnp.einsum('blhi,hij->blhj', xb, wa).reshape(B, L, W) + ba)
    i = jax.nn.sigmoid(jnp.einsum('blhi,hij->blhj', xb, wx).reshape(B, L, W) + bx)
    log_a = (-C_RG * r.astype(jnp.float32)) * jax.nn.softplus(-a_param.astype(jnp.float32))
    a = jnp.exp(log_a)
    mult = jnp.sqrt(-jnp.expm1(2.0 * log_a))
    if reset_first:
        mult = mult.at[:, 0].set(1.0)
    u = x.astype(jnp.float32) * i.astype(jnp.float32) * mult

    def step(h, inp):
        a_t, u_t = inp
        h = a_t * h + u_t
        return h, h

    hT, hs = lax.scan(step, h0.astype(jnp.float32), (jnp.swapaxes(a, 0, 1), jnp.swapaxes(u, 0, 1)))
    return jnp.swapaxes(hs, 0, 1).astype(x.dtype), hT


def _chunk_sgu(u, v, w_s, b_s):
    B, L, _ = v.shape
    cl = min(L, CHUNK)
    nc = L // cl
    mask = jnp.tril(jnp.ones((cl, cl), dtype=bool))
    w = jnp.where(mask, w_s[:, :cl, :cl], 0.0)
    vc = v.reshape(B, nc, cl, H_B, HD_B)
    mixed = jnp.einsum('hts,bcshd->bcthd', w, vc) + jnp.transpose(b_s[:, :cl])[None, None, :, :, None]
    return u * mixed.reshape(B, L, W_B)


def _layer(h, p, h0, conv_buf, ffn_buf, reset_first, lw):
    n1 = _rmsnorm(h, lw['g_mix_norm'])
    z = n1 @ lw['w_in']
    xa = z[..., :W_A]
    ga = z[..., W_A:2 * W_A]
    ub = z[..., 2 * W_A:2 * W_A + W_B]
    vb = z[..., 2 * W_A + W_B:]
    xa_c, conv_new = _causal_dwconv(xa, conv_buf, lw['conv_a_w'], lw['conv_a_b'])
    ya, hT = _rglru(xa_c, h0, lw['lru_wa'], lw['lru_ba'], lw['lru_wx'], lw['lru_bx'],
                    lw['lru_a_param'], reset_first)
    ya = _rmsnorm(ya * jax.nn.gelu(ga), lw['g_out_a'])
    vn = _layernorm(jax.nn.gelu(vb), lw['ln_v_g'], lw['ln_v_b'])
    yb = _rmsnorm(_chunk_sgu(jax.nn.gelu(ub), vn, lw['sgu_w'], lw['sgu_b']), lw['g_out_b'])
    h = h + jnp.concatenate([ya, yb], axis=-1) @ lw['w_out']
    n2 = _rmsnorm(h, lw['g_ffn_norm'])
    up = n2 @ lw['w_up']
    up_c, ffn_new = _causal_dwconv(up, ffn_buf, lw['ffn_conv_w'], lw['ffn_conv_b'])
    h = h + (jax.nn.gelu(up_c[..., :D_FF]) * up_c[..., D_FF:]) @ lw['w_down']
    gate = jax.nn.sigmoid(_rmsnorm(h, lw['g_ple_norm']) @ lw['w_ple_gate'])
    h = h + (p @ lw['w_ple']) * gate
    return h, hT, conv_new, vn, ffn_new


def setup_inputs(seed: int = 0) -> dict:
    key = jax.random.key(seed)
    ks = jax.random.split(key, 40)
    f32 = jnp.float32
    nrm = lambda k, s, sc: jax.random.normal(k, s, f32) * sc
    gain = lambda k, s: 1.0 + 0.02 * jax.random.normal(k, s, f32)
    u = jax.random.uniform(ks[12], (DEPTH, W_A), f32, minval=0.9, maxval=0.999)
    return {
        "x_prompt": nrm(ks[0], (BATCH, SEQ, D_MODEL), 1.0),
        "x_sample": nrm(ks[1], (DEC_BATCH, DEC_SEQ, D_MODEL), 1.0),
        "p_prompt": nrm(ks[2], (DEPTH, BATCH, SEQ, PLE_DIM), 1.0),
        "p_sample": nrm(ks[3], (DEPTH, DEC_BATCH, DEC_SEQ, PLE_DIM), 1.0),
        "state_rglru_h": nrm(ks[4], (DEPTH, DEC_BATCH, W_A), 0.5),
        "state_rglru_conv": nrm(ks[5], (DEPTH, DEC_BATCH, CONV_A - 1, W_A), 1.0),
        "state_ffn_conv": nrm(ks[6], (DEPTH, DEC_BATCH, CONV_F - 1, 2 * D_FF), 1.0),
        "g_mix_norm": gain(ks[7], (DEPTH, D_MODEL)),
        "w_in": nrm(ks[8], (DEPTH, D_MODEL, 2 * W_A + 2 * W_B), D_MODEL ** -0.5),
        "conv_a_w": nrm(ks[9], (DEPTH, CONV_A, W_A), CONV_A ** -0.5),
        "conv_a_b": nrm(ks[10], (DEPTH, W_A), 0.02),
        "lru_wa": nrm(ks[11], (DEPTH, H_A, BW_A, BW_A), BW_A ** -0.5),
        "lru_ba": nrm(ks[13], (DEPTH, W_A), 0.02),
        "lru_wx": nrm(ks[14], (DEPTH, H_A, BW_A, BW_A), BW_A ** -0.5),
        "lru_bx": nrm(ks[15], (DEPTH, W_A), 0.02),
        "lru_a_param": jnp.log(u) - jnp.log1p(-u),
        "g_out_a": gain(ks[16], (DEPTH, W_A)),
        "ln_v_g": gain(ks[17], (DEPTH, W_B)),
        "ln_v_b": nrm(ks[18], (DEPTH, W_B), 0.02),
        "sgu_w": nrm(ks[19], (DEPTH, H_B, CHUNK, CHUNK), CHUNK ** -0.5),
        "sgu_b": gain(ks[20], (DEPTH, H_B, CHUNK)),
        "g_out_b": gain(ks[21], (DEPTH, W_B)),
        "w_out": nrm(ks[22], (DEPTH, MIX_W, D_MODEL), MIX_W ** -0.5),
        "g_ffn_norm": gain(ks[23], (DEPTH, D_MODEL)),
        "w_up": nrm(ks[24], (DEPTH, D_MODEL, 2 * D_FF), D_MODEL ** -0.5),
        "ffn_conv_w": nrm(ks[25], (DEPTH, CONV_F, 2 * D_FF), CONV_F ** -0.5),
        "ffn_conv_b": nrm(ks[26], (DEPTH, 2 * D_FF), 0.02),
        "w_down": nrm(ks[27], (DEPTH, D_FF, D_MODEL), D_FF ** -0.5),
        "g_ple_norm": gain(ks[28], (DEPTH, D_MODEL)),
        "w_ple_gate": nrm(ks[29], (DEPTH, D_MODEL, D_MODEL), D_MODEL ** -0.5),
        "w_ple": nrm(ks[30], (DEPTH, PLE_DIM, D_MODEL), PLE_DIM ** -0.5),
        "g_final": gain(ks[31], (D_MODEL,)),
    }


def reference(x_prompt, x_sample, p_prompt, p_sample, state_rglru_h, state_rglru_conv,
              state_ffn_conv, g_mix_norm, w_in, conv_a_w, conv_a_b, lru_wa, lru_ba, lru_wx,
              lru_bx, lru_a_param, g_out_a, ln_v_g, ln_v_b, sgu_w, sgu_b, g_out_b, w_out,
              g_ffn_norm, w_up, ffn_conv_w, ffn_conv_b, w_down, g_ple_norm, w_ple_gate,
              w_ple, g_final):
    hp = x_prompt
    hs = x_sample
    Bp = x_prompt.shape[0]
    hP, hS, cP, cS, vS, fP, fS = [], [], [], [], [], [], []
    for i in range(DEPTH):
        lw = {
            'g_mix_norm': g_mix_norm[i], 'w_in': w_in[i], 'conv_a_w': conv_a_w[i],
            'conv_a_b': conv_a_b[i], 'lru_wa': lru_wa[i], 'lru_ba': lru_ba[i],
            'lru_wx': lru_wx[i], 'lru_bx': lru_bx[i], 'lru_a_param': lru_a_param[i],
            'g_out_a': g_out_a[i], 'ln_v_g': ln_v_g[i], 'ln_v_b': ln_v_b[i],
            'sgu_w': sgu_w[i], 'sgu_b': sgu_b[i], 'g_out_b': g_out_b[i], 'w_out': w_out[i],
            'g_ffn_norm': g_ffn_norm[i], 'w_up': w_up[i], 'ffn_conv_w': ffn_conv_w[i],
            'ffn_conv_b': ffn_conv_b[i], 'w_down': w_down[i], 'g_ple_norm': g_ple_norm[i],
            'w_ple_gate': w_ple_gate[i], 'w_ple': w_ple[i],
        }
        z_h = jnp.zeros((Bp, W_A), jnp.float32)
        z_c = jnp.zeros((Bp, CONV_A - 1, W_A), hp.dtype)
        z_f = jnp.zeros((Bp, CONV_F - 1, 2 * D_FF), hp.dtype)
        hp, h_p, c_p, _, f_p = _layer(hp, p_prompt[i], z_h, z_c, z_f, True, lw)
        hs, h_s, c_s, v_s, f_s = _layer(hs, p_sample[i], state_rglru_h[i], state_rglru_conv[i],
                                        state_ffn_conv[i], False, lw)
        hP.append(h_p); hS.append(h_s); cP.append(c_p); cS.append(c_s)
        vS.append(v_s); fP.append(f_p); fS.append(f_s)
    y_prompt = _rmsnorm(hp, g_final)
    y_sample = _rmsnorm(hs, g_final)
    new_rglru_h_prompt = jnp.stack(hP)
    new_rglru_h_sample = jnp.stack(hS)
    new_rglru_conv_prompt = jnp.stack(cP)
    new_rglru_conv_sample = jnp.stack(cS)
    new_sgu_v_sample = jnp.stack(vS)
    new_ffn_conv_prompt = jnp.stack(fP)
    new_ffn_conv_sample = jnp.stack(fS)
    return (y_prompt, y_sample, new_rglru_h_prompt, new_rglru_h_sample, new_rglru_conv_prompt,
            new_rglru_conv_sample, new_sgu_v_sample, new_ffn_conv_prompt, new_ffn_conv_sample)
```

```cpp
#ifndef REP
#define REP 0
#endif
#ifndef PSKIP
#define PSKIP 0
#endif
#ifndef PMODE
#define PMODE 0
#endif
#include <hip/hip_runtime.h>
#include <hip/hip_cooperative_groups.h>
#include <cstdio>
namespace cg = cooperative_groups;
#define LAS __attribute__((address_space(3)))
typedef unsigned short bf16_t;
typedef short bf16x8 __attribute__((ext_vector_type(8)));
typedef float f32x4 __attribute__((ext_vector_type(4)));
typedef float f32x2 __attribute__((ext_vector_type(2)));
typedef unsigned u32x4 __attribute__((ext_vector_type(4)));
typedef unsigned u32x2 __attribute__((ext_vector_type(2)));

constexpr int D = 1024, NP = 16384, NS = 512, NT = 16896, SEQ = 2048, NBP = 8, NBS = 128;
constexpr int WA = 512, DFF = 3072, PLE = 256;
constexpr float EPS = 1e-6f;
constexpr size_t O_Y = 0;
constexpr size_t O_HP = 17301504, O_HS = 17305600, O_CP = 17371136, O_CS = 17383424, O_VS = 17580032, O_FP = 17842176, O_FS = 17940480, O_END = 19513344;
constexpr size_t OFF_BAR = 0, OFF_FLAG = 16384, CTL_BYTES = 32768;
constexpr size_t OFF_WIN = 32768;
constexpr size_t OFF_WOUT = OFF_WIN + (size_t)2048 * 1024 * 2;
constexpr size_t OFF_WUP = OFF_WOUT + (size_t)1024 * 1024 * 2;
constexpr size_t OFF_WDN = OFF_WUP + (size_t)6144 * 1024 * 2;
constexpr size_t OFF_WPG = OFF_WDN + (size_t)1024 * 3072 * 2;
constexpr size_t OFF_WPLE = OFF_WPG + (size_t)1024 * 1024 * 2;
constexpr size_t OFF_WG = OFF_WPLE + (size_t)1024 * 256 * 2;
constexpr size_t OFF_WSGU = OFF_WG + (size_t)8 * 128 * 64 * 2;
constexpr size_t OFF_RSTD1 = OFF_WSGU + (size_t)4 * 128 * 128 * 2;
constexpr size_t OFF_SP = OFF_RSTD1 + 98304;
constexpr size_t OFF_LNSTAT = OFF_RSTD1 + 131072;
constexpr size_t STAT_BYTES = (size_t)NT * 16 * 4;
constexpr size_t OFF_SSQY = OFF_LNSTAT + STAT_BYTES;
constexpr size_t OFF_SSQ1 = OFF_SSQY + STAT_BYTES;
constexpr size_t OFF_SSQ2 = OFF_SSQ1 + STAT_BYTES;
constexpr size_t OFF_SSQ3 = OFF_SSQ2 + STAT_BYTES;
constexpr size_t OFF_AGG = OFF_SSQ3 + STAT_BYTES;
constexpr size_t OFF_HALO = OFF_AGG + (size_t)1024 * 128 * 4;
constexpr size_t OFF_PB = OFF_HALO + (size_t)264 * 4 * 6144 * 4;
constexpr size_t OFF_R1 = OFF_PB + (size_t)NT * 256 * 2;
constexpr size_t OFF_XB = OFF_R1, OFF_Z = OFF_R1 + (size_t)NT * 1024 * 2, OFF_ACT = OFF_R1, OFF_H3 = OFF_R1;
constexpr size_t OFF_R3 = OFF_R1 + (size_t)NT * 3072 * 2;
constexpr size_t OFF_E = OFF_R3 + (size_t)NT * 1024 * 2, OFF_Y = OFF_E;
constexpr size_t WS_END = OFF_E + (size_t)NT * 1024 * 2;

constexpr int LDS_BYTES = 155648, LDS_X = 131072;

struct Params {
    const float* in[32];
    float* out;
    unsigned char* ws;
    int use_cg;
    int pad;
};

typedef const __attribute__((address_space(4))) Params* KP;

__device__ __forceinline__ unsigned cvt_pk_bf16(float lo, float hi) { unsigned r; asm volatile("v_cvt_pk_bf16_f32 %0, %1, %2" : "=v"(r) : "v"(lo), "v"(hi)); return r; }
__device__ __forceinline__ float bflo(unsigned w) { return __uint_as_float(w << 16); }
__device__ __forceinline__ float bfhi(unsigned w) { return __uint_as_float(w & 0xffff0000u); }
__device__ __forceinline__ float bf2f(bf16_t v) { return __uint_as_float((unsigned)v << 16); }
__device__ __forceinline__ float sigmoidf_(float x) { return __builtin_amdgcn_rcpf(1.0f + __builtin_amdgcn_exp2f(-1.4426950409f * x)); }
__device__ __forceinline__ float gelu_t(float x) {
    const float u = x * (-2.3022082f - 0.1029432f * x * x);
    return x * __builtin_amdgcn_rcpf(1.0f + __builtin_amdgcn_exp2f(u));
}
__device__ __forceinline__ f32x2 gelu2(f32x2 x) {
    const f32x2 u = x * ((x * x) * (-0.1029432f) + (-2.3022082f));
    f32x2 e; e.x = __builtin_amdgcn_exp2f(u.x); e.y = __builtin_amdgcn_exp2f(u.y);
    const f32x2 d = e + 1.0f;
    f32x2 r; r.x = __builtin_amdgcn_rcpf(d.x); r.y = __builtin_amdgcn_rcpf(d.y);
    return x * r;
}
__device__ __forceinline__ f32x4 gelu4(f32x4 v) { const f32x2 a = gelu2((f32x2){v[0], v[1]}), b = gelu2((f32x2){v[2], v[3]}); return (f32x4){a.x, a.y, b.x, b.y}; }
__device__ __forceinline__ float wave_sum(float v) {
#pragma unroll
    for (int o = 32; o >= 1; o >>= 1) v += __shfl_xor(v, o);
    return v;
}
template <int CTRL> __device__ __forceinline__ float dppf(float v) { return __int_as_float(__builtin_amdgcn_update_dpp(0, __float_as_int(v), CTRL, 0xf, 0xf, false)); }

#define XB_TMO      128
#define XB_XCNT(j)  (256  + 64 * (j))
#define XB_XSUB(j)  (1280 + 64 * (j))
#define XB_XGEN(j)  (2304 + 64 * (j))
#define XB_TOP      3328
#define XB_TOPGEN   3392
#define XCD_BAR_WORDS 3456
#define XB_SPIN_CAP (1u << 20)
__device__ __forceinline__ unsigned xb_ld(unsigned* p)              { return __hip_atomic_load(p, __ATOMIC_RELAXED, __HIP_MEMORY_SCOPE_AGENT); }
__device__ __forceinline__ unsigned xb_add(unsigned* p, unsigned v) { return __hip_atomic_fetch_add(p, v, __ATOMIC_RELAXED, __HIP_MEMORY_SCOPE_AGENT); }
__device__ __forceinline__ unsigned xb_xcc_id() { return (unsigned)__builtin_amdgcn_s_getreg((3 << 11) | 20) & 0xFu; }
#define XB_SPIN(cond, bar) do { unsigned _sp = 0; while (cond) { __builtin_amdgcn_s_sleep(1); \
    if ((++_sp & 255u) == 0u) { if (xb_ld(&(bar)[XB_TMO])) break; if (_sp > XB_SPIN_CAP) { atomicAdd(&(bar)[XB_TMO], 1u); break; } } } } while (0)
struct XcdBarrier { unsigned* bar; unsigned x; volatile LAS unsigned* st; };
__device__ __forceinline__ XcdBarrier xcd_barrier_post(unsigned* bar, volatile LAS unsigned* st) {
    XcdBarrier b; b.bar = bar; b.x = xb_xcc_id(); b.st = st;
    if (threadIdx.x == 0) (void)xb_add(&bar[XB_XCNT(b.x)], 1u);
    return b;
}
__device__ __forceinline__ void xcd_barrier_complete(unsigned* bar, unsigned x, unsigned& nloc, unsigned& nx) {
    const unsigned G = gridDim.x * gridDim.y * gridDim.z;
    unsigned sum, cnt, mine, sp = 0u;
    for (;;) {
        sum = 0u; cnt = 0u; mine = 0u;
#pragma unroll
        for (unsigned j = 0; j < 16; ++j) { const unsigned c = xb_ld(&bar[XB_XCNT(j)]); sum += c; cnt += (c > 0u) ? 1u : 0u; mine = (j == x) ? c : mine; }
        if (sum == G) break;
        __builtin_amdgcn_s_sleep(1);
        if ((++sp & 255u) == 0u) { if (xb_ld(&bar[XB_TMO])) break; if (sp > XB_SPIN_CAP) { atomicAdd(&bar[XB_TMO], 1u); break; } }
    }
    nloc = mine > 0u ? mine : 1u; nx = cnt > 0u ? cnt : 1u;
}
__device__ __forceinline__ void xcd_barrier(const XcdBarrier& b) {
    asm volatile("s_waitcnt vmcnt(0)" ::: "memory");
    __syncthreads();
    if (threadIdx.x == 0) {
        unsigned* bar = b.bar;
        __builtin_amdgcn_s_waitcnt(0);
        unsigned nloc = b.st[0], nx = b.st[1];
        if (nloc == 0u) { xcd_barrier_complete(bar, b.x, nloc, nx); b.st[0] = nloc; b.st[1] = nx; }
        const unsigned old = xb_add(&bar[XB_XSUB(b.x)], 1u);
        const unsigned gen = old / nloc;
        if (old + 1u == (gen + 1u) * nloc) {
            __builtin_amdgcn_fence(__ATOMIC_RELEASE, "agent");
            asm volatile("s_waitcnt vmcnt(0)" ::: "memory");
            const unsigned og = xb_add(&bar[XB_TOP], 1u);
            const unsigned tg = og / nx;
            if (og + 1u == (tg + 1u) * nx) xb_add(&bar[XB_TOPGEN], 1u);
            else XB_SPIN(xb_ld(&bar[XB_TOPGEN]) == tg, bar);
            __builtin_amdgcn_fence(__ATOMIC_ACQUIRE, "agent");
            xb_add(&bar[XB_XGEN(b.x)], 1u);
            asm volatile("s_waitcnt vmcnt(0)" ::: "memory");
        } else {
            XB_SPIN(xb_ld(&bar[XB_XGEN(b.x)]) == gen, bar);
            __builtin_amdgcn_fence(__ATOMIC_ACQUIRE, "agent");
            asm volatile("s_waitcnt vmcnt(0)" ::: "memory");
        }
    }
    __syncthreads();
}
namespace pg8 {
constexpr int BM = 256, BK = 64, HALF = 128, HTB = HALF * BK * 2, STAGE_BYTES = 8 * HTB, NXCD = 8, WGM = 8;
__device__ __forceinline__ int lds_byte(int r, int c) { const int st = (r >> 4) * 2 + (c >> 5), rr = r & 15, cc = c & 31, ob = rr * 64 + cc * 2; return st * 1024 + (ob ^ (((ob >> 9) & 1) << 5)); }
__device__ __forceinline__ void stage_rc(int b, int& R, int& C) { const int st = b / 1024, sb = b % 1024, swz = sb ^ (((sb >> 9) & 1) << 5); R = (st >> 1) * 16 + swz / 64; C = (st & 1) * 32 + (swz % 64) / 2; }
__device__ __forceinline__ int perm32(int rho) { const int n = rho >> 4, i = rho & 15; return 8 * (i >> 2) + 4 * n + (i & 3); }
struct Unit { int pm, pn; };
struct Gemm { const bf16_t* A; const bf16_t* Bt; int M, N, K; };
struct StaticOrder {
    int nM, nN, nwg, G, c;
    __device__ void init(int M, int N, int G_, int c_) { nM = M / BM; nN = N / BM; nwg = nM * nN; G = G_; c = c_; }
    __device__ bool next(int i, Unit& u) const {
        const long L = (long)i * G + c; if (L >= nwg) return false;
        int wgid = (int)L; { const int q = nwg / NXCD, r = nwg % NXCD, xcd = wgid % NXCD, off = wgid / NXCD; wgid = (xcd < r ? xcd * (q + 1) : r * (q + 1) + (xcd - r) * q) + off; }
        const int nig = WGM * nN, gid = wgid / nig, fm = gid * WGM, gsz = (nM - fm) < WGM ? (nM - fm) : WGM;
        u.pm = fm + ((wgid % nig) % gsz); u.pn = (wgid % nig) / gsz; return true;
    }
};

template <class Epi, class Sched, bool ALIGN_EPI = false, bool SP2 = false>
__device__ __forceinline__ void gemm_phase(LAS unsigned char* lds, const Gemm g, const Sched& S, const Epi& E) {
    int tid_ = threadIdx.x; asm volatile("" : "+v"(tid_));
    const int tid = tid_, wid = __builtin_amdgcn_readfirstlane(tid >> 6), lane = tid & 63, wr = wid >> 2, wc = wid & 3, fr = lane & 15, fq = lane >> 4;
    const int K = g.K, nt = K / BK;
    unsigned voffA[2], voffB[2];
#pragma unroll
    for (int i = 0; i < 2; ++i) { int R, C; stage_rc(tid * 16 + i * 8192, R, C); const int Rb = Epi::PERM ? ((R & ~31) + perm32(R & 31)) : R;
        const int Ra = Epi::APERM ? ((R & 64) + 4 * (R & 15) + ((R >> 4) & 3)) : R;
        voffA[i] = (unsigned)(Ra * K + C) * 2u; voffB[i] = (unsigned)(Rb * K + C) * 2u; }
    const size_t kstep = (size_t)(BK * 2);
    const size_t hstep = (size_t)HALF * K * 2;
    const size_t tstep = 2 * hstep;
    const unsigned ldsw = (unsigned)wid * 1024u;
    const int aoff = lds_byte(wr * 64 + fr, fq * 8), boff = lds_byte(wc * 32 + fr, fq * 8);
#define PG8_SA(b, h) (((b) * 2 + (h)) * HTB)
#define PG8_SB(b, h) ((4 + (b) * 2 + (h)) * HTB)
#define PG8_STAGE(bufoff, gbase, voff) do { _Pragma("unroll") for (int _i = 0; _i < 2; ++_i) \
        __builtin_amdgcn_global_load_lds((const unsigned*)((const char*)(gbase) + (voff)[_i]), (LAS unsigned*)(lds + (bufoff) + ldsw + _i * 8192), 16, 0, 0); } while (0)
#define PG8_LDA(dst, b, h) do { _Pragma("unroll") for (int m = 0; m < 4; ++m) _Pragma("unroll") for (int k = 0; k < 2; ++k) dst[m][k] = *(const LAS bf16x8*)(lds + PG8_SA(b, h) + aoff + m * 2048 + k * 1024); } while (0)
#define PG8_LDB(dst, b, h) do { _Pragma("unroll") for (int n = 0; n < 2; ++n) _Pragma("unroll") for (int k = 0; k < 2; ++k) dst[n][k] = *(const LAS bf16x8*)(lds + PG8_SB(b, h) + boff + n * 2048 + k * 1024); } while (0)
#define PG8_MMA(ai, bj, At, Bt) do { __builtin_amdgcn_s_setprio(1); _Pragma("unroll") for (int m = 0; m < 4; ++m) _Pragma("unroll") for (int n = 0; n < 2; ++n) _Pragma("unroll") for (int k = 0; k < 2; ++k) \
        acc[ai][bj][m][n] = __builtin_amdgcn_mfma_f32_16x16x32_bf16(Bt[n][k], At[m][k], acc[ai][bj][m][n], 0, 0, 0); __builtin_amdgcn_s_setprio(0); } while (0)
#define PG8_WAIT_V(n) asm volatile("s_waitcnt vmcnt(" #n ")" ::: "memory")
#define PG8_WAIT_L(n) asm volatile("s_waitcnt lgkmcnt(" #n ")" ::: "memory")
#define PG8_BAR __builtin_amdgcn_s_barrier()
#define PG8_SCHED __builtin_amdgcn_sched_barrier(0)
    Unit cur, nxt; int ui = 0;
    if (!S.next(0, cur)) return;
    f32x4 acc[2][2][4][2];
#pragma unroll
    for (int a = 0; a < 2; ++a)
#pragma unroll
        for (int b = 0; b < 2; ++b)
#pragma unroll
            for (int m = 0; m < 4; ++m)
#pragma unroll
                for (int n = 0; n < 2; ++n) acc[a][b][m][n] = (f32x4){0.f, 0.f, 0.f, 0.f};
    bf16x8 At[4][2], B0[2][2], B1[2][2];
    const char* cA = (const char*)g.A + (size_t)cur.pm * tstep; const char* cB = (const char*)g.Bt + (size_t)cur.pn * tstep;
    if constexpr (SP2) {
        PG8_STAGE(PG8_SB(0, 0), cB, voffB); PG8_STAGE(PG8_SB(0, 1), cB + hstep, voffB); PG8_STAGE(PG8_SA(0, 0), cA, voffA); PG8_STAGE(PG8_SA(0, 1), cA + hstep, voffA);
        if (wr == 1) PG8_BAR;
        PG8_WAIT_V(2); PG8_BAR;
        PG8_STAGE(PG8_SB(1, 0), cB + kstep, voffB); PG8_STAGE(PG8_SA(1, 0), cA + kstep, voffA); PG8_STAGE(PG8_SB(1, 1), cB + hstep + kstep, voffB);
        PG8_WAIT_V(6); PG8_BAR;
    } else {
        PG8_STAGE(PG8_SB(0, 0), cB, voffB); PG8_STAGE(PG8_SA(0, 0), cA, voffA); PG8_STAGE(PG8_SB(0, 1), cB + hstep, voffB); PG8_STAGE(PG8_SA(0, 1), cA + hstep, voffA);
        if (wr == 1) PG8_BAR;
        PG8_WAIT_V(4); PG8_BAR;
        PG8_STAGE(PG8_SB(1, 0), cB + kstep, voffB); PG8_STAGE(PG8_SA(1, 0), cA + kstep, voffA); PG8_STAGE(PG8_SB(1, 1), cB + hstep + kstep, voffB);
        PG8_WAIT_V(6); PG8_BAR;
    }
    for (;;) {
        const bool has_next = S.next(ui + 1, nxt);
        const char* nA = has_next ? (const char*)g.A + (size_t)nxt.pm * tstep : cA; const char* nB = has_next ? (const char*)g.Bt + (size_t)nxt.pn * tstep : cB;
        for (int t = 0; t < nt; t += 2) {
            const bool last = (t == nt - 2);
            const char* a1 = cA + (size_t)(t + 1) * kstep;
            const char* a2 = last ? nA : cA + (size_t)(t + 2) * kstep; const char* b2 = last ? nB : cB + (size_t)(t + 2) * kstep;
            const char* a3 = a2 + kstep; const char* b3 = b2 + kstep;
            if constexpr (Epi::HAS_MID) { if (t == (nt >> 1)) E.mid(acc, cur, ui, wr, fr); }
            if constexpr (SP2) {
            PG8_LDB(B0, 0, 0); PG8_LDB(B1, 0, 1); PG8_SCHED; PG8_LDA(At, 0, 0); PG8_STAGE(PG8_SA(1, 1), a1 + hstep, voffA);
            PG8_WAIT_V(8); PG8_WAIT_L(0); PG8_BAR; PG8_MMA(0, 0, At, B0); PG8_MMA(0, 1, At, B1); PG8_BAR; PG8_SCHED;
            PG8_LDA(At, 0, 1); PG8_STAGE(PG8_SB(0, 0), b2, voffB); PG8_STAGE(PG8_SB(0, 1), b2 + hstep, voffB); PG8_STAGE(PG8_SA(0, 0), a2, voffA);
            PG8_WAIT_V(8); PG8_WAIT_L(0); PG8_BAR; PG8_MMA(1, 0, At, B0); PG8_MMA(1, 1, At, B1); PG8_BAR; PG8_SCHED;
            PG8_LDB(B0, 1, 0); PG8_LDB(B1, 1, 1); PG8_SCHED; PG8_LDA(At, 1, 0); PG8_STAGE(PG8_SA(0, 1), a2 + hstep, voffA);
            PG8_WAIT_V(8); PG8_WAIT_L(0); PG8_BAR; PG8_MMA(0, 0, At, B0); PG8_MMA(0, 1, At, B1); PG8_BAR; PG8_SCHED;
            PG8_LDA(At, 1, 1); PG8_STAGE(PG8_SB(1, 0), b3, voffB); PG8_STAGE(PG8_SB(1, 1), b3 + hstep, voffB); PG8_STAGE(PG8_SA(1, 0), a3, voffA);
            PG8_WAIT_V(8); PG8_WAIT_L(0); PG8_BAR; PG8_MMA(1, 0, At, B0); PG8_MMA(1, 1, At, B1); PG8_BAR; PG8_SCHED;
            } else {
            PG8_LDB(B0, 0, 0); PG8_SCHED; PG8_LDA(At, 0, 0); PG8_STAGE(PG8_SA(1, 1), a1 + hstep, voffA);
            PG8_WAIT_L(8); PG8_BAR; PG8_WAIT_L(0); PG8_MMA(0, 0, At, B0); PG8_BAR; PG8_SCHED;
            PG8_LDB(B1, 0, 1); PG8_STAGE(PG8_SB(0, 0), b2, voffB);
            PG8_BAR; PG8_WAIT_L(0); PG8_MMA(0, 1, At, B1); PG8_BAR;
            PG8_LDA(At, 0, 1); PG8_STAGE(PG8_SA(0, 0), a2, voffA);
            PG8_BAR; PG8_WAIT_L(0); PG8_MMA(1, 0, At, B0); PG8_BAR; PG8_SCHED;
            PG8_STAGE(PG8_SB(0, 1), b2 + hstep, voffB);
            PG8_WAIT_V(6); PG8_BAR; PG8_MMA(1, 1, At, B1); PG8_BAR;
            PG8_LDB(B0, 1, 0); PG8_SCHED; PG8_LDA(At, 1, 0); PG8_STAGE(PG8_SA(0, 1), a2 + hstep, voffA);
            PG8_WAIT_L(8); PG8_BAR; PG8_WAIT_L(0); PG8_MMA(0, 0, At, B0); PG8_BAR; PG8_SCHED;
            PG8_LDB(B1, 1, 1); PG8_STAGE(PG8_SB(1, 0), b3, voffB);
            PG8_BAR; PG8_WAIT_L(0); PG8_MMA(0, 1, At, B1); PG8_BAR;
            PG8_LDA(At, 1, 1); PG8_STAGE(PG8_SA(1, 0), a3, voffA);
            PG8_BAR; PG8_WAIT_L(0); PG8_MMA(1, 0, At, B0); PG8_BAR; PG8_SCHED;
            PG8_STAGE(PG8_SB(1, 1), b3 + hstep, voffB);
            PG8_WAIT_V(6); PG8_BAR; PG8_MMA(1, 1, At, B1); PG8_BAR;
            }
        }
        if constexpr (ALIGN_EPI) { if (wr == 0) PG8_BAR; }
        if constexpr (!Epi::AFTER_DRAIN) E(acc, cur, ui, wr, wc, fr, fq);
        if (!has_next) break;
#pragma unroll
        for (int a = 0; a < 2; ++a)
#pragma unroll
            for (int b = 0; b < 2; ++b)
#pragma unroll
                for (int m = 0; m < 4; ++m)
#pragma unroll
                    for (int n = 0; n < 2; ++n) acc[a][b][m][n] = (f32x4){0.f, 0.f, 0.f, 0.f};
        cur = nxt; cA = nA; cB = nB; ++ui;
        if constexpr (ALIGN_EPI) { if (wr == 1) PG8_BAR; }
    }
    PG8_WAIT_V(0);
    if constexpr (!ALIGN_EPI) { if (wr == 0) PG8_BAR; }
    PG8_BAR;
    if constexpr (Epi::AFTER_DRAIN) E.fused(acc, cur, ui, wr, wc, fr, fq, lds);
#undef PG8_SA
#undef PG8_SB
#undef PG8_STAGE
#undef PG8_LDA
#undef PG8_LDB
#undef PG8_MMA
#undef PG8_WAIT_V
#undef PG8_WAIT_L
#undef PG8_BAR
#undef PG8_SCHED
}
}
using pg8::Unit;
typedef f32x4 Acc[2][2][4][2];

__device__ __forceinline__ u32x4 pack8(f32x4 a, f32x4 b) { u32x4 w; w.x = cvt_pk_bf16(a[0], a[1]); w.y = cvt_pk_bf16(a[2], a[3]); w.z = cvt_pk_bf16(b[0], b[1]); w.w = cvt_pk_bf16(b[2], b[3]); return w; }
__device__ __forceinline__ void unpack8(u32x4 w, f32x4& a, f32x4& b) { a = (f32x4){bflo(w.x), bfhi(w.x), bflo(w.y), bfhi(w.y)}; b = (f32x4){bflo(w.z), bfhi(w.z), bflo(w.w), bfhi(w.w)}; }
__device__ __forceinline__ float red_fq(float v) { v += __shfl_xor(v, 16); v += __shfl_xor(v, 32); return v; }
__device__ __forceinline__ float red8(float v) { v += __shfl_xor(v, 1); v += __shfl_xor(v, 2); v += __shfl_xor(v, 4); return v; }
__device__ __forceinline__ float sq4(f32x4 a) { return a[0] * a[0] + a[1] * a[1] + a[2] * a[2] + a[3] * a[3]; }
__device__ __forceinline__ float sum4(f32x4 a) { return (a[0] + a[1]) + (a[2] + a[3]); }
__device__ __forceinline__ float sum16(const float* sp) { return (sum4(*(const f32x4*)sp) + sum4(*(const f32x4*)(sp + 4))) + (sum4(*(const f32x4*)(sp + 8)) + sum4(*(const f32x4*)(sp + 12))); }

__device__ __forceinline__ void seg_z(int kind, float rs, f32x4& v0, f32x4& v1, float& s1, float& s2) {
    v0 *= rs; v1 *= rs;
    if (kind != 0) { v0 = gelu4(v0); v1 = gelu4(v1); }
    if (kind == 3) { s1 += sum4(v0) + sum4(v1); s2 += sq4(v0) + sq4(v1); }
}
struct EpiZ {
    static constexpr bool PERM = true, HAS_MID = false, AFTER_DRAIN = false, APERM = false;
    bf16_t* Z; const float* rstd1; float* lnstat;
    __device__ __forceinline__ void operator()(const Acc& acc, const Unit& u, int ui, int wr, int wc, int fr, int fq) const {
        const int row0 = u.pm * 256 + wr * 64 + fr, col0 = u.pn * 256 + wc * 32 + 8 * fq, kind = u.pn >> 1;
#pragma unroll
        for (int ai = 0; ai < 2; ++ai)
#pragma unroll
            for (int m = 0; m < 4; ++m) {
                const int row = row0 + ai * 128 + m * 16; const float rs = rstd1[row];
                float s1 = 0.f, s2 = 0.f;
#pragma unroll
                for (int bj = 0; bj < 2; ++bj) {
                    f32x4 v0 = acc[ai][bj][m][0], v1 = acc[ai][bj][m][1];
                    seg_z(kind, rs, v0, v1, s1, s2);
                    *(u32x4*)(Z + (size_t)row * 2048 + col0 + bj * 128) = pack8(v0, v1);
                }
                if (kind == 3) { s1 = red_fq(s1); s2 = red_fq(s2);
                    if (fq == 0) *(f32x2*)(lnstat + (size_t)row * 16 + (((u.pn - 6) * 4 + wc) * 2)) = (f32x2){s1, s2}; }
            }
    }
};
struct EpiE {
    static constexpr bool PERM = true, HAS_MID = false, AFTER_DRAIN = false, APERM = false;
    bf16_t* O;
    __device__ __forceinline__ void operator()(const Acc& acc, const Unit& u, int ui, int wr, int wc, int fr, int fq) const {
        const int row0 = u.pm * 256 + wr * 64 + fr, col0 = u.pn * 256 + wc * 32 + 8 * fq;
#pragma unroll
        for (int ai = 0; ai < 2; ++ai)
#pragma unroll
            for (int m = 0; m < 4; ++m)
#pragma unroll
                for (int bj = 0; bj < 2; ++bj)
                    *(u32x4*)(O + (size_t)(row0 + ai * 128 + m * 16) * 1024 + col0 + bj * 128) = pack8(acc[ai][bj][m][0], acc[ai][bj][m][1]);
    }
};
struct EpiH1 {
    static constexpr bool PERM = true, HAS_MID = true, AFTER_DRAIN = false, APERM = false;
    const bf16_t* Xb; bf16_t* Hb; float* ssq; const LAS f32x2* tab;
    __device__ __forceinline__ void mid(Acc& acc, const Unit& u, int ui, int wr, int fr) const {
#pragma unroll
        for (int ai = 0; ai < 2; ++ai)
#pragma unroll
            for (int m = 0; m < 4; ++m) { const float r = tab[ui * 256 + ai * 128 + wr * 64 + m * 16 + fr].x;
#pragma unroll
                for (int bj = 0; bj < 2; ++bj)
#pragma unroll
                    for (int n = 0; n < 2; ++n) acc[ai][bj][m][n] *= r; }
    }
    __device__ __forceinline__ void operator()(const Acc& acc, const Unit& u, int ui, int wr, int wc, int fr, int fq) const {
        const int rt0 = wr * 64 + fr, col0 = u.pn * 256 + wc * 32 + 8 * fq;
#pragma unroll
        for (int ai = 0; ai < 2; ++ai)
#pragma unroll
            for (int m = 0; m < 4; ++m) {
                const int rt = rt0 + ai * 128 + m * 16, row = u.pm * 256 + rt; const float rs = tab[ui * 256 + rt].y;
                float ss = 0.f;
#pragma unroll
                for (int bj = 0; bj < 2; ++bj) { const size_t o = (size_t)row * 1024 + col0 + bj * 128;
                    f32x4 x0, x1; unpack8(*(const u32x4*)(Xb + o), x0, x1);
                    const f32x4 h0 = x0 + acc[ai][bj][m][0] * rs, h1 = x1 + acc[ai][bj][m][1] * rs;
                    ss += sq4(h0) + sq4(h1);
                    *(u32x4*)(Hb + o) = pack8(h0, h1); }
                ss = red_fq(ss);
                if (fq == 0) ssq[(size_t)row * 16 + u.pn * 4 + wc] = ss;
            }
    }
};
struct EpiH2 {
    static constexpr bool PERM = true, HAS_MID = false, AFTER_DRAIN = false, APERM = false;
    bf16_t* Hb; float* ssq;
    __device__ __forceinline__ void operator()(const Acc& acc, const Unit& u, int ui, int wr, int wc, int fr, int fq) const {
        const int row0 = u.pm * 256 + wr * 64 + fr, col0 = u.pn * 256 + wc * 32 + 8 * fq;
#pragma unroll
        for (int ai = 0; ai < 2; ++ai)
#pragma unroll
            for (int m = 0; m < 4; ++m) {
                const int row = row0 + ai * 128 + m * 16; float ss = 0.f;
#pragma unroll
                for (int bj = 0; bj < 2; ++bj) { bf16_t* hp = Hb + (size_t)row * 1024 + col0 + bj * 128;
                    f32x4 x0, x1; unpack8(*(const u32x4*)hp, x0, x1);
                    const f32x4 h0 = x0 + acc[ai][bj][m][0], h1 = x1 + acc[ai][bj][m][1];
                    ss += sq4(h0) + sq4(h1);
                    *(u32x4*)hp = pack8(h0, h1); }
                ss = red_fq(ss);
                if (fq == 0) ssq[(size_t)row * 16 + u.pn * 4 + wc] = ss;
            }
    }
};
struct EpiG {
    static constexpr bool PERM = true, HAS_MID = false, AFTER_DRAIN = false, APERM = false;
    const bf16_t* Hb; const bf16_t* E; bf16_t* H3; float* ssq; const LAS float* tab;
    __device__ __forceinline__ void operator()(const Acc& acc, const Unit& u, int ui, int wr, int wc, int fr, int fq) const {
        const int rt0 = wr * 64 + fr, col0 = u.pn * 256 + wc * 32 + 8 * fq;
#pragma unroll
        for (int ai = 0; ai < 2; ++ai)
#pragma unroll
            for (int m = 0; m < 4; ++m) {
                const int rt = rt0 + ai * 128 + m * 16, row = u.pm * 256 + rt; const float rs = tab[ui * 256 + rt]; float ss = 0.f;
#pragma unroll
                for (int bj = 0; bj < 2; ++bj) { const size_t o = (size_t)row * 1024 + col0 + bj * 128;
                    f32x4 e0, e1, x0, x1; unpack8(*(const u32x4*)(E + o), e0, e1); unpack8(*(const u32x4*)(Hb + o), x0, x1);
                    f32x4 g0 = acc[ai][bj][m][0] * rs, g1 = acc[ai][bj][m][1] * rs;
#pragma unroll
                    for (int e = 0; e < 4; ++e) { g0[e] = sigmoidf_(g0[e]); g1[e] = sigmoidf_(g1[e]); }
                    const f32x4 h0 = x0 + e0 * g0, h1 = x1 + e1 * g1;
                    ss += sq4(h0) + sq4(h1);
                    *(u32x4*)(H3 + o) = pack8(h0, h1); }
                ss = red_fq(ss);
                if (fq == 0) ssq[(size_t)row * 16 + u.pn * 4 + wc] = ss;
            }
    }
};
struct EpiGF {
    static constexpr bool PERM = true, HAS_MID = false, AFTER_DRAIN = true, APERM = false;
    const bf16_t* Hb; const bf16_t* E; float* Y; const float* gfin; float* X; unsigned* cnt; const LAS float* tab;
    __device__ __forceinline__ void operator()(const Acc& acc, const Unit& u, int ui, int wr, int wc, int fr, int fq) const {}
    __device__ __forceinline__ void fused(Acc& acc, const Unit& u, int ui, int wr, int wc, int fr, int fq, LAS unsigned char* lds) const {
        const int rt0 = wr * 64 + fr, col0 = u.pn * 256 + wc * 32 + 8 * fq, tid = threadIdx.x;
        LAS float* Pw = (LAS float*)lds;
        LAS float* Rs = (LAS float*)lds + 1024;
#pragma unroll
        for (int ai = 0; ai < 2; ++ai)
#pragma unroll
            for (int m = 0; m < 4; ++m) {
                const int rt = rt0 + ai * 128 + m * 16, row = u.pm * 256 + rt; const float rs = tab[ui * 256 + rt]; float ss = 0.f;
#pragma unroll
                for (int bj = 0; bj < 2; ++bj) { const size_t o = (size_t)row * 1024 + col0 + bj * 128;
                    f32x4 e0, e1, x0, x1; unpack8(*(const u32x4*)(E + o), e0, e1); unpack8(*(const u32x4*)(Hb + o), x0, x1);
                    f32x4 g0 = acc[ai][bj][m][0] * rs, g1 = acc[ai][bj][m][1] * rs;
#pragma unroll
                    for (int e = 0; e < 4; ++e) { g0[e] = sigmoidf_(g0[e]); g1[e] = sigmoidf_(g1[e]); }
                    const f32x4 h0 = x0 + e0 * g0, h1 = x1 + e1 * g1;
                    ss += sq4(h0) + sq4(h1);
                    acc[ai][bj][m][0] = h0; acc[ai][bj][m][1] = h1; }
                ss = red_fq(ss);
                if (fq == 0) Pw[rt * 4 + wc] = ss;
            }
        __syncthreads();
        if (tid < 256) { const f32x4 q = *(const LAS f32x4*)(Pw + tid * 4);
            __hip_atomic_store((unsigned*)(X + ((size_t)u.pm * 4 + u.pn) * 256 + tid), __float_as_uint(sum4(q)), __ATOMIC_RELAXED, __HIP_MEMORY_SCOPE_AGENT); }
        asm volatile("s_waitcnt vmcnt(0)" ::: "memory");
        __syncthreads();
        if (tid == 0) { __hip_atomic_fetch_add(cnt + u.pm * 16, 1u, __ATOMIC_RELAXED, __HIP_MEMORY_SCOPE_AGENT); unsigned sp = 0;
            while (__hip_atomic_load(cnt + u.pm * 16, __ATOMIC_RELAXED, __HIP_MEMORY_SCOPE_AGENT) < 4u) { __builtin_amdgcn_s_sleep(1); if (++sp > (1u << 22)) break; } }
        __syncthreads();
        if (tid < 256) { float s = 0.f;
#pragma unroll
            for (int k = 0; k < 4; ++k) s += __uint_as_float(__hip_atomic_load((const unsigned*)(X + ((size_t)u.pm * 4 + k) * 256 + tid), __ATOMIC_RELAXED, __HIP_MEMORY_SCOPE_AGENT));
            Rs[tid] = rsqrtf(s * (1.0f / 1024.0f) + EPS); }
        __syncthreads();
        f32x4 gv[2][2];
#pragma unroll
        for (int bj = 0; bj < 2; ++bj) { gv[bj][0] = *(const f32x4*)(gfin + col0 + bj * 128); gv[bj][1] = *(const f32x4*)(gfin + col0 + bj * 128 + 4); }
#pragma unroll
        for (int ai = 0; ai < 2; ++ai)
#pragma unroll
            for (int m = 0; m < 4; ++m) {
                const int rt = rt0 + ai * 128 + m * 16, row = u.pm * 256 + rt; const float rs = Rs[rt];
#pragma unroll
                for (int bj = 0; bj < 2; ++bj) { float* yp = Y + (size_t)row * 1024 + col0 + bj * 128;
                    *(f32x4*)yp = acc[ai][bj][m][0] * rs * gv[bj][0]; *(f32x4*)(yp + 4) = acc[ai][bj][m][1] * rs * gv[bj][1]; }
            }
        __syncthreads();
    }
};
template <int C> __device__ __forceinline__ f32x4 dpp4(f32x4 v) { return (f32x4){dppf<C>(v[0]), dppf<C>(v[1]), dppf<C>(v[2]), dppf<C>(v[3])}; }
__device__ __forceinline__ f32x4 sel4(bool c, f32x4 a, f32x4 b) { return c ? a : b; }
template <int C> __device__ __forceinline__ float dppo(float old, float v) { return __int_as_float(__builtin_amdgcn_update_dpp(__float_as_int(old), __float_as_int(v), C, 0xf, 0xf, false)); }
template <int C> __device__ __forceinline__ f32x4 dppo4(f32x4 o, f32x4 v) { return (f32x4){dppo<C>(o[0], v[0]), dppo<C>(o[1], v[1]), dppo<C>(o[2], v[2]), dppo<C>(o[3], v[3])}; }
template <int C> __device__ __forceinline__ float dppz(float v) { return __int_as_float(__builtin_amdgcn_update_dpp(0, __float_as_int(v), C, 0xf, 0xf, true)); }
template <int C> __device__ __forceinline__ f32x4 dppz4(f32x4 v) { return (f32x4){dppz<C>(v[0]), dppz<C>(v[1]), dppz<C>(v[2]), dppz<C>(v[3])}; }
struct EpiUp {
    static constexpr bool PERM = true, HAS_MID = false, AFTER_DRAIN = false, APERM = true;
    bf16_t* ACT; const LAS float* tab; const float* cw; const float* cb; bf16_t* halo; float* ofp; int mode;
    __device__ __forceinline__ void operator()(const Acc& acc, const Unit& u, int ui, int wr, int wc, int fr, int fq) const {
        const int jc0 = u.pn * 128 + wc * 32 + 8 * fq;
        u32x2 held[2][4];
#pragma unroll
        for (int n = 0; n < 2; ++n) {
            const int jc = jc0 + 4 * n;
            const f32x4 w0g = *(const f32x4*)(cw + jc), w1g = *(const f32x4*)(cw + 6144 + jc), w2g = *(const f32x4*)(cw + 12288 + jc), bg = *(const f32x4*)(cb + jc);
            const f32x4 w0v = *(const f32x4*)(cw + 3072 + jc), w1v = *(const f32x4*)(cw + 6144 + 3072 + jc), w2v = *(const f32x4*)(cw + 12288 + 3072 + jc), bv = *(const f32x4*)(cb + 3072 + jc);
#pragma unroll
            for (int ai = 0; ai < 2; ++ai) {
                const int rt0 = ai * 128 + wr * 64 + 4 * fr, row0 = u.pm * 256 + rt0, g = row0 >> 6;
                const f32x4 rs = *(const LAS f32x4*)(tab + ui * 256 + rt0);
                f32x4 cg[4], cv[4];
#pragma unroll
                for (int m = 0; m < 4; ++m) { cg[m] = acc[ai][0][m][n] * rs[m]; cv[m] = acc[ai][1][m][n] * rs[m]; }
                const f32x4 pg3 = dppz4<0x111>(cg[3]), pg2 = dppz4<0x111>(cg[2]), pv3 = dppz4<0x111>(cv[3]), pv2 = dppz4<0x111>(cv[2]);
#pragma unroll
                for (int m = 0; m < 4; ++m) {
                    const f32x4 xg1 = m == 0 ? pg3 : cg[m - 1], xg2 = m == 0 ? pg2 : (m == 1 ? pg3 : cg[m - 2]);
                    const f32x4 xv1 = m == 0 ? pv3 : cv[m - 1], xv2 = m == 0 ? pv2 : (m == 1 ? pv3 : cv[m - 2]);
                    const f32x4 og = bg + w0g * xg2 + w1g * xg1 + w2g * cg[m], ov = bv + w0v * xv2 + w1v * xv1 + w2v * cv[m];
                    const f32x4 av = gelu4(og) * ov;
                    const u32x2 pk = (u32x2){cvt_pk_bf16(av[0], av[1]), cvt_pk_bf16(av[2], av[3])};
                    if (n == 0) held[ai][m] = pk;
                    else if (!(m < 2 && fr == 0)) *(u32x4*)(ACT + (size_t)(row0 + m) * 3072 + jc0) = (u32x4){held[ai][m].x, held[ai][m].y, pk.x, pk.y};
                }
                if (fr == 0) {
#pragma unroll
                    for (int m = 0; m < 2; ++m) { bf16_t* hp = halo + (size_t)(g * 4 + m) * 6144 + jc;
                        *(u32x2*)hp = (u32x2){cvt_pk_bf16(cg[m][0], cg[m][1]), cvt_pk_bf16(cg[m][2], cg[m][3])}; *(u32x2*)(hp + 3072) = (u32x2){cvt_pk_bf16(cv[m][0], cv[m][1]), cvt_pk_bf16(cv[m][2], cv[m][3])}; } }
                if (fr == 15) {
#pragma unroll
                    for (int m = 2; m < 4; ++m) { bf16_t* hp = halo + (size_t)(g * 4 + m) * 6144 + jc;
                        *(u32x2*)hp = (u32x2){cvt_pk_bf16(cg[m][0], cg[m][1]), cvt_pk_bf16(cg[m][2], cg[m][3])}; *(u32x2*)(hp + 3072) = (u32x2){cvt_pk_bf16(cv[m][0], cv[m][1]), cvt_pk_bf16(cv[m][2], cv[m][3])};
                        const int row = row0 + m;
                        if ((row & 2047) >= 2046) { float* op = ofp + (size_t)((row >> 11) * 2 + (row & 2047) - 2046) * 6144 + jc; *(f32x4*)op = cg[m]; *(f32x4*)(op + 3072) = cv[m]; } } }
            }
        }
    }
};

template <int UN> struct Frags { bf16x8 a[UN][4], b[UN][4]; };
struct TileP { const bf16_t* ap; const bf16_t* bp[4]; int lda; };
__device__ __forceinline__ TileP st_tile(const bf16_t* A, int lda, int arow0, const bf16_t* Bt, int ldb, int b0, int b1, int b2, int b3, int K) {
    int tid_ = threadIdx.x; asm volatile("" : "+v"(tid_));
    const int wave = tid_ >> 6, lane = tid_ & 63, fr = lane & 15, fq = lane >> 4, kw = K >> 3;
    TileP t; t.lda = lda; t.ap = A + (size_t)(arow0 + fr) * lda + wave * kw + 8 * fq;
    const bf16_t* bb = Bt + (size_t)fr * ldb + wave * kw + 8 * fq;
    t.bp[0] = bb + (size_t)b0 * ldb; t.bp[1] = bb + (size_t)b1 * ldb; t.bp[2] = bb + (size_t)b2 * ldb; t.bp[3] = bb + (size_t)b3 * ldb;
    return t;
}
template <int UN> __device__ __forceinline__ void st_load(Frags<UN>& F, const TileP& t, int s0) {
#pragma unroll
    for (int s = 0; s < UN; ++s)
#pragma unroll
        for (int i = 0; i < 4; ++i) { F.a[s][i] = *(const bf16x8*)(t.ap + (size_t)(16 * i) * t.lda + (s0 + s) * 32); F.b[s][i] = *(const bf16x8*)(t.bp[i] + (s0 + s) * 32); }
}
template <int UN> __device__ __forceinline__ void st_mma(f32x4 (&acc)[4][4], const Frags<UN>& F) {
#pragma unroll
    for (int s = 0; s < UN; ++s)
#pragma unroll
        for (int i = 0; i < 4; ++i)
#pragma unroll
            for (int j = 0; j < 4; ++j) acc[i][j] = __builtin_amdgcn_mfma_f32_16x16x32_bf16(F.b[s][j], F.a[s][i], acc[i][j], 0, 0, 0);
}
__device__ __forceinline__ void st_zero(f32x4 (&acc)[4][4]) {
#pragma unroll
    for (int i = 0; i < 4; ++i)
#pragma unroll
        for (int j = 0; j < 4; ++j) acc[i][j] = (f32x4){0.f, 0.f, 0.f, 0.f};
}
__device__ __forceinline__ void st_reduce(LAS unsigned char* lds, const f32x4 (&acc)[4][4], f32x4& lo0, f32x4& lo1, f32x4& hi0, f32x4& hi1) {
    int tid_ = threadIdx.x; asm volatile("" : "+v"(tid_));
    const int tid = tid_, wave = tid >> 6, lane = tid & 63, fr = lane & 15, fq = lane >> 4;
    LAS float* P = (LAS float*)lds + wave * 4096;
#pragma unroll
    for (int i = 0; i < 4; ++i)
#pragma unroll
        for (int j = 0; j < 4; ++j) { const int r = 16 * i + fr, ch = (4 * j + fq) ^ fr; *(LAS f32x4*)(P + r * 64 + ch * 4) = acc[i][j]; }
    __syncthreads();
    {   const int r = tid >> 3, c = tid & 7; LAS const float* Q = (LAS const float*)lds + r * 64;
        const int c0 = ((2 * c) ^ (r & 15)) * 4, c1 = ((2 * c + 1) ^ (r & 15)) * 4;
        lo0 = (f32x4){0.f, 0.f, 0.f, 0.f}; lo1 = lo0; hi0 = lo0; hi1 = lo0;
#pragma unroll
        for (int w = 0; w < 4; ++w) { lo0 += *(LAS const f32x4*)(Q + w * 4096 + c0); lo1 += *(LAS const f32x4*)(Q + w * 4096 + c1);
            hi0 += *(LAS const f32x4*)(Q + (w + 4) * 4096 + c0); hi1 += *(LAS const f32x4*)(Q + (w + 4) * 4096 + c1); } }
    __syncthreads();
}
struct XpT { const float* src; const float* scale; bf16_t* dst; };
__device__ __forceinline__ XpT xp_desc(KP p, unsigned char* ws, int tt) {
    const int lane = threadIdx.x & 63, w = threadIdx.x >> 6;
    const float* src; int ldsrc, k0, scol0, lddst, drow0; const float* scale; bf16_t* dst;
    if (tt < 512) { const int kt = tt >> 5, nt = tt & 31; src = p->in[8]; ldsrc = 2048; k0 = kt * 64; scol0 = nt * 64; scale = p->in[7] + k0; dst = (bf16_t*)(ws + OFF_WIN); lddst = 1024; drow0 = nt * 64; }
    else if (tt < 768) { const int t2 = tt - 512, kt = t2 >> 4, nt = t2 & 15; src = p->in[22]; ldsrc = 1024; k0 = kt * 64; scol0 = nt * 64; scale = k0 < 512 ? p->in[16] + k0 : p->in[21] + (k0 - 512); dst = (bf16_t*)(ws + OFF_WOUT); lddst = 1024; drow0 = nt * 64; }
    else if (tt < 2304) { const int t2 = tt - 768, kt = t2 / 96, nt = t2 % 96, n0 = nt * 64; src = p->in[24]; ldsrc = 6144; k0 = kt * 64; scol0 = ((n0 & 255) >> 7) * 3072 + (n0 >> 8) * 128 + (n0 & 127); scale = p->in[23] + k0; dst = (bf16_t*)(ws + OFF_WUP); lddst = 1024; drow0 = n0; }
    else if (tt < 3072) { const int t2 = tt - 2304, kt = t2 >> 4, nt = t2 & 15; src = p->in[27]; ldsrc = 1024; k0 = kt * 64; scol0 = nt * 64; scale = nullptr; dst = (bf16_t*)(ws + OFF_WDN); lddst = 3072; drow0 = nt * 64; }
    else if (tt < 3328) { const int t2 = tt - 3072, kt = t2 >> 4, nt = t2 & 15; src = p->in[29]; ldsrc = 1024; k0 = kt * 64; scol0 = nt * 64; scale = p->in[28] + k0; dst = (bf16_t*)(ws + OFF_WPG); lddst = 1024; drow0 = nt * 64; }
    else { const int t2 = tt - 3328, kt = t2 >> 4, nt = t2 & 15; src = p->in[30]; ldsrc = 1024; k0 = kt * 64; scol0 = nt * 64; scale = nullptr; dst = (bf16_t*)(ws + OFF_WPLE); lddst = 256; drow0 = nt * 64; }
    XpT t; t.src = src + (size_t)(k0 + 8 * w) * ldsrc + scol0 + lane; t.scale = scale ? scale + 8 * w : nullptr; t.dst = dst + (size_t)(drow0 + lane) * lddst + k0 + 8 * w;
    return t;
}
__device__ __forceinline__ int xp_ld(int tt) { return tt < 512 ? 2048 : (tt >= 768 && tt < 2304) ? 6144 : 1024; }
__device__ __forceinline__ void p0_phase(KP p, LAS unsigned char* lds) {
    const int tid = threadIdx.x, lane = tid & 63, wave = tid >> 6, G = gridDim.x, blk = blockIdx.x;
    unsigned char* ws = p->ws;
    {   bf16_t* Xb = (bf16_t*)(ws + OFF_XB); float* rstd1 = (float*)(ws + OFF_RSTD1);
        for (int r0 = (blk * 8 + wave) * 2; r0 < NT; r0 += G * 16) {
            f32x4 v[2][4]; float ss[2];
#pragma unroll
            for (int h = 0; h < 2; ++h) { const int r = r0 + h; const float* src = r < NP ? p->in[0] + (size_t)r * D : p->in[1] + (size_t)(r - NP) * D;
#pragma unroll
                for (int i = 0; i < 4; ++i) v[h][i] = *(const f32x4*)(src + i * 256 + lane * 4); }
#pragma unroll
            for (int h = 0; h < 2; ++h) { ss[h] = 0.f;
#pragma unroll
                for (int i = 0; i < 4; ++i) ss[h] += sq4(v[h][i]);
                ss[h] = wave_sum(ss[h]);
                if (lane == 0) rstd1[r0 + h] = rsqrtf(ss[h] * (1.0f / 1024.0f) + EPS);
#pragma unroll
                for (int i = 0; i < 4; ++i) *(u32x2*)(Xb + (size_t)(r0 + h) * D + i * 256 + lane * 4) = (u32x2){cvt_pk_bf16(v[h][i][0], v[h][i][1]), cvt_pk_bf16(v[h][i][2], v[h][i][3])}; }
        } }
    {   bf16_t* Pb = (bf16_t*)(ws + OFF_PB);
        for (size_t i0 = ((size_t)blk * 512 + tid) * 4; i0 < (size_t)NT * 256; i0 += (size_t)G * 512 * 16) {
            f32x4 v[4];
#pragma unroll
            for (int h = 0; h < 4; ++h) { const size_t idx = i0 + (size_t)h * G * 512 * 4;
                if (idx < (size_t)NT * 256) v[h] = *(const f32x4*)(idx < (size_t)NP * 256 ? p->in[2] + idx : p->in[3] + (idx - (size_t)NP * 256)); }
#pragma unroll
            for (int h = 0; h < 4; ++h) { const size_t idx = i0 + (size_t)h * G * 512 * 4;
                if (idx < (size_t)NT * 256) *(u32x2*)(Pb + idx) = (u32x2){cvt_pk_bf16(v[h][0], v[h][1]), cvt_pk_bf16(v[h][2], v[h][3])}; }
        } }
    {   for (int tt = blk; tt < 3392; tt += 2 * G) {
            const int t1 = tt + G; const bool two = t1 < 3392;
            const XpT A = xp_desc(p, ws, tt), B = xp_desc(p, ws, two ? t1 : tt);
            const int la = xp_ld(tt), lb = xp_ld(two ? t1 : tt);
            float va[8], vb[8];
#pragma unroll
            for (int e = 0; e < 8; ++e) { va[e] = A.src[(size_t)e * la]; vb[e] = B.src[(size_t)e * lb]; }
            if (A.scale) {
#pragma unroll
                for (int e = 0; e < 8; ++e) va[e] *= A.scale[e]; }
            if (B.scale) {
#pragma unroll
                for (int e = 0; e < 8; ++e) vb[e] *= B.scale[e]; }
            *(u32x4*)A.dst = (u32x4){cvt_pk_bf16(va[0], va[1]), cvt_pk_bf16(va[2], va[3]), cvt_pk_bf16(va[4], va[5]), cvt_pk_bf16(va[6], va[7])};
            if (two) *(u32x4*)B.dst = (u32x4){cvt_pk_bf16(vb[0], vb[1]), cvt_pk_bf16(vb[2], vb[3]), cvt_pk_bf16(vb[4], vb[5]), cvt_pk_bf16(vb[6], vb[7])};
        } }
    {   u32x4* ag = (u32x4*)(ws + OFF_AGG); for (int i = blk * 512 + tid; i < 32768; i += G * 512) ag[i] = (u32x4){0u, 0u, 0u, 0u}; }
    {   bf16_t* Wg = (bf16_t*)(ws + OFF_WG); bf16_t* Ws = (bf16_t*)(ws + OFF_WSGU);
        if (blk == 0) ((float*)(ws + OFF_SP))[tid] = log1pf(expf(-p->in[15][tid]));
        for (int idx = blk * 512 + tid; idx < 65536; idx += G * 512) {
            const int hd = idx >> 13, n = (idx >> 6) & 127, k = idx & 63;
            const float v = n < 64 ? p->in[11][(hd * 64 + k) * 64 + n] : p->in[13][(hd * 64 + k) * 64 + (n - 64)];
            Wg[idx] = (bf16_t)(cvt_pk_bf16(v, 0.f) & 0xffffu);
            const int t = (idx >> 7) & 127, s = idx & 127;
            const float w = s <= t ? p->in[19][idx] : 0.f;
            Ws[idx] = (bf16_t)(cvt_pk_bf16(w, 0.f) & 0xffffu);
        } }
}

__device__ __forceinline__ float ald_f(const float* p) { return __uint_as_float(__hip_atomic_load((const unsigned*)p, __ATOMIC_RELAXED, __HIP_MEMORY_SCOPE_AGENT)); }
__device__ __forceinline__ void ast_f(float* p, float v) { __hip_atomic_store((unsigned*)p, __float_as_uint(v), __ATOMIC_RELAXED, __HIP_MEMORY_SCOPE_AGENT); }

__device__ __forceinline__ void p2_taskA(KP p, LAS unsigned char* lds, int task, int skip = 0) {
    int tid_ = threadIdx.x; asm volatile("" : "+v"(tid_));
    const int tid = tid_, lane = tid & 63, wave = tid >> 6;
    unsigned char* ws = p->ws;
    const bool samp = task >= 1024;
    const int hd = task & 7;
    const int c = samp ? 0 : (task >> 6), b = samp ? 0 : ((task >> 3) & 7), sc = samp ? ((task - 1024) >> 3) : 0;
    const int R0 = samp ? NP + sc * 128 : b * 2048 + c * 128;
    const bf16_t* Z = (const bf16_t*)(ws + OFF_Z);
    LAS bf16_t* xcb = (LAS bf16_t*)lds;
    LAS float* aS = (LAS float*)(lds + 18432);
    LAS float* uS = (LAS float*)(lds + 18432 + 34816);
    LAS float* Pseg = (LAS float*)(lds + 88064);
    LAS float* Sseg = Pseg + 512;
    LAS float* hin = Sseg + 512;
    const bf16_t* gap_ = Z + (size_t)(R0 + (tid >> 2)) * 2048 + 512 + hd * 64 + (tid & 3) * 16;
    const u32x4 gaw0 = *(const u32x4*)gap_, gaw1 = *(const u32x4*)(gap_ + 8);
    if (!(skip & 1))
    {   const int t = tid >> 2, cgp = tid & 3, ch0 = hd * 64 + cgp * 16;
        f32x4 xc[4];
#pragma unroll
        for (int i = 0; i < 4; ++i) xc[i] = *(const f32x4*)(p->in[10] + ch0 + 4 * i);
#pragma unroll
        for (int j = 0; j < 4; ++j) {
            f32x4 xv[4] = {{0.f, 0.f, 0.f, 0.f}, {0.f, 0.f, 0.f, 0.f}, {0.f, 0.f, 0.f, 0.f}, {0.f, 0.f, 0.f, 0.f}};
            const bf16_t* src = nullptr; const float* srcf = nullptr;
            if (!samp) { const int pos = c * 128 + t - 3 + j; if (pos >= 0) src = Z + (size_t)(b * 2048 + pos) * 2048 + ch0; }
            else { const int q = sc * 32 + (t >> 2), idx = (t & 3) + j; if (idx < 3) srcf = p->in[5] + ((size_t)q * 3 + idx) * 512 + ch0; else src = Z + (size_t)(NP + 4 * q + idx - 3) * 2048 + ch0; }
            if (src) { const u32x4 w0 = *(const u32x4*)src, w1 = *(const u32x4*)(src + 8); unpack8(w0, xv[0], xv[1]); unpack8(w1, xv[2], xv[3]); }
            else if (srcf) {
#pragma unroll
                for (int i = 0; i < 4; ++i) xv[i] = *(const f32x4*)(srcf + 4 * i); }
#pragma unroll
            for (int i = 0; i < 4; ++i) xc[i] += *(const f32x4*)(p->in[9] + j * 512 + ch0 + 4 * i) * xv[i];
            if (j == 3) {
                float* op = nullptr;
                if (!samp) { if (c == 15 && t >= 125) op = p->out + O_CP + (size_t)(b * 3 + t - 125) * 512 + ch0; }
                else { const int q = sc * 32 + (t >> 2), pos = t & 3; if (pos >= 1) op = p->out + O_CS + (size_t)(q * 3 + pos - 1) * 512 + ch0; }
                if (op) {
#pragma unroll
                    for (int i = 0; i < 4; ++i) *(f32x4*)(op + 4 * i) = xv[i]; }
            }
        }
        *(LAS u32x4*)(xcb + t * 72 + cgp * 16) = pack8(xc[0], xc[1]);
        *(LAS u32x4*)(xcb + t * 72 + cgp * 16 + 8) = pack8(xc[2], xc[3]);
    }
    __syncthreads();
    if (!(skip & 2))
    {   const int fr = lane & 15, fq = lane >> 4;
        bf16x8 af[2];
#pragma unroll
        for (int ks = 0; ks < 2; ++ks) af[ks] = *(const LAS bf16x8*)(xcb + (16 * wave + fr) * 72 + 32 * ks + 8 * fq);
        LAS const bf16_t* WgL = (LAS const bf16_t*)(lds + 98304);
        f32x4 acc[8];
#pragma unroll
        for (int nb = 0; nb < 8; ++nb) { acc[nb] = (f32x4){0.f, 0.f, 0.f, 0.f};
#pragma unroll
            for (int ks = 0; ks < 2; ++ks) { const bf16x8 bb = *(const LAS bf16x8*)(WgL + (16 * nb + fr) * 72 + 32 * ks + 8 * fq);
                acc[nb] = __builtin_amdgcn_mfma_f32_16x16x32_bf16(af[ks], bb, acc[nb], 0, 0, 0); } }
#pragma unroll
        for (int nb = 0; nb < 4; ++nb) {
            const int ch = 16 * nb + fr, chg = hd * 64 + ch;
            const float ba = p->in[12][chg], bx = p->in[14][chg], sp = ((const float*)(ws + OFF_SP))[chg];
#pragma unroll
            for (int j = 0; j < 4; ++j) {
                const int tok = 16 * wave + 4 * fq + j;
                const float rg = sigmoidf_(acc[nb][j] + ba), ig = sigmoidf_(acc[nb + 4][j] + bx);
                const float la = -8.0f * rg * sp;
                const float a = __builtin_amdgcn_exp2f(1.4426950409f * la);
                float mult = __builtin_amdgcn_sqrtf((1.0f - a) * (1.0f + a));
                if (!samp && c == 0 && tok == 0) mult = 1.0f;
                const float xcv = bf2f(xcb[tok * 72 + ch]);
                aS[tok * 68 + ch] = a; uS[tok * 68 + ch] = xcv * ig * mult;
            }
        }
    }
    __syncthreads();
    if (samp) {
        const int ch = lane;
#pragma unroll
        for (int s4 = 0; s4 < 4; ++s4) {
            const int q = sc * 32 + wave * 4 + s4;
            float h = p->in[4][(size_t)q * 512 + hd * 64 + ch];
#pragma unroll
            for (int i = 0; i < 4; ++i) { const int tok = 16 * wave + 4 * s4 + i; h = aS[tok * 68 + ch] * h + uS[tok * 68 + ch]; uS[tok * 68 + ch] = h; }
            p->out[O_HS + (size_t)q * 512 + hd * 64 + ch] = h;
        }
        __syncthreads();
    } else {
        {   const int ch = lane; float P = 1.f, S = 0.f;
#pragma unroll
            for (int i = 0; i < 16; ++i) { const int o = (16 * wave + i) * 68 + ch; const float a = aS[o]; S = a * S + uS[o]; P *= a; uS[o] = S; aS[o] = P; }
            Pseg[wave * 64 + ch] = P; Sseg[wave * 64 + ch] = S; }
        __syncthreads();
        if (wave == 0) {
            const int ch = lane;
            float Pc = 1.f, Sc = 0.f;
#pragma unroll
            for (int s = 0; s < 8; ++s) { const float P = Pseg[s * 64 + ch]; Sc = P * Sc + Sseg[s * 64 + ch]; Pc *= P; }
            unsigned long long* AGG = (unsigned long long*)(ws + OFF_AGG);
            if (c < 15 && !(skip & 3)) __hip_atomic_store(AGG + (size_t)task * 64 + ch, ((unsigned long long)__float_as_uint(Sc) << 32) | (unsigned long long)(__float_as_uint(Pc) | 0x80000000u), __ATOMIC_RELAXED, __HIP_MEMORY_SCOPE_AGENT);
            float h = 0.f;
            if (c > 0 && !(skip & 4)) {
                unsigned long long gv[15];
#pragma unroll
                for (int j = 0; j < 15; ++j) gv[j] = 1ull;
                unsigned sp = 0;
                for (;;) {
                    bool miss = false;
#pragma unroll
                    for (int j = 0; j < 15; ++j) if (j < c) { gv[j] = __hip_atomic_load(AGG + (size_t)(j * 64 + b * 8 + hd) * 64 + ch, __ATOMIC_RELAXED, __HIP_MEMORY_SCOPE_AGENT); }
#pragma unroll
                    for (int j = 0; j < 15; ++j) miss |= (gv[j] == 0ull);
                    if (__builtin_amdgcn_ballot_w64(miss) == 0ull) break;
                    __builtin_amdgcn_s_sleep(2); if (++sp > (1u << 20)) break;
                }
#pragma unroll
                for (int j = 0; j < 15; ++j) if (j < c) h = __uint_as_float((unsigned)gv[j] & 0x7fffffffu) * h + __uint_as_float((unsigned)(gv[j] >> 32));
            }
#pragma unroll
            for (int s = 0; s < 8; ++s) { hin[s * 64 + ch] = h; h = Pseg[s * 64 + ch] * h + Sseg[s * 64 + ch]; }
            if (c == 15) p->out[O_HP + (size_t)b * 512 + hd * 64 + ch] = h;
        }
        __syncthreads();
    }
    if (!(skip & 8))
    {   const int t = tid >> 2, part = tid & 3, row = R0 + t;
        f32x4 g[4]; unpack8(gaw0, g[0], g[1]); unpack8(gaw1, g[2], g[3]);
        float ss = 0.f;
#pragma unroll
        for (int i = 0; i < 4; ++i) { f32x4 h = *(const LAS f32x4*)(uS + t * 68 + part * 16 + 4 * i);
            if (!samp) h += *(const LAS f32x4*)(aS + t * 68 + part * 16 + 4 * i) * *(const LAS f32x4*)(hin + (t >> 4) * 64 + part * 16 + 4 * i);
            g[i] *= h; ss += sq4(g[i]); }
        ss += __shfl_xor(ss, 1); ss += __shfl_xor(ss, 2);
        if (part == 0) ((float*)(ws + OFF_SSQY))[(size_t)row * 16 + hd] = ss;
        bf16_t* yp = (bf16_t*)(ws + OFF_Y) + (size_t)row * 1024 + hd * 64 + part * 16;
        *(u32x4*)yp = pack8(g[0], g[1]); *(u32x4*)(yp + 8) = pack8(g[2], g[3]);
    }
    __syncthreads();
}

__device__ __forceinline__ void p2_taskB(KP p, LAS unsigned char* lds, int idx) {
    int tid_ = threadIdx.x; asm volatile("" : "+v"(tid_));
    const int tid = tid_, lane = tid & 63, wave = tid >> 6;
    unsigned char* ws = p->ws;
    const int chunk = idx >> 2, hb = idx & 3, R0 = chunk * 128;
    const bf16_t* Z = (const bf16_t*)(ws + OFF_Z);
    LAS bf16_t* vnT = (LAS bf16_t*)lds;
    {   const int s = tid >> 2, dg = tid & 3;
        float m_, r_;
        {   const float* lp = (const float*)(ws + OFF_LNSTAT) + (size_t)(R0 + s) * 16;
            float s1 = 0.f, s2 = 0.f;
#pragma unroll
            for (int i = 0; i < 4; ++i) { const f32x4 v = *(const f32x4*)(lp + 4 * i); s1 += v[0] + v[2]; s2 += v[1] + v[3]; }
            m_ = s1 * (1.0f / 512.0f); r_ = rsqrtf(s2 * (1.0f / 512.0f) - m_ * m_ + EPS); }
        const bf16_t* gp = Z + (size_t)(R0 + s) * 2048 + 1536 + hb * 128 + dg * 32;
#pragma unroll
        for (int q8 = 0; q8 < 4; ++q8) {
            f32x4 g0, g1; unpack8(*(const u32x4*)(gp + 8 * q8), g0, g1);
            const int d0 = dg * 32 + 8 * q8;
            const f32x4 lg0 = *(const f32x4*)(p->in[17] + hb * 128 + d0), lg1 = *(const f32x4*)(p->in[17] + hb * 128 + d0 + 4);
            const f32x4 lb0 = *(const f32x4*)(p->in[18] + hb * 128 + d0), lb1 = *(const f32x4*)(p->in[18] + hb * 128 + d0 + 4);
            g0 = (g0 - m_) * r_ * lg0 + lb0; g1 = (g1 - m_) * r_ * lg1 + lb1;
#pragma unroll
            for (int e = 0; e < 4; ++e) { vnT[(d0 + e) * 136 + s] = (bf16_t)(cvt_pk_bf16(g0[e], 0.f) & 0xffffu); vnT[(d0 + 4 + e) * 136 + s] = (bf16_t)(cvt_pk_bf16(g1[e], 0.f) & 0xffffu); }
        } }
    __syncthreads();
    {   const int fr = lane & 15, fq = lane >> 4, t = 16 * wave + fr, row = R0 + t;
        const bf16_t* W = (const bf16_t*)(ws + OFF_WSGU) + hb * 16384;
        f32x4 acc[8]; u32x2 gwv[8];
        const float bs = p->in[20][hb * 128 + t];
#pragma unroll
        for (int nb = 0; nb < 8; ++nb) { acc[nb] = (f32x4){0.f, 0.f, 0.f, 0.f}; gwv[nb] = *(const u32x2*)(Z + (size_t)row * 2048 + 1024 + hb * 128 + 16 * nb + 4 * fq); }
        for (int ks = 0; ks <= (wave >> 1); ++ks) {
            const bf16x8 wf = *(const bf16x8*)(W + t * 128 + 32 * ks + 8 * fq);
#pragma unroll
            for (int nb = 0; nb < 8; ++nb) { const bf16x8 vf = *(const LAS bf16x8*)(vnT + (16 * nb + fr) * 136 + 32 * ks + 8 * fq);
                acc[nb] = __builtin_amdgcn_mfma_f32_16x16x32_bf16(vf, wf, acc[nb], 0, 0, 0); } }
        float ss = 0.f;
#pragma unroll
        for (int nb = 0; nb < 8; ++nb) { const int d0 = hb * 128 + 16 * nb + 4 * fq; const u32x2 gw = gwv[nb];
            f32x4 v = (f32x4){bflo(gw.x), bfhi(gw.x), bflo(gw.y), bfhi(gw.y)} * (acc[nb] + bs);
            ss += sq4(v);
            *(u32x2*)((bf16_t*)(ws + OFF_Y) + (size_t)row * 1024 + 512 + d0) = (u32x2){cvt_pk_bf16(v[0], v[1]), cvt_pk_bf16(v[2], v[3])}; }
        ss = red_fq(ss);
        if (fq == 0) ((float*)(ws + OFF_SSQY))[(size_t)row * 16 + 8 + hb] = ss;
    }
    __syncthreads();
}
__device__ __forceinline__ void p2_taskBs(KP p, int q) {
    const int lane = threadIdx.x & 63, hb = lane >> 4;
    unsigned char* ws = p->ws;
    const bf16_t* Z = (const bf16_t*)(ws + OFF_Z);
    const f32x4 lg0 = *(const f32x4*)(p->in[17] + 8 * lane), lg1 = *(const f32x4*)(p->in[17] + 8 * lane + 4), lb0 = *(const f32x4*)(p->in[18] + 8 * lane), lb1 = *(const f32x4*)(p->in[18] + 8 * lane + 4);
    f32x4 vn[4][2];
#pragma unroll
    for (int t = 0; t < 4; ++t) {
        const int row = NP + 4 * q + t;
        const float* lp = (const float*)(ws + OFF_LNSTAT) + (size_t)row * 16;
        float s1 = 0.f, s2 = 0.f;
#pragma unroll
        for (int i = 0; i < 4; ++i) { const f32x4 v = *(const f32x4*)(lp + 4 * i); s1 += v[0] + v[2]; s2 += v[1] + v[3]; }
        const float mean = s1 * (1.0f / 512.0f), var = s2 * (1.0f / 512.0f) - mean * mean, r_ = rsqrtf(var + EPS);
        f32x4 g0, g1; unpack8(*(const u32x4*)(Z + (size_t)row * 2048 + 1536 + 8 * lane), g0, g1);
        vn[t][0] = (g0 - mean) * r_ * lg0 + lb0; vn[t][1] = (g1 - mean) * r_ * lg1 + lb1;
        float* op = p->out + O_VS + (size_t)(q * 4 + t) * 512 + 8 * lane;
        *(f32x4*)op = vn[t][0]; *(f32x4*)(op + 4) = vn[t][1];
    }
#pragma unroll
    for (int t = 0; t < 4; ++t) {
        const int row = NP + 4 * q + t;
        const float bs = p->in[20][hb * 128 + t];
        f32x4 m0 = {bs, bs, bs, bs}, m1 = m0;
#pragma unroll
        for (int s = 0; s <= t; ++s) { const float w = p->in[19][(size_t)(hb * 128 + t) * 128 + s]; m0 += w * vn[s][0]; m1 += w * vn[s][1]; }
        f32x4 g0, g1; unpack8(*(const u32x4*)(Z + (size_t)row * 2048 + 1024 + 8 * lane), g0, g1);
        g0 *= m0; g1 *= m1;
        float ss = sq4(g0) + sq4(g1);
        ss += __shfl_xor(ss, 1); ss += __shfl_xor(ss, 2); ss += __shfl_xor(ss, 4); ss += __shfl_xor(ss, 8);
        if ((lane & 15) == 0) ((float*)(ws + OFF_SSQY))[(size_t)row * 16 + 8 + hb] = ss;
        *(u32x4*)((bf16_t*)(ws + OFF_Y) + (size_t)row * 1024 + 512 + 8 * lane) = pack8(g0, g1);
    }
}
__device__ __forceinline__ void p2_phase(KP p, LAS unsigned char* lds, int lo = 0, int hi = 1584, int skip = 0) {
    int cur_hd = -1;
    const int bfirst = blockIdx.x & 1; int npass = 2; asm volatile("" : "+s"(npass));
    for (int pass = 0; pass < npass; ++pass)
    for (int task = blockIdx.x; task < 1584; task += gridDim.x) {
        if (task < lo || task >= hi) continue;
        if (((task < 1056) ? 1 : 0) != (pass ^ bfirst ^ 1)) continue;
        if (task < 1056 && (task & 7) != cur_hd) {
            cur_hd = task & 7;
            const bf16_t* Wg = (const bf16_t*)(p->ws + OFF_WG) + cur_hd * 8192;
            __syncthreads();
            for (int i = threadIdx.x; i < 1024; i += 512) { const int n = i >> 3, k8 = i & 7; *(LAS u32x4*)((LAS bf16_t*)(lds + 98304) + n * 72 + k8 * 8) = *(const u32x4*)(Wg + n * 64 + k8 * 8); }
            __syncthreads();
        }
        if (task < 1056) p2_taskA(p, lds, task, skip);
        else if (task < 1568) p2_taskB(p, lds, task - 1056);
        else p2_taskBs(p, (task - 1568) * 8 + (threadIdx.x >> 6));
    }
}

__device__ __forceinline__ f32x4 ld_bf4(const bf16_t* q) { const u32x2 w = *(const u32x2*)q; return (f32x4){bflo(w.x), bfhi(w.x), bflo(w.y), bfhi(w.y)}; }
__device__ __forceinline__ void p4b_tile(KP p, int pm) {
    unsigned char* ws = p->ws;
    const bf16_t* halo = (const bf16_t*)(ws + OFF_HALO); bf16_t* ACT = (bf16_t*)(ws + OFF_ACT);
    const float* cw = p->in[25]; const float* cb = p->in[26];
    for (int jj = threadIdx.x; jj < 768; jj += 512) {
        const int j = jj * 4;
        const f32x4 bg = *(const f32x4*)(cb + j), w0g = *(const f32x4*)(cw + j), w1g = *(const f32x4*)(cw + 6144 + j), w2g = *(const f32x4*)(cw + 12288 + j);
        const f32x4 bv = *(const f32x4*)(cb + 3072 + j), w0v = *(const f32x4*)(cw + 3072 + j), w1v = *(const f32x4*)(cw + 6144 + 3072 + j), w2v = *(const f32x4*)(cw + 12288 + 3072 + j);
#pragma unroll
        for (int gl = 0; gl < 4; ++gl) {
            const int g = pm * 4 + gl; const bool first = (g & 31) == 0;
            const f32x4 z4 = {0.f, 0.f, 0.f, 0.f};
            const bf16_t* hb = halo + (size_t)(g * 4) * 6144 + j; const bf16_t* tb = halo + (size_t)((g - 1) * 4 + 2) * 6144 + j;
            const f32x4 h0g = ld_bf4(hb), h1g = ld_bf4(hb + 6144), h0v = ld_bf4(hb + 3072), h1v = ld_bf4(hb + 6144 + 3072);
            const f32x4 t0g = first ? z4 : ld_bf4(tb), t1g = first ? z4 : ld_bf4(tb + 6144), t0v = first ? z4 : ld_bf4(tb + 3072), t1v = first ? z4 : ld_bf4(tb + 6144 + 3072);
            {   const f32x4 og = bg + w0g * t0g + w1g * t1g + w2g * h0g, ov = bv + w0v * t0v + w1v * t1v + w2v * h0v;
                *(u32x2*)(ACT + (size_t)(g * 64) * 3072 + j) = (u32x2){cvt_pk_bf16(gelu_t(og[0]) * ov[0], gelu_t(og[1]) * ov[1]), cvt_pk_bf16(gelu_t(og[2]) * ov[2], gelu_t(og[3]) * ov[3])}; }
            {   const f32x4 og = bg + w0g * t1g + w1g * h0g + w2g * h1g, ov = bv + w0v * t1v + w1v * h0v + w2v * h1v;
                *(u32x2*)(ACT + (size_t)(g * 64 + 1) * 3072 + j) = (u32x2){cvt_pk_bf16(gelu_t(og[0]) * ov[0], gelu_t(og[1]) * ov[1]), cvt_pk_bf16(gelu_t(og[2]) * ov[2], gelu_t(og[3]) * ov[3])}; }
        }
    }
}
__device__ __forceinline__ void p7_phase(KP p, int row_lo) {
    const int lane = threadIdx.x & 63, wave = threadIdx.x >> 6;
    const float* ssq = (const float*)(p->ws + OFF_SSQ3); const bf16_t* H3 = (const bf16_t*)(p->ws + OFF_H3);
    f32x4 gf[4];
#pragma unroll
    for (int i = 0; i < 2; ++i) { gf[2 * i] = *(const f32x4*)(p->in[31] + i * 512 + lane * 8); gf[2 * i + 1] = *(const f32x4*)(p->in[31] + i * 512 + lane * 8 + 4); }
    for (int r = row_lo + blockIdx.x * 8 + wave; r < NT; r += gridDim.x * 8) {
        const float rs = rsqrtf(sum16(ssq + (size_t)r * 16) * (1.0f / 1024.0f) + EPS);
        float* op = p->out + (size_t)r * 1024;
#pragma unroll
        for (int i = 0; i < 2; ++i) { f32x4 a, b; unpack8(*(const u32x4*)(H3 + (size_t)r * 1024 + i * 512 + lane * 8), a, b);
            *(f32x4*)(op + i * 512 + lane * 8) = a * rs * gf[2 * i]; *(f32x4*)(op + i * 512 + lane * 8 + 4) = b * rs * gf[2 * i + 1]; }
    }
}

__device__ __forceinline__ bool st_map(int i, int nct, int& rt, int& ct) {
    const int b = blockIdx.x;
    if (gridDim.x == 256) {
        const int xcd = b & 7, slot = b >> 3, cl = slot >> 3;
        rt = slot & 7;
        if (nct >= 32) { ct = i * 32 + xcd * 4 + cl; return ct < nct; }
        ct = xcd * 2 + cl; return i == 0 && cl < 2;
    }
    const int idx = i * gridDim.x + b; rt = idx & 7; ct = idx >> 3; return ct < nct;
}
#define ST_IDX(nct_) const int r = threadIdx.x >> 3, c = threadIdx.x & 7; (void)r; (void)c; int rt, ct; for (int it_ = 0; st_map(it_, (nct_), rt, ct); ++it_)
__device__ __forceinline__ void p1_small(KP p, LAS unsigned char* lds) {
    unsigned char* ws = p->ws;
    ST_IDX(32) {
        const int arow0 = NP + 64 * rt;
        const TileP T = st_tile((const bf16_t*)(ws + OFF_XB), 1024, arow0, (const bf16_t*)(ws + OFF_WIN), 1024, 64 * ct, 64 * ct + 16, 64 * ct + 32, 64 * ct + 48, 1024);
        Frags<4> F; st_load(F, T, 0);
        const int row = arow0 + r, col = 64 * ct + 8 * c, kind = ct >> 3;
        const float rs = ((const float*)(ws + OFF_RSTD1))[row];
        f32x4 acc[4][4]; st_zero(acc); st_mma(acc, F);
        f32x4 lo0, lo1, hi0, hi1; st_reduce(lds, acc, lo0, lo1, hi0, hi1);
        f32x4 v0 = lo0 + hi0, v1 = lo1 + hi1; float s1 = 0.f, s2 = 0.f;
        seg_z(kind, rs, v0, v1, s1, s2);
        *(u32x4*)((bf16_t*)(ws + OFF_Z) + (size_t)row * 2048 + col) = pack8(v0, v1);
        if (kind == 3) { s1 = red8(s1); s2 = red8(s2); if (c == 0) *(f32x2*)((float*)(ws + OFF_LNSTAT) + (size_t)row * 16 + (ct - 24) * 2) = (f32x2){s1, s2}; }
    }
}
__device__ __forceinline__ void p3_small(KP p, LAS unsigned char* lds) {
    unsigned char* ws = p->ws;
    ST_IDX(16) {
        const int arow0 = NP + 64 * rt;
        const TileP T = st_tile((const bf16_t*)(ws + OFF_Y), 1024, arow0, (const bf16_t*)(ws + OFF_WOUT), 1024, 64 * ct, 64 * ct + 16, 64 * ct + 32, 64 * ct + 48, 1024);
        Frags<4> F; st_load(F, T, 0);
        const int row = arow0 + r; const float* sp = (const float*)(ws + OFF_SSQY) + (size_t)row * 16;
        const f32x4 q0 = *(const f32x4*)sp, q1 = *(const f32x4*)(sp + 4), q2 = *(const f32x4*)(sp + 8);
        const size_t o = (size_t)row * 1024 + 64 * ct + 8 * c;
        const u32x4 xw = *(const u32x4*)((const bf16_t*)(ws + OFF_XB) + o);
        f32x4 acc[4][4]; st_zero(acc); st_mma(acc, F);
        f32x4 lo0, lo1, hi0, hi1; st_reduce(lds, acc, lo0, lo1, hi0, hi1);
        const float ra = rsqrtf((sum4(q0) + sum4(q1)) * (1.0f / 512.0f) + EPS), rb = rsqrtf(sum4(q2) * (1.0f / 512.0f) + EPS);
        f32x4 x0, x1; unpack8(xw, x0, x1);
        const f32x4 h0 = x0 + lo0 * ra + hi0 * rb, h1 = x1 + lo1 * ra + hi1 * rb;
        *(u32x4*)((bf16_t*)(ws + OFF_R3) + o) = pack8(h0, h1);
        const float ss = red8(sq4(h0) + sq4(h1));
        if (c == 0) ((float*)(ws + OFF_SSQ1))[(size_t)row * 16 + ct] = ss;
    }
}
__device__ __forceinline__ void p5_small(KP p, LAS unsigned char* lds, int mode = 0) {
    unsigned char* ws = p->ws;
    int tid_ = threadIdx.x; asm volatile("" : "+v"(tid_));
    const int tid = tid_, wave = tid >> 6, lane = tid & 63, fr = lane & 15, fq = lane >> 4;
    for (int idx = blockIdx.x; idx < 256; idx += gridDim.x) {
        int rt, ct;
        if (gridDim.x == 256) { const int xcd = idx & 7, slot = idx >> 3; rt = slot & 15; ct = xcd * 2 + (slot >> 4); } else { rt = idx & 15; ct = idx >> 4; }
        const int arow0 = NP + 32 * rt;
        const bf16_t* ap = (const bf16_t*)(ws + OFF_ACT) + (size_t)(arow0 + fr) * 3072 + wave * 384 + 8 * fq;
        const bf16_t* bp = (const bf16_t*)(ws + OFF_WDN) + (size_t)(64 * ct + fr) * 3072 + wave * 384 + 8 * fq;
        bf16x8 a0[2][2], b0[2][4], a1[2][2], b1[2][4];
#define P5S_LOAD(A_, B_, s0) do { _Pragma("unroll") for (int s = 0; s < 2; ++s) { _Pragma("unroll") for (int i = 0; i < 2; ++i) A_[s][i] = *(const bf16x8*)(ap + (size_t)(16 * i) * 3072 + ((s0) + s) * 32); \
            _Pragma("unroll") for (int j = 0; j < 4; ++j) B_[s][j] = *(const bf16x8*)(bp + (size_t)(16 * j) * 3072 + ((s0) + s) * 32); } } while (0)
#define P5S_MMA(A_, B_) do { _Pragma("unroll") for (int s = 0; s < 2; ++s) _Pragma("unroll") for (int i = 0; i < 2; ++i) _Pragma("unroll") for (int j = 0; j < 4; ++j) \
            acc[i][j] = __builtin_amdgcn_mfma_f32_16x16x32_bf16(B_[s][j], A_[s][i], acc[i][j], 0, 0, 0); } while (0)
        P5S_LOAD(a0, b0, 0); P5S_LOAD(a1, b1, 2);
        const int r = tid >> 4, c4 = tid & 15, row = arow0 + r;
        bf16_t* hp = (bf16_t*)(ws + OFF_R3) + (size_t)row * 1024 + 64 * ct + 4 * c4;
        const u32x2 xw = *(const u32x2*)hp;
        f32x4 acc[2][4];
#pragma unroll
        for (int i = 0; i < 2; ++i)
#pragma unroll
            for (int j = 0; j < 4; ++j) acc[i][j] = (f32x4){0.f, 0.f, 0.f, 0.f};
#pragma unroll
        for (int s0 = 0; s0 < 12; s0 += 4) { P5S_MMA(a0, b0); if (s0 + 4 < 12) P5S_LOAD(a0, b0, s0 + 4); P5S_MMA(a1, b1); if (s0 + 6 < 12) P5S_LOAD(a1, b1, s0 + 6); }
#undef P5S_LOAD
#undef P5S_MMA
        LAS float* P = (LAS float*)lds + wave * 2048;
#pragma unroll
        for (int i = 0; i < 2; ++i)
#pragma unroll
            for (int j = 0; j < 4; ++j) { const int rr = 16 * i + fr, ch = (4 * j + fq) ^ fr; *(LAS f32x4*)(P + rr * 64 + ch * 4) = acc[i][j]; }
        __syncthreads();
        f32x4 sum = {0.f, 0.f, 0.f, 0.f};
        {   LAS const float* Q = (LAS const float*)lds + r * 64 + ((c4 ^ (r & 15)) * 4);
#pragma unroll
            for (int w = 0; w < 8; ++w) sum += *(LAS const f32x4*)(Q + w * 2048); }
        __syncthreads();
        const f32x4 h = (f32x4){bflo(xw.x), bfhi(xw.x), bflo(xw.y), bfhi(xw.y)} + sum;
        float ss = sq4(h); ss += __shfl_xor(ss, 1); ss += __shfl_xor(ss, 2); ss += __shfl_xor(ss, 4); ss += __shfl_xor(ss, 8);
        if (mode) { asm volatile("" :: "v"(ss), "v"(h[0])); continue; }
        *(u32x2*)hp = (u32x2){cvt_pk_bf16(h[0], h[1]), cvt_pk_bf16(h[2], h[3])};
        if (c4 == 0) ((float*)(ws + OFF_SSQ2))[(size_t)row * 16 + ct] = ss;
    }
}
__device__ __forceinline__ void p6_small(KP p, LAS unsigned char* lds, bool fuse) {
    unsigned char* ws = p->ws;
    ST_IDX(16) {
        const int arow0 = NP + 64 * rt;
        const TileP T = st_tile((const bf16_t*)(ws + OFF_R3), 1024, arow0, (const bf16_t*)(ws + OFF_WPG), 1024, 64 * ct, 64 * ct + 16, 64 * ct + 32, 64 * ct + 48, 1024);
        Frags<4> F; st_load(F, T, 0);
        const int row = arow0 + r; const float* sp = (const float*)(ws + OFF_SSQ2) + (size_t)row * 16;
        const f32x4 q0 = *(const f32x4*)sp, q1 = *(const f32x4*)(sp + 4), q2 = *(const f32x4*)(sp + 8), q3 = *(const f32x4*)(sp + 12);
        const size_t o = (size_t)row * 1024 + 64 * ct + 8 * c;
        const u32x4 ew = *(const u32x4*)((const bf16_t*)(ws + OFF_E) + o), xw = *(const u32x4*)((const bf16_t*)(ws + OFF_R3) + o);
        f32x4 acc[4][4]; st_zero(acc); st_mma(acc, F);
        f32x4 lo0, lo1, hi0, hi1; st_reduce(lds, acc, lo0, lo1, hi0, hi1);
        const float rs = rsqrtf(((sum4(q0) + sum4(q1)) + (sum4(q2) + sum4(q3))) * (1.0f / 1024.0f) + EPS);
        f32x4 e0, e1, x0, x1; unpack8(ew, e0, e1); unpack8(xw, x0, x1);
        f32x4 g0 = (lo0 + hi0) * rs, g1 = (lo1 + hi1) * rs;
#pragma unroll
        for (int e = 0; e < 4; ++e) { g0[e] = sigmoidf_(g0[e]); g1[e] = sigmoidf_(g1[e]); }
        const f32x4 h0 = x0 + e0 * g0, h1 = x1 + e1 * g1;
        const float ss = red8(sq4(h0) + sq4(h1));
        if (!fuse) {
            *(u32x4*)((bf16_t*)(ws + OFF_H3) + o) = pack8(h0, h1);
            if (c == 0) ((float*)(ws + OFF_SSQ3))[(size_t)row * 16 + ct] = ss;
        } else {
            float* X2 = (float*)(ws + OFF_SSQ3) + 65536 + (size_t)rt * 1024;
            unsigned* cnt2 = (unsigned*)(ws + OFF_FLAG) + 1016 + rt;
            if (c == 0) __hip_atomic_store((unsigned*)(X2 + ct * 64 + r), __float_as_uint(ss), __ATOMIC_RELAXED, __HIP_MEMORY_SCOPE_AGENT);
            asm volatile("s_waitcnt vmcnt(0)" ::: "memory");
            __syncthreads();
            if (threadIdx.x == 0) { __hip_atomic_fetch_add(cnt2, 1u, __ATOMIC_RELAXED, __HIP_MEMORY_SCOPE_AGENT); unsigned sp = 0;
                while (__hip_atomic_load(cnt2, __ATOMIC_RELAXED, __HIP_MEMORY_SCOPE_AGENT) < 16u) { __builtin_amdgcn_s_sleep(1); if (++sp > (1u << 22)) break; } }
            __syncthreads();
            float tot = __uint_as_float(__hip_atomic_load((const unsigned*)(X2 + (2 * c) * 64 + r), __ATOMIC_RELAXED, __HIP_MEMORY_SCOPE_AGENT))
                      + __uint_as_float(__hip_atomic_load((const unsigned*)(X2 + (2 * c + 1) * 64 + r), __ATOMIC_RELAXED, __HIP_MEMORY_SCOPE_AGENT));
            tot = red8(tot);
            const float r4 = rsqrtf(tot * (1.0f / 1024.0f) + EPS);
            const int col = 64 * ct + 8 * c;
            float* yp = p->out + O_Y + (size_t)row * 1024 + col;
            *(f32x4*)yp = h0 * r4 * *(const f32x4*)(p->in[31] + col); *(f32x4*)(yp + 4) = h1 * r4 * *(const f32x4*)(p->in[31] + col + 4);
        }
    }
}
__device__ __forceinline__ void p4s_issue(unsigned char* ws, int rt, int s96, Frags<4>& F, int& arow0, int& jc0) {
    const int pn = s96 >> 2, s = s96 & 3, nb = 256 * pn + 32 * s;
    arow0 = NP + 64 * rt; jc0 = 128 * pn + 32 * s;
    const TileP T = st_tile((const bf16_t*)(ws + OFF_R3), 1024, arow0, (const bf16_t*)(ws + OFF_WUP), 1024, nb, nb + 16, nb + 128, nb + 144, 1024);
    st_load(F, T, 0);
}
__device__ __forceinline__ void pe_small(KP p, LAS unsigned char* lds) {
    unsigned char* ws = p->ws;
    ST_IDX(16) {
        const int arow0 = NP + 64 * rt;
        const TileP T = st_tile((const bf16_t*)(ws + OFF_PB), 256, arow0, (const bf16_t*)(ws + OFF_WPLE), 256, 64 * ct, 64 * ct + 16, 64 * ct + 32, 64 * ct + 48, 256);
        Frags<1> F; st_load(F, T, 0);
        f32x4 acc[4][4]; st_zero(acc); st_mma(acc, F);
        f32x4 lo0, lo1, hi0, hi1; st_reduce(lds, acc, lo0, lo1, hi0, hi1);
        *(u32x4*)((bf16_t*)(ws + OFF_E) + (size_t)(arow0 + r) * 1024 + 64 * ct + 8 * c) = pack8(lo0 + hi0, lo1 + hi1);
    }
}
__device__ __forceinline__ void p4_small(KP p, LAS unsigned char* lds, int mode = 0) {
    unsigned char* ws = p->ws; const int r = threadIdx.x >> 3, c = threadIdx.x & 7;
    const float* cw = p->in[25]; const float* cb = p->in[26]; const float* st = p->in[6];
    int it = 0, rt, ct; if (!st_map(0, 96, rt, ct)) return;
    Frags<4> F; int arow0, jc0; p4s_issue(ws, rt, ct, F, arow0, jc0);
    for (;;) {
        const int row = arow0 + r;
        const float rs = rsqrtf(sum16((const float*)(ws + OFF_SSQ1) + (size_t)row * 16) * (1.0f / 1024.0f) + EPS);
        f32x4 acc[4][4]; st_zero(acc); st_mma(acc, F);
        const bool more = st_map(it + 1, 96, rt, ct);
        int narow0 = 0, njc0 = 0; if (more) p4s_issue(ws, rt, ct, F, narow0, njc0);
        f32x4 lo0, lo1, hi0, hi1;
        if (mode == 2) { lo0 = acc[0][0]; lo1 = acc[0][1]; hi0 = acc[1][0]; hi1 = acc[1][1]; } else st_reduce(lds, acc, lo0, lo1, hi0, hi1);
        if (mode == 1) { asm volatile("" :: "v"(lo0[0] + lo1[0] + hi0[0] + hi1[0])); } else {
            LAS float* U = (LAS float*)lds;
            *(LAS f32x4*)(U + r * 68 + 8 * c) = (lo0 + hi0) * rs; *(LAS f32x4*)(U + r * 68 + 8 * c + 4) = (lo1 + hi1) * rs;
            __syncthreads();
            {   const int jc = jc0 + 4 * c, t = r & 3, q = (row - NP) >> 2;
                const f32x4 cg = *(LAS const f32x4*)(U + r * 68 + 4 * c), cv = *(LAS const f32x4*)(U + r * 68 + 32 + 4 * c);
                f32x4 x1g, x1v, x2g, x2v;
                if (t >= 1) { x1g = *(LAS const f32x4*)(U + (r - 1) * 68 + 4 * c); x1v = *(LAS const f32x4*)(U + (r - 1) * 68 + 32 + 4 * c); }
                else { x1g = *(const f32x4*)(st + (size_t)(q * 2 + 1) * 6144 + jc); x1v = *(const f32x4*)(st + (size_t)(q * 2 + 1) * 6144 + 3072 + jc); }
                if (t >= 2) { x2g = *(LAS const f32x4*)(U + (r - 2) * 68 + 4 * c); x2v = *(LAS const f32x4*)(U + (r - 2) * 68 + 32 + 4 * c); }
                else { x2g = *(const f32x4*)(st + (size_t)(q * 2 + t) * 6144 + jc); x2v = *(const f32x4*)(st + (size_t)(q * 2 + t) * 6144 + 3072 + jc); }
                const f32x4 og = *(const f32x4*)(cb + jc) + *(const f32x4*)(cw + jc) * x2g + *(const f32x4*)(cw + 6144 + jc) * x1g + *(const f32x4*)(cw + 12288 + jc) * cg;
                const f32x4 ov = *(const f32x4*)(cb + 3072 + jc) + *(const f32x4*)(cw + 3072 + jc) * x2v + *(const f32x4*)(cw + 6144 + 3072 + jc) * x1v + *(const f32x4*)(cw + 12288 + 3072 + jc) * cv;
                const float a0 = gelu_t(og[0]) * ov[0], a1 = gelu_t(og[1]) * ov[1], a2 = gelu_t(og[2]) * ov[2], a3 = gelu_t(og[3]) * ov[3];
                *(u32x2*)((bf16_t*)(ws + OFF_ACT) + (size_t)row * 3072 + jc) = (u32x2){cvt_pk_bf16(a0, a1), cvt_pk_bf16(a2, a3)};
                if (t >= 2) { float* op = p->out + O_FS + (size_t)(q * 2 + t - 2) * 6144 + jc; *(f32x4*)op = cg; *(f32x4*)(op + 3072) = cv; }
            }
            __syncthreads();
        }
        if (!more) break;
        arow0 = narow0; jc0 = njc0; ++it;
    }
}
#ifndef GP1_ALIGN
#define GP1_ALIGN true
#endif
#ifndef GP1_SP2
#define GP1_SP2 true
#endif
#ifndef GP3_ALIGN
#define GP3_ALIGN false
#endif
#ifndef GP3_SP2
#define GP3_SP2 true
#endif
#ifndef GP4_ALIGN
#define GP4_ALIGN true
#endif
#ifndef GP4_SP2
#define GP4_SP2 true
#endif
#ifndef GP5_ALIGN
#define GP5_ALIGN false
#endif
#ifndef GP5_SP2
#define GP5_SP2 true
#endif
#ifndef GPE_ALIGN
#define GPE_ALIGN false
#endif
#ifndef GPE_SP2
#define GPE_SP2 true
#endif
#ifndef GP6_ALIGN
#define GP6_ALIGN false
#endif
#ifndef GP6_SP2
#define GP6_SP2 true
#endif
#ifndef REP
#define REP 0
#endif
#if REP
__device__ __forceinline__ int rep_count(int bit) { int n = ((REP >> bit) & 1) ? 2 : 1; asm volatile("" : "+s"(n)); return n; }
#define REPEAT(bit) for (int nrep_ = rep_count(bit), rep_ = 0; rep_ < nrep_; ++rep_)
#else
#define REPEAT(bit)
#endif
template <class S> __device__ __forceinline__ void fill_tab_rstd(LAS float* tab, const S& sched, const float* ssq, float invn) {
    Unit u; const int r = threadIdx.x & 255;
    for (int i = threadIdx.x >> 8; sched.next(i, u); i += 2) {
        const float* sp = ssq + (size_t)(u.pm * 256 + r) * 16;
        tab[i * 256 + r] = rsqrtf(sum16(sp) * invn + EPS); }
    __syncthreads();
}

__global__ void __launch_bounds__(512) mega(Params p_) {
    KP p = (KP)__builtin_amdgcn_kernarg_segment_ptr();
#define FRESH_P() asm volatile("" : "+s"(p))
    extern __shared__ __attribute__((aligned(16))) unsigned char lds_raw[];
    LAS unsigned char* lds = (LAS unsigned char*)lds_raw;
    const int tid = threadIdx.x, G = gridDim.x, blk = blockIdx.x;
    volatile LAS unsigned* st = (volatile LAS unsigned*)(lds + LDS_X);
    if (tid < 4) st[tid] = 0u;
    __syncthreads();
    unsigned char* ws = p->ws;
    XcdBarrier bar = xcd_barrier_post((unsigned*)(ws + OFF_BAR), st);
    LAS float* tab = (LAS float*)(lds + LDS_X + 256);
#define GRID_BAR() do { if (p_.use_cg) cg::this_grid().sync(); else xcd_barrier(bar); } while (0)

    REPEAT(0) { p0_phase(p, lds); __syncthreads(); }
    GRID_BAR();
    FRESH_P(); ws = p->ws;
    {   pg8::Gemm g{(const bf16_t*)(ws + OFF_XB), (const bf16_t*)(ws + OFF_WIN), NP, 2048, 1024};
        pg8::StaticOrder S; S.init(NP, 2048, G, blk);
        EpiZ E{(bf16_t*)(ws + OFF_Z), (const float*)(ws + OFF_RSTD1), (float*)(ws + OFF_LNSTAT)};
        pg8::gemm_phase<EpiZ, pg8::StaticOrder, GP1_ALIGN, GP1_SP2>(lds, g, S, E);
        p1_small(p, lds);
    }
    GRID_BAR();
    FRESH_P(); ws = p->ws;
#if REP & 4
    { int lo = (PMODE == 1) ? 0 : 1056, hi = (PMODE == 1) ? 1024 : 1568; int sk = PSKIP; asm volatile("" : "+s"(lo), "+s"(hi), "+s"(sk)); p2_phase(p, lds, lo, hi, sk); __syncthreads(); }
#endif
    p2_phase(p, lds);
    GRID_BAR();
    FRESH_P(); ws = p->ws;
    {   pg8::StaticOrder S; S.init(NP, 1024, G, blk);
        LAS f32x2* tab2 = (LAS f32x2*)tab;
        {   Unit u; const float* sq = (const float*)(ws + OFF_SSQY);
            for (int i = 0; S.next(i, u); ++i)
                if (tid < 256) { const float* sp = sq + (size_t)(u.pm * 256 + tid) * 16;
                    const float sa = sum4(*(const f32x4*)sp) + sum4(*(const f32x4*)(sp + 4)), sb = sum4(*(const f32x4*)(sp + 8));
                    const float ra = rsqrtf(sa * (1.0f / 512.0f) + EPS), rb = rsqrtf(sb * (1.0f / 512.0f) + EPS);
                    tab2[i * 256 + tid] = (f32x2){ra / rb, rb}; }
            __syncthreads(); }
        pg8::Gemm g{(const bf16_t*)(ws + OFF_Y), (const bf16_t*)(ws + OFF_WOUT), NP, 1024, 1024};
        EpiH1 E{(const bf16_t*)(ws + OFF_XB), (bf16_t*)(ws + OFF_R3), (float*)(ws + OFF_SSQ1), tab2};
        REPEAT(3) { pg8::gemm_phase<EpiH1, pg8::StaticOrder, GP3_ALIGN, GP3_SP2>(lds, g, S, E); }
        REPEAT(10) { p3_small(p, lds); }
    }
    GRID_BAR();
    FRESH_P(); ws = p->ws;
    {   pg8::StaticOrder S; S.init(NP, 6144, G, blk);
        fill_tab_rstd(tab, S, (const float*)(ws + OFF_SSQ1), 1.0f / 1024.0f);
        pg8::Gemm g{(const bf16_t*)(ws + OFF_R3), (const bf16_t*)(ws + OFF_WUP), NP, 6144, 1024};
        EpiUp E{(bf16_t*)(ws + OFF_ACT), tab, p->in[25], p->in[26], (bf16_t*)(ws + OFF_HALO), p->out + O_FP, 0};
        pg8::gemm_phase<EpiUp, pg8::StaticOrder, GP4_ALIGN, GP4_SP2>(lds, g, S, E);
#if REP & 4096
        { int md = PMODE; asm volatile("" : "+s"(md)); p4_small(p, lds, md); }
#endif
        p4_small(p, lds);
    }
    GRID_BAR();
    FRESH_P(); ws = p->ws;
    {   pg8::StaticOrder S; S.init(NP, 1024, G, blk);
        {   Unit u; int last = -1;
            for (int i = 0; S.next(i, u); ++i) if (u.pm != last) { p4b_tile(p, u.pm); last = u.pm; }
            asm volatile("s_waitcnt vmcnt(0)" ::: "memory"); __syncthreads(); }
        pg8::Gemm g{(const bf16_t*)(ws + OFF_ACT), (const bf16_t*)(ws + OFF_WDN), NP, 1024, 3072};
        EpiH2 E{(bf16_t*)(ws + OFF_R3), (float*)(ws + OFF_SSQ2)};
        pg8::gemm_phase<EpiH2, pg8::StaticOrder, GP5_ALIGN, GP5_SP2>(lds, g, S, E);
#if REP & 8192
        { int md = 1; asm volatile("" : "+s"(md)); p5_small(p, lds, md); }
#endif
        p5_small(p, lds);
        pg8::Gemm g2{(const bf16_t*)(ws + OFF_PB), (const bf16_t*)(ws + OFF_WPLE), NP, 1024, 256};
        pg8::StaticOrder S2; S2.init(NP, 1024, G, blk);
        EpiE E2{(bf16_t*)(ws + OFF_E)};
        REPEAT(11) { pg8::gemm_phase<EpiE, pg8::StaticOrder, GPE_ALIGN, GPE_SP2>(lds, g2, S2, E2); }
        pe_small(p, lds);
    }
    GRID_BAR();
    FRESH_P(); ws = p->ws;
    {   pg8::StaticOrder S; S.init(NP, 1024, G, blk);
        fill_tab_rstd(tab, S, (const float*)(ws + OFF_SSQ2), 1.0f / 1024.0f);
        pg8::Gemm g{(const bf16_t*)(ws + OFF_R3), (const bf16_t*)(ws + OFF_WPG), NP, 1024, 1024};
        if (G == 256) {
            EpiGF E{(const bf16_t*)(ws + OFF_R3), (const bf16_t*)(ws + OFF_E), p->out + O_Y, p->in[31], (float*)(ws + OFF_SSQ3), (unsigned*)(ws + OFF_FLAG), tab};
            pg8::gemm_phase<EpiGF, pg8::StaticOrder, false, GP6_SP2>(lds, g, S, E);
        } else {
            EpiG E{(const bf16_t*)(ws + OFF_R3), (const bf16_t*)(ws + OFF_E), (bf16_t*)(ws + OFF_H3), (float*)(ws + OFF_SSQ3), tab};
            pg8::gemm_phase<EpiG, pg8::StaticOrder, GP6_ALIGN, GP6_SP2>(lds, g, S, E);
        }
        p6_small(p, lds, G == 256);
    }
    if (G != 256) {
        GRID_BAR();
        FRESH_P(); ws = p->ws;
        p7_phase(p, 0);
    }
}

extern "C" void kernel_launch(void* const* d_in, const int* in_sizes, int n_in, void* d_out, int out_size, void* d_ws, size_t ws_size, hipStream_t stream) {
    static int grid = 0;
    if (grid == 0) {
        if (n_in != 32 || out_size != (int)O_END || ws_size < WS_END) { fprintf(stderr, "kernel_launch: unexpected shapes (n_in %d out %d ws %zu, need ws %zu)\n", n_in, out_size, ws_size, (size_t)WS_END); grid = -1; return; }
        int dev = 0, cus = 0, per_cu = 0;
        if (hipGetDevice(&dev) != hipSuccess || hipDeviceGetAttribute(&cus, hipDeviceAttributeMultiprocessorCount, dev) != hipSuccess) { grid = -1; return; }
        if (hipFuncSetAttribute((const void*)mega, hipFuncAttributeMaxDynamicSharedMemorySize, LDS_BYTES) != hipSuccess) { fprintf(stderr, "kernel_launch: hipFuncSetAttribute failed\n"); grid = -1; return; }
        if (hipOccupancyMaxActiveBlocksPerMultiprocessor(&per_cu, (const void*)mega, 512, LDS_BYTES) != hipSuccess || per_cu < 1) { fprintf(stderr, "kernel_launch: occupancy query says %d\n", per_cu); (void)hipGetLastError(); grid = -1; return; }
        grid = cus;
    }
    if (grid < 0) return;
    (void)hipMemsetAsync(d_ws, 0, CTL_BYTES, stream);
    Params hp{};
    for (int i = 0; i < 32; ++i) hp.in[i] = (const float*)d_in[i];
    hp.out = (float*)d_out; hp.ws = (unsigned char*)d_ws; hp.use_cg = 0; hp.pad = 0;
    void* args[] = {&hp};
    hipError_t e = hipLaunchCooperativeKernel((const void*)mega, dim3(grid), dim3(512), args, LDS_BYTES, stream);
    if (e != hipSuccess) fprintf(stderr, "kernel_launch: cooperative launch failed: %s (grid %d)\n", hipGetErrorString(e), grid);
}
```

```cpp
#ifndef REP
#define REP 0
#endif
#ifndef PSKIP
#define PSKIP 0
#endif
#ifndef PMODE
#define PMODE 0
#endif
#include <hip/hip_runtime.h>
#include <hip/hip_cooperative_groups.h>
#include <cstdio>
namespace cg = cooperative_groups;
#define LAS __attribute__((address_space(3)))
typedef unsigned short bf16_t;
typedef short bf16x8 __attribute__((ext_vector_type(8)));
typedef float f32x4 __attribute__((ext_vector_type(4)));
typedef float f32x2 __attribute__((ext_vector_type(2)));
typedef unsigned u32x4 __attribute__((ext_vector_type(4)));
typedef unsigned u32x2 __attribute__((ext_vector_type(2)));

constexpr int D = 1024, NP = 16384, NS = 512, NT = 16896, SEQ = 2048, NBP = 8, NBS = 128;
constexpr int WA = 512, DFF = 3072, PLE = 256;
constexpr float EPS = 1e-6f;
constexpr size_t O_Y = 0;
constexpr size_t O_HP = 17301504, O_HS = 17305600, O_CP = 17371136, O_CS = 17383424, O_VS = 17580032, O_FP = 17842176, O_FS = 17940480, O_END = 19513344;
constexpr size_t OFF_BAR = 0, OFF_FLAG = 16384, CTL_BYTES = 32768;
constexpr size_t OFF_WIN = 32768;
constexpr size_t OFF_WOUT = OFF_WIN + (size_t)2048 * 1024 * 2;
constexpr size_t OFF_WUP = OFF_WOUT + (size_t)1024 * 1024 * 2;
constexpr size_t OFF_WDN = OFF_WUP + (size_t)6144 * 1024 * 2;
constexpr size_t OFF_WPG = OFF_WDN + (size_t)1024 * 3072 * 2;
constexpr size_t OFF_WPLE = OFF_WPG + (size_t)1024 * 1024 * 2;
constexpr size_t OFF_WG = OFF_WPLE + (size_t)1024 * 256 * 2;
constexpr size_t OFF_WSGU = OFF_WG + (size_t)8 * 128 * 64 * 2;
constexpr size_t OFF_RSTD1 = OFF_WSGU + (size_t)4 * 128 * 128 * 2;
constexpr size_t OFF_SP = OFF_RSTD1 + 98304;
constexpr size_t OFF_LNSTAT = OFF_RSTD1 + 131072;
constexpr size_t STAT_BYTES = (size_t)NT * 16 * 4;
constexpr size_t OFF_SSQY = OFF_LNSTAT + STAT_BYTES;
constexpr size_t OFF_SSQ1 = OFF_SSQY + STAT_BYTES;
constexpr size_t OFF_SSQ2 = OFF_SSQ1 + STAT_BYTES;
constexpr size_t OFF_SSQ3 = OFF_SSQ2 + STAT_BYTES;
constexpr size_t OFF_AGG = OFF_SSQ3 + STAT_BYTES;
constexpr size_t OFF_HALO = OFF_AGG + (size_t)1024 * 128 * 4;
constexpr size_t OFF_PB = OFF_HALO + (size_t)264 * 4 * 6144 * 4;
constexpr size_t OFF_R1 = OFF_PB + (size_t)NT * 256 * 2;
constexpr size_t OFF_XB = OFF_R1, OFF_Z = OFF_R1 + (size_t)NT * 1024 * 2, OFF_ACT = OFF_R1, OFF_H3 = OFF_R1;
constexpr size_t OFF_R3 = OFF_R1 + (size_t)NT * 3072 * 2;
constexpr size_t OFF_E = OFF_R3 + (size_t)NT * 1024 * 2, OFF_Y = OFF_E;
constexpr size_t WS_END = OFF_E + (size_t)NT * 1024 * 2;

constexpr int LDS_BYTES = 155648, LDS_X = 131072;

struct Params {
    const float* in[32];
    float* out;
    unsigned char* ws;
    int use_cg;
    int pad;
};

typedef const __attribute__((address_space(4))) Params* KP;

__device__ __forceinline__ unsigned cvt_pk_bf16(float lo, float hi) { unsigned r; asm volatile("v_cvt_pk_bf16_f32 %0, %1, %2" : "=v"(r) : "v"(lo), "v"(hi)); return r; }
__device__ __forceinline__ float bflo(unsigned w) { return __uint_as_float(w << 16); }
__device__ __forceinline__ float bfhi(unsigned w) { return __uint_as_float(w & 0xffff0000u); }
__device__ __forceinline__ float bf2f(bf16_t v) { return __uint_as_float((unsigned)v << 16); }
__device__ __forceinline__ float sigmoidf_(float x) { return __builtin_amdgcn_rcpf(1.0f + __builtin_amdgcn_exp2f(-1.4426950409f * x)); }
__device__ __forceinline__ float gelu_t(float x) {
    const float u = x * (-2.3022082f - 0.1029432f * x * x);
    return x * __builtin_amdgcn_rcpf(1.0f + __builtin_amdgcn_exp2f(u));
}
__device__ __forceinline__ f32x2 gelu2(f32x2 x) {
    const f32x2 u = x * ((x * x) * (-0.1029432f) + (-2.3022082f));
    f32x2 e; e.x = __builtin_amdgcn_exp2f(u.x); e.y = __builtin_amdgcn_exp2f(u.y);
    const f32x2 d = e + 1.0f;
    f32x2 r; r.x = __builtin_amdgcn_rcpf(d.x); r.y = __builtin_amdgcn_rcpf(d.y);
    return x * r;
}
__device__ __forceinline__ f32x4 gelu4(f32x4 v) { const f32x2 a = gelu2((f32x2){v[0], v[1]}), b = gelu2((f32x2){v[2], v[3]}); return (f32x4){a.x, a.y, b.x, b.y}; }
__device__ __forceinline__ float wave_sum(float v) {
#pragma unroll
    for (int o = 32; o >= 1; o >>= 1) v += __shfl_xor(v, o);
    return v;
}
template <int CTRL> __device__ __forceinline__ float dppf(float v) { return __int_as_float(__builtin_amdgcn_update_dpp(0, __float_as_int(v), CTRL, 0xf, 0xf, false)); }

#define XB_TMO      128
#define XB_XCNT(j)  (256  + 64 * (j))
#define XB_XSUB(j)  (1280 + 64 * (j))
#define XB_XGEN(j)  (2304 + 64 * (j))
#define XB_TOP      3328
#define XB_TOPGEN   3392
#define XCD_BAR_WORDS 3456
#define XB_SPIN_CAP (1u << 20)
__device__ __forceinline__ unsigned xb_ld(unsigned* p)              { return __hip_atomic_load(p, __ATOMIC_RELAXED, __HIP_MEMORY_SCOPE_AGENT); }
__device__ __forceinline__ unsigned xb_add(unsigned* p, unsigned v) { return __hip_atomic_fetch_add(p, v, __ATOMIC_RELAXED, __HIP_MEMORY_SCOPE_AGENT); }
__device__ __forceinline__ unsigned xb_xcc_id() { return (unsigned)__builtin_amdgcn_s_getreg((3 << 11) | 20) & 0xFu; }
#define XB_SPIN(cond, bar) do { unsigned _sp = 0; while (cond) { __builtin_amdgcn_s_sleep(1); \
    if ((++_sp & 255u) == 0u) { if (xb_ld(&(bar)[XB_TMO])) break; if (_sp > XB_SPIN_CAP) { atomicAdd(&(bar)[XB_TMO], 1u); break; } } } } while (0)
struct XcdBarrier { unsigned* bar; unsigned x; volatile LAS unsigned* st; };
__device__ __forceinline__ XcdBarrier xcd_barrier_post(unsigned* bar, volatile LAS unsigned* st) {
    XcdBarrier b; b.bar = bar; b.x = xb_xcc_id(); b.st = st;
    if (threadIdx.x == 0) (void)xb_add(&bar[XB_XCNT(b.x)], 1u);
    return b;
}
__device__ __forceinline__ void xcd_barrier_complete(unsigned* bar, unsigned x, unsigned& nloc, unsigned& nx) {
    const unsigned G = gridDim.x * gridDim.y * gridDim.z;
    unsigned sum, cnt, mine, sp = 0u;
    for (;;) {
        sum = 0u; cnt = 0u; mine = 0u;
#pragma unroll
        for (unsigned j = 0; j < 16; ++j) { const unsigned c = xb_ld(&bar[XB_XCNT(j)]); sum += c; cnt += (c > 0u) ? 1u : 0u; mine = (j == x) ? c : mine; }
        if (sum == G) break;
        __builtin_amdgcn_s_sleep(1);
        if ((++sp & 255u) == 0u) { if (xb_ld(&bar[XB_TMO])) break; if (sp > XB_SPIN_CAP) { atomicAdd(&bar[XB_TMO], 1u); break; } }
    }
    nloc = mine > 0u ? mine : 1u; nx = cnt > 0u ? cnt : 1u;
}
__device__ __forceinline__ void xcd_barrier(const XcdBarrier& b) {
    asm volatile("s_waitcnt vmcnt(0)" ::: "memory");
    __syncthreads();
    if (threadIdx.x == 0) {
        unsigned* bar = b.bar;
        __builtin_amdgcn_s_waitcnt(0);
        unsigned nloc = b.st[0], nx = b.st[1];
        if (nloc == 0u) { xcd_barrier_complete(bar, b.x, nloc, nx); b.st[0] = nloc; b.st[1] = nx; }
        const unsigned old = xb_add(&bar[XB_XSUB(b.x)], 1u);
        const unsigned gen = old / nloc;
        if (old + 1u == (gen + 1u) * nloc) {
            __builtin_amdgcn_fence(__ATOMIC_RELEASE, "agent");
            asm volatile("s_waitcnt vmcnt(0)" ::: "memory");
            const unsigned og = xb_add(&bar[XB_TOP], 1u);
            const unsigned tg = og / nx;
            if (og + 1u == (tg + 1u) * nx) xb_add(&bar[XB_TOPGEN], 1u);
            else XB_SPIN(xb_ld(&bar[XB_TOPGEN]) == tg, bar);
            __builtin_amdgcn_fence(__ATOMIC_ACQUIRE, "agent");
            xb_add(&bar[XB_XGEN(b.x)], 1u);
            asm volatile("s_waitcnt vmcnt(0)" ::: "memory");
        } else {
            XB_SPIN(xb_ld(&bar[XB_XGEN(b.x)]) == gen, bar);
            __builtin_amdgcn_fence(__ATOMIC_ACQUIRE, "agent");
            asm volatile("s_waitcnt vmcnt(0)" ::: "memory");
        }
    }
    __syncthreads();
}
namespace pg8 {
constexpr int BM = 256, BK = 64, HALF = 128, HTB = HALF * BK * 2, STAGE_BYTES = 8 * HTB, NXCD = 8, WGM = 8;
__device__ __forceinline__ int lds_byte(int r, int c) { const int st = (r >> 4) * 2 + (c >> 5), rr = r & 15, cc = c & 31, ob = rr * 64 + cc * 2; return st * 1024 + (ob ^ (((ob >> 9) & 1) << 5)); }
__device__ __forceinline__ void stage_rc(int b, int& R, int& C) { const int st = b / 1024, sb = b % 1024, swz = sb ^ (((sb >> 9) & 1) << 5); R = (st >> 1) * 16 + swz / 64; C = (st & 1) * 32 + (swz % 64) / 2; }
__device__ __forceinline__ int perm32(int rho) { const int n = rho >> 4, i = rho & 15; return 8 * (i >> 2) + 4 * n + (i & 3); }
struct Unit { int pm, pn; };
struct Gemm { const bf16_t* A; const bf16_t* Bt; int M, N, K; };
struct StaticOrder {
    int nM, nN, nwg, G, c;
    __device__ void init(int M, int N, int G_, int c_) { nM = M / BM; nN = N / BM; nwg = nM * nN; G = G_; c = c_; }
    __device__ bool next(int i, Unit& u) const {
        const long L = (long)i * G + c; if (L >= nwg) return false;
        int wgid = (int)L; { const int q = nwg / NXCD, r = nwg % NXCD, xcd = wgid % NXCD, off = wgid / NXCD; wgid = (xcd < r ? xcd * (q + 1) : r * (q + 1) + (xcd - r) * q) + off; }
        const int nig = WGM * nN, gid = wgid / nig, fm = gid * WGM, gsz = (nM - fm) < WGM ? (nM - fm) : WGM;
        u.pm = fm + ((wgid % nig) % gsz); u.pn = (wgid % nig) / gsz; return true;
    }
};

template <class Epi, class Sched, bool ALIGN_EPI = false, bool SP2 = false>
__device__ __forceinline__ void gemm_phase(LAS unsigned char* lds, const Gemm g, const Sched& S, const Epi& E) {
    int tid_ = threadIdx.x; asm volatile("" : "+v"(tid_));
    const int tid = tid_, wid = __builtin_amdgcn_readfirstlane(tid >> 6), lane = tid & 63, wr = wid >> 2, wc = wid & 3, fr = lane & 15, fq = lane >> 4;
    const int K = g.K, nt = K / BK;
    unsigned voffA[2], voffB[2];
#pragma unroll
    for (int i = 0; i < 2; ++i) { int R, C; stage_rc(tid * 16 + i * 8192, R, C); const int Rb = Epi::PERM ? ((R & ~31) + perm32(R & 31)) : R;
        const int Ra = Epi::APERM ? ((R & 64) + 4 * (R & 15) + ((R >> 4) & 3)) : R;
        voffA[i] = (unsigned)(Ra * K + C) * 2u; voffB[i] = (unsigned)(Rb * K + C) * 2u; }
    const size_t kstep = (size_t)(BK * 2);
    const size_t hstep = (size_t)HALF * K * 2;
    const size_t tstep = 2 * hstep;
    const unsigned ldsw = (unsigned)wid * 1024u;
    const int aoff = lds_byte(wr * 64 + fr, fq * 8), boff = lds_byte(wc * 32 + fr, fq * 8);
#define PG8_SA(b, h) (((b) * 2 + (h)) * HTB)
#define PG8_SB(b, h) ((4 + (b) * 2 + (h)) * HTB)
#define PG8_STAGE(bufoff, gbase, voff) do { _Pragma("unroll") for (int _i = 0; _i < 2; ++_i) \
        __builtin_amdgcn_global_load_lds((const unsigned*)((const char*)(gbase) + (voff)[_i]), (LAS unsigned*)(lds + (bufoff) + ldsw + _i * 8192), 16, 0, 0); } while (0)
#define PG8_LDA(dst, b, h) do { _Pragma("unroll") for (int m = 0; m < 4; ++m) _Pragma("unroll") for (int k = 0; k < 2; ++k) dst[m][k] = *(const LAS bf16x8*)(lds + PG8_SA(b, h) + aoff + m * 2048 + k * 1024); } while (0)
#define PG8_LDB(dst, b, h) do { _Pragma("unroll") for (int n = 0; n < 2; ++n) _Pragma("unroll") for (int k = 0; k < 2; ++k) dst[n][k] = *(const LAS bf16x8*)(lds + PG8_SB(b, h) + boff + n * 2048 + k * 1024); } while (0)
#define PG8_MMA(ai, bj, At, Bt) do { __builtin_amdgcn_s_setprio(1); _Pragma("unroll") for (int m = 0; m < 4; ++m) _Pragma("unroll") for (int n = 0; n < 2; ++n) _Pragma("unroll") for (int k = 0; k < 2; ++k) \
        acc[ai][bj][m][n] = __builtin_amdgcn_mfma_f32_16x16x32_bf16(Bt[n][k], At[m][k], acc[ai][bj][m][n], 0, 0, 0); __builtin_amdgcn_s_setprio(0); } while (0)
#define PG8_WAIT_V(n) asm volatile("s_waitcnt vmcnt(" #n ")" ::: "memory")
#define PG8_WAIT_L(n) asm volatile("s_waitcnt lgkmcnt(" #n ")" ::: "memory")
#define PG8_BAR __builtin_amdgcn_s_barrier()
#define PG8_SCHED __builtin_amdgcn_sched_barrier(0)
    Unit cur, nxt; int ui = 0;
    if (!S.next(0, cur)) return;
    f32x4 acc[2][2][4][2];
#pragma unroll
    for (int a = 0; a < 2; ++a)
#pragma unroll
        for (int b = 0; b < 2; ++b)
#pragma unroll
            for (int m = 0; m < 4; ++m)
#pragma unroll
                for (int n = 0; n < 2; ++n) acc[a][b][m][n] = (f32x4){0.f, 0.f, 0.f, 0.f};
    bf16x8 At[4][2], B0[2][2], B1[2][2];
    const char* cA = (const char*)g.A + (size_t)cur.pm * tstep; const char* cB = (const char*)g.Bt + (size_t)cur.pn * tstep;
    if constexpr (SP2) {
        PG8_STAGE(PG8_SB(0, 0), cB, voffB); PG8_STAGE(PG8_SB(0, 1), cB + hstep, voffB); PG8_STAGE(PG8_SA(0, 0), cA, voffA); PG8_STAGE(PG8_SA(0, 1), cA + hstep, voffA);
        if (wr == 1) PG8_BAR;
        PG8_WAIT_V(2); PG8_BAR;
        PG8_STAGE(PG8_SB(1, 0), cB + kstep, voffB); PG8_STAGE(PG8_SA(1, 0), cA + kstep, voffA); PG8_STAGE(PG8_SB(1, 1), cB + hstep + kstep, voffB);
        PG8_WAIT_V(6); PG8_BAR;
    } else {
        PG8_STAGE(PG8_SB(0, 0), cB, voffB); PG8_STAGE(PG8_SA(0, 0), cA, voffA); PG8_STAGE(PG8_SB(0, 1), cB + hstep, voffB); PG8_STAGE(PG8_SA(0, 1), cA + hstep, voffA);
        if (wr == 1) PG8_BAR;
        PG8_WAIT_V(4); PG8_BAR;
        PG8_STAGE(PG8_SB(1, 0), cB + kstep, voffB); PG8_STAGE(PG8_SA(1, 0), cA + kstep, voffA); PG8_STAGE(PG8_SB(1, 1), cB + hstep + kstep, voffB);
        PG8_WAIT_V(6); PG8_BAR;
    }
    for (;;) {
        const bool has_next = S.next(ui + 1, nxt);
        const char* nA = has_next ? (const char*)g.A + (size_t)nxt.pm * tstep : cA; const char* nB = has_next ? (const char*)g.Bt + (size_t)nxt.pn * tstep : cB;
        for (int t = 0; t < nt; t += 2) {
            const bool last = (t == nt - 2);
            const char* a1 = cA + (size_t)(t + 1) * kstep;
            const char* a2 = last ? nA : cA + (size_t)(t + 2) * kstep; const char* b2 = last ? nB : cB + (size_t)(t + 2) * kstep;
            const char* a3 = a2 + kstep; const char* b3 = b2 + kstep;
            if constexpr (Epi::HAS_MID) { if (t == (nt >> 1)) E.mid(acc, cur, ui, wr, fr); }
            if constexpr (SP2) {
            PG8_LDB(B0, 0, 0); PG8_LDB(B1, 0, 1); PG8_SCHED; PG8_LDA(At, 0, 0); PG8_STAGE(PG8_SA(1, 1), a1 + hstep, voffA);
            PG8_WAIT_V(8); PG8_WAIT_L(0); PG8_BAR; PG8_MMA(0, 0, At, B0); PG8_MMA(0, 1, At, B1); PG8_BAR; PG8_SCHED;
            PG8_LDA(At, 0, 1); PG8_STAGE(PG8_SB(0, 0), b2, voffB); PG8_STAGE(PG8_SB(0, 1), b2 + hstep, voffB); PG8_STAGE(PG8_SA(0, 0), a2, voffA);
            PG8_WAIT_V(8); PG8_WAIT_L(0); PG8_BAR; PG8_MMA(1, 0, At, B0); PG8_MMA(1, 1, At, B1); PG8_BAR; PG8_SCHED;
            PG8_LDB(B0, 1, 0); PG8_LDB(B1, 1, 1); PG8_SCHED; PG8_LDA(At, 1, 0); PG8_STAGE(PG8_SA(0, 1), a2 + hstep, voffA);
            PG8_WAIT_V(8); PG8_WAIT_L(0); PG8_BAR; PG8_MMA(0, 0, At, B0); PG8_MMA(0, 1, At, B1); PG8_BAR; PG8_SCHED;
            PG8_LDA(At, 1, 1); PG8_STAGE(PG8_SB(1, 0), b3, voffB); PG8_STAGE(PG8_SB(1, 1), b3 + hstep, voffB); PG8_STAGE(PG8_SA(1, 0), a3, voffA);
            PG8_WAIT_V(8); PG8_WAIT_L(0); PG8_BAR; PG8_MMA(1, 0, At, B0); PG8_MMA(1, 1, At, B1); PG8_BAR; PG8_SCHED;
            } else {
            PG8_LDB(B0, 0, 0); PG8_SCHED; PG8_LDA(At, 0, 0); PG8_STAGE(PG8_SA(1, 1), a1 + hstep, voffA);
            PG8_WAIT_L(8); PG8_BAR; PG8_WAIT_L(0); PG8_MMA(0, 0, At, B0); PG8_BAR; PG8_SCHED;
            PG8_LDB(B1, 0, 1); PG8_STAGE(PG8_SB(0, 0), b2, voffB);
            PG8_BAR; PG8_WAIT_L(0); PG8_MMA(0, 1, At, B1); PG8_BAR;
            PG8_LDA(At, 0, 1); PG8_STAGE(PG8_SA(0, 0), a2, voffA);
            PG8_BAR; PG8_WAIT_L(0); PG8_MMA(1, 0, At, B0); PG8_BAR; PG8_SCHED;
            PG8_STAGE(PG8_SB(0, 1), b2 + hstep, voffB);
            PG8_WAIT_V(6); PG8_BAR; PG8_MMA(1, 1, At, B1); PG8_BAR;
            PG8_LDB(B0, 1, 0); PG8_SCHED; PG8_LDA(At, 1, 0); PG8_STAGE(PG8_SA(0, 1), a2 + hstep, voffA);
            PG8_WAIT_L(8); PG8_BAR; PG8_WAIT_L(0); PG8_MMA(0, 0, At, B0); PG8_BAR; PG8_SCHED;
            PG8_LDB(B1, 1, 1); PG8_STAGE(PG8_SB(1, 0), b3, voffB);
            PG8_BAR; PG8_WAIT_L(0); PG8_MMA(0, 1, At, B1); PG8_BAR;
            PG8_LDA(At, 1, 1); PG8_STAGE(PG8_SA(1, 0), a3, voffA);
            PG8_BAR; PG8_WAIT_L(0); PG8_MMA(1, 0, At, B0); PG8_BAR; PG8_SCHED;
            PG8_STAGE(PG8_SB(1, 1), b3 + hstep, voffB);
            PG8_WAIT_V(6); PG8_BAR; PG8_MMA(1, 1, At, B1); PG8_BAR;
            }
        }
        if constexpr (ALIGN_EPI) { if (wr == 0) PG8_BAR; }
        if constexpr (!Epi::AFTER_DRAIN) E(acc, cur, ui, wr, wc, fr, fq);
        if (!has_next) break;
#pragma unroll
        for (int a = 0; a < 2; ++a)
#pragma unroll
            for (int b = 0; b < 2; ++b)
#pragma unroll
                for (int m = 0; m < 4; ++m)
#pragma unroll
                    for (int n = 0; n < 2; ++n) acc[a][b][m][n] = (f32x4){0.f, 0.f, 0.f, 0.f};
        cur = nxt; cA = nA; cB = nB; ++ui;
        if constexpr (ALIGN_EPI) { if (wr == 1) PG8_BAR; }
    }
    PG8_WAIT_V(0);
    if constexpr (!ALIGN_EPI) { if (wr == 0) PG8_BAR; }
    PG8_BAR;
    if constexpr (Epi::AFTER_DRAIN) E.fused(acc, cur, ui, wr, wc, fr, fq, lds);
#undef PG8_SA
#undef PG8_SB
#undef PG8_STAGE
#undef PG8_LDA
#undef PG8_LDB
#undef PG8_MMA
#undef PG8_WAIT_V
#undef PG8_WAIT_L
#undef PG8_BAR
#undef PG8_SCHED
}
}
using pg8::Unit;
typedef f32x4 Acc[2][2][4][2];

__device__ __forceinline__ u32x4 pack8(f32x4 a, f32x4 b) { u32x4 w; w.x = cvt_pk_bf16(a[0], a[1]); w.y = cvt_pk_bf16(a[2], a[3]); w.z = cvt_pk_bf16(b[0], b[1]); w.w = cvt_pk_bf16(b[2], b[3]); return w; }
__device__ __forceinline__ void unpack8(u32x4 w, f32x4& a, f32x4& b) { a = (f32x4){bflo(w.x), bfhi(w.x), bflo(w.y), bfhi(w.y)}; b = (f32x4){bflo(w.z), bfhi(w.z), bflo(w.w), bfhi(w.w)}; }
__device__ __forceinline__ float red_fq(float v) { v += __shfl_xor(v, 16); v += __shfl_xor(v, 32); return v; }
__device__ __forceinline__ float red8(float v) { v += __shfl_xor(v, 1); v += __shfl_xor(v, 2); v += __shfl_xor(v, 4); return v; }
__device__ __forceinline__ float sq4(f32x4 a) { return a[0] * a[0] + a[1] * a[1] + a[2] * a[2] + a[3] * a[3]; }
__device__ __forceinline__ float sum4(f32x4 a) { return (a[0] + a[1]) + (a[2] + a[3]); }
__device__ __forceinline__ float sum16(const float* sp) { return (sum4(*(const f32x4*)sp) + sum4(*(const f32x4*)(sp + 4))) + (sum4(*(const f32x4*)(sp + 8)) + sum4(*(const f32x4*)(sp + 12))); }

__device__ __forceinline__ void seg_z(int kind, float rs, f32x4& v0, f32x4& v1, float& s1, float& s2) {
    v0 *= rs; v1 *= rs;
    if (kind >= 2) { v0 = gelu4(v0); v1 = gelu4(v1); }
    if (kind == 3) { s1 += sum4(v0) + sum4(v1); s2 += sq4(v0) + sq4(v1); }
}
struct EpiZ {
    static constexpr bool PERM = true, HAS_MID = false, AFTER_DRAIN = false, APERM = false;
    bf16_t* Z; const float* rstd1; float* lnstat;
    __device__ __forceinline__ void operator()(const Acc& acc, const Unit& u, int ui, int wr, int wc, int fr, int fq) const {
        const int row0 = u.pm * 256 + wr * 64 + fr, col0 = u.pn * 256 + wc * 32 + 8 * fq, kind = u.pn >> 1;
#pragma unroll
        for (int ai = 0; ai < 2; ++ai)
#pragma unroll
            for (int m = 0; m < 4; ++m) {
                const int row = row0 + ai * 128 + m * 16; const float rs = rstd1[row];
                float s1 = 0.f, s2 = 0.f;
#pragma unroll
                for (int bj = 0; bj < 2; ++bj) {
                    f32x4 v0 = acc[ai][bj][m][0], v1 = acc[ai][bj][m][1];
                    seg_z(kind, rs, v0, v1, s1, s2);
                    *(u32x4*)(Z + (size_t)row * 2048 + col0 + bj * 128) = pack8(v0, v1);
                }
                if (kind == 3) { s1 = red_fq(s1); s2 = red_fq(s2);
                    if (fq == 0) *(f32x2*)(lnstat + (size_t)row * 16 + (((u.pn - 6) * 4 + wc) * 2)) = (f32x2){s1, s2}; }
            }
    }
};
struct EpiE {
    static constexpr bool PERM = true, HAS_MID = false, AFTER_DRAIN = false, APERM = false;
    bf16_t* O;
    __device__ __forceinline__ void operator()(const Acc& acc, const Unit& u, int ui, int wr, int wc, int fr, int fq) const {
        const int row0 = u.pm * 256 + wr * 64 + fr, col0 = u.pn * 256 + wc * 32 + 8 * fq;
#pragma unroll
        for (int ai = 0; ai < 2; ++ai)
#pragma unroll
            for (int m = 0; m < 4; ++m)
#pragma unroll
                for (int bj = 0; bj < 2; ++bj)
                    *(u32x4*)(O + (size_t)(row0 + ai * 128 + m * 16) * 1024 + col0 + bj * 128) = pack8(acc[ai][bj][m][0], acc[ai][bj][m][1]);
    }
};
struct EpiH1 {
    static constexpr bool PERM = true, HAS_MID = true, AFTER_DRAIN = false, APERM = false;
    const bf16_t* Xb; bf16_t* Hb; float* ssq; const LAS f32x2* tab;
    __device__ __forceinline__ void mid(Acc& acc, const Unit& u, int ui, int wr, int fr) const {
#pragma unroll
        for (int ai = 0; ai < 2; ++ai)
#pragma unroll
            for (int m = 0; m < 4; ++m) { const float r = tab[ui * 256 + ai * 128 + wr * 64 + m * 16 + fr].x;
#pragma unroll
                for (int bj = 0; bj < 2; ++bj)
#pragma unroll
                    for (int n = 0; n < 2; ++n) acc[ai][bj][m][n] *= r; }
    }
    __device__ __forceinline__ void operator()(const Acc& acc, const Unit& u, int ui, int wr, int wc, int fr, int fq) const {
        const int rt0 = wr * 64 + fr, col0 = u.pn * 256 + wc * 32 + 8 * fq;
#pragma unroll
        for (int ai = 0; ai < 2; ++ai)
#pragma unroll
            for (int m = 0; m < 4; ++m) {
                const int rt = rt0 + ai * 128 + m * 16, row = u.pm * 256 + rt; const float rs = tab[ui * 256 + rt].y;
                float ss = 0.f;
#pragma unroll
                for (int bj = 0; bj < 2; ++bj) { const size_t o = (size_t)row * 1024 + col0 + bj * 128;
                    f32x4 x0, x1; unpack8(*(const u32x4*)(Xb + o), x0, x1);
                    const f32x4 h0 = x0 + acc[ai][bj][m][0] * rs, h1 = x1 + acc[ai][bj][m][1] * rs;
                    ss += sq4(h0) + sq4(h1);
                    *(u32x4*)(Hb + o) = pack8(h0, h1); }
                ss = red_fq(ss);
                if (fq == 0) ssq[(size_t)row * 16 + u.pn * 4 + wc] = ss;
            }
    }
};
struct EpiH2 {
    static constexpr bool PERM = true, HAS_MID = false, AFTER_DRAIN = false, APERM = false;
    bf16_t* Hb; float* ssq;
    __device__ __forceinline__ void operator()(const Acc& acc, const Unit& u, int ui, int wr, int wc, int fr, int fq) const {
        const int row0 = u.pm * 256 + wr * 64 + fr, col0 = u.pn * 256 + wc * 32 + 8 * fq;
#pragma unroll
        for (int ai = 0; ai < 2; ++ai)
#pragma unroll
            for (int m = 0; m < 4; ++m) {
                const int row = row0 + ai * 128 + m * 16; float ss = 0.f;
#pragma unroll
                for (int bj = 0; bj < 2; ++bj) { bf16_t* hp = Hb + (size_t)row * 1024 + col0 + bj * 128;
                    f32x4 x0, x1; unpack8(*(const u32x4*)hp, x0, x1);
                    const f32x4 h0 = x0 + acc[ai][bj][m][0], h1 = x1 + acc[ai][bj][m][1];
                    ss += sq4(h0) + sq4(h1);
                    *(u32x4*)hp = pack8(h0, h1); }
                ss = red_fq(ss);
                if (fq == 0) ssq[(size_t)row * 16 + u.pn * 4 + wc] = ss;
            }
    }
};
struct EpiG {
    static constexpr bool PERM = true, HAS_MID = false, AFTER_DRAIN = false, APERM = false;
    const bf16_t* Hb; const bf16_t* E; bf16_t* H3; float* ssq; const LAS float* tab;
    __device__ __forceinline__ void operator()(const Acc& acc, const Unit& u, int ui, int wr, int wc, int fr, int fq) const {
        const int rt0 = wr * 64 + fr, col0 = u.pn * 256 + wc * 32 + 8 * fq;
#pragma unroll
        for (int ai = 0; ai < 2; ++ai)
#pragma unroll
            for (int m = 0; m < 4; ++m) {
                const int rt = rt0 + ai * 128 + m * 16, row = u.pm * 256 + rt; const float rs = tab[ui * 256 + rt]; float ss = 0.f;
#pragma unroll
                for (int bj = 0; bj < 2; ++bj) { const size_t o = (size_t)row * 1024 + col0 + bj * 128;
                    f32x4 e0, e1, x0, x1; unpack8(*(const u32x4*)(E + o), e0, e1); unpack8(*(const u32x4*)(Hb + o), x0, x1);
                    f32x4 g0 = acc[ai][bj][m][0] * rs, g1 = acc[ai][bj][m][1] * rs;
#pragma unroll
                    for (int e = 0; e < 4; ++e) { g0[e] = sigmoidf_(g0[e]); g1[e] = sigmoidf_(g1[e]); }
                    const f32x4 h0 = x0 + e0 * g0, h1 = x1 + e1 * g1;
                    ss += sq4(h0) + sq4(h1);
                    *(u32x4*)(H3 + o) = pack8(h0, h1); }
                ss = red_fq(ss);
                if (fq == 0) ssq[(size_t)row * 16 + u.pn * 4 + wc] = ss;
            }
    }
};
struct EpiGF {
    static constexpr bool PERM = true, HAS_MID = false, AFTER_DRAIN = true, APERM = false;
    const bf16_t* Hb; const bf16_t* E; float* Y; const float* gfin; float* X; unsigned* cnt; const LAS float* tab;
    __device__ __forceinline__ void operator()(const Acc& acc, const Unit& u, int ui, int wr, int wc, int fr, int fq) const {}
    __device__ __forceinline__ void fused(Acc& acc, const Unit& u, int ui, int wr, int wc, int fr, int fq, LAS unsigned char* lds) const {
        const int rt0 = wr * 64 + fr, col0 = u.pn * 256 + wc * 32 + 8 * fq, tid = threadIdx.x;
        LAS float* Pw = (LAS float*)lds;
        LAS float* Rs = (LAS float*)lds + 1024;
#pragma unroll
        for (int ai = 0; ai < 2; ++ai)
#pragma unroll
            for (int m = 0; m < 4; ++m) {
                const int rt = rt0 + ai * 128 + m * 16, row = u.pm * 256 + rt; const float rs = tab[ui * 256 + rt]; float ss = 0.f;
#pragma unroll
                for (int bj = 0; bj < 2; ++bj) { const size_t o = (size_t)row * 1024 + col0 + bj * 128;
                    f32x4 e0, e1, x0, x1; unpack8(*(const u32x4*)(E + o), e0, e1); unpack8(*(const u32x4*)(Hb + o), x0, x1);
                    f32x4 g0 = acc[ai][bj][m][0] * rs, g1 = acc[ai][bj][m][1] * rs;
#pragma unroll
                    for (int e = 0; e < 4; ++e) { g0[e] = sigmoidf_(g0[e]); g1[e] = sigmoidf_(g1[e]); }
                    const f32x4 h0 = x0 + e0 * g0, h1 = x1 + e1 * g1;
                    ss += sq4(h0) + sq4(h1);
                    acc[ai][bj][m][0] = h0; acc[ai][bj][m][1] = h1; }
                ss = red_fq(ss);
                if (fq == 0) Pw[rt * 4 + wc] = ss;
            }
        __syncthreads();
        if (tid < 256) { const f32x4 q = *(const LAS f32x4*)(Pw + tid * 4);
            __hip_atomic_store((unsigned*)(X + ((size_t)u.pm * 4 + u.pn) * 256 + tid), __float_as_uint(sum4(q)), __ATOMIC_RELAXED, __HIP_MEMORY_SCOPE_AGENT); }
        asm volatile("s_waitcnt vmcnt(0)" ::: "memory");
        __syncthreads();
        if (tid == 0) { __hip_atomic_fetch_add(cnt + u.pm * 16, 1u, __ATOMIC_RELAXED, __HIP_MEMORY_SCOPE_AGENT); unsigned sp = 0;
            while (__hip_atomic_load(cnt + u.pm * 16, __ATOMIC_RELAXED, __HIP_MEMORY_SCOPE_AGENT) < 4u) { __builtin_amdgcn_s_sleep(1); if (++sp > (1u << 22)) break; } }
        __syncthreads();
        if (tid < 256) { float s = 0.f;
#pragma unroll
            for (int k = 0; k < 4; ++k) s += __uint_as_float(__hip_atomic_load((const unsigned*)(X + ((size_t)u.pm * 4 + k) * 256 + tid), __ATOMIC_RELAXED, __HIP_MEMORY_SCOPE_AGENT));
            Rs[tid] = rsqrtf(s * (1.0f / 1024.0f) + EPS); }
        __syncthreads();
        f32x4 gv[2][2];
#pragma unroll
        for (int bj = 0; bj < 2; ++bj) { gv[bj][0] = *(const f32x4*)(gfin + col0 + bj * 128); gv[bj][1] = *(const f32x4*)(gfin + col0 + bj * 128 + 4); }
#pragma unroll
        for (int ai = 0; ai < 2; ++ai)
#pragma unroll
            for (int m = 0; m < 4; ++m) {
                const int rt = rt0 + ai * 128 + m * 16, row = u.pm * 256 + rt; const float rs = Rs[rt];
#pragma unroll
                for (int bj = 0; bj < 2; ++bj) { float* yp = Y + (size_t)row * 1024 + col0 + bj * 128;
                    *(f32x4*)yp = acc[ai][bj][m][0] * rs * gv[bj][0]; *(f32x4*)(yp + 4) = acc[ai][bj][m][1] * rs * gv[bj][1]; }
            }
        __syncthreads();
    }
};
template <int C> __device__ __forceinline__ f32x4 dpp4(f32x4 v) { return (f32x4){dppf<C>(v[0]), dppf<C>(v[1]), dppf<C>(v[2]), dppf<C>(v[3])}; }
__device__ __forceinline__ f32x4 sel4(bool c, f32x4 a, f32x4 b) { return c ? a : b; }
template <int C> __device__ __forceinline__ float dppo(float old, float v) { return __int_as_float(__builtin_amdgcn_update_dpp(__float_as_int(old), __float_as_int(v), C, 0xf, 0xf, false)); }
template <int C> __device__ __forceinline__ f32x4 dppo4(f32x4 o, f32x4 v) { return (f32x4){dppo<C>(o[0], v[0]), dppo<C>(o[1], v[1]), dppo<C>(o[2], v[2]), dppo<C>(o[3], v[3])}; }
template <int C> __device__ __forceinline__ float dppz(float v) { return __int_as_float(__builtin_amdgcn_update_dpp(0, __float_as_int(v), C, 0xf, 0xf, true)); }
template <int C> __device__ __forceinline__ f32x4 dppz4(f32x4 v) { return (f32x4){dppz<C>(v[0]), dppz<C>(v[1]), dppz<C>(v[2]), dppz<C>(v[3])}; }
struct EpiUp {
    static constexpr bool PERM = true, HAS_MID = false, AFTER_DRAIN = false, APERM = true;
    bf16_t* ACT; const LAS float* tab; const float* cw; const float* cb; bf16_t* halo; float* ofp; int mode;
    __device__ __forceinline__ void operator()(const Acc& acc, const Unit& u, int ui, int wr, int wc, int fr, int fq) const {
        const int jc0 = u.pn * 128 + wc * 32 + 8 * fq;
        u32x2 held[2][4];
#pragma unroll
        for (int n = 0; n < 2; ++n) {
            const int jc = jc0 + 4 * n;
            const f32x4 w0g = *(const f32x4*)(cw + jc), w1g = *(const f32x4*)(cw + 6144 + jc), w2g = *(const f32x4*)(cw + 12288 + jc), bg = *(const f32x4*)(cb + jc);
            const f32x4 w0v = *(const f32x4*)(cw + 3072 + jc), w1v = *(const f32x4*)(cw + 6144 + 3072 + jc), w2v = *(const f32x4*)(cw + 12288 + 3072 + jc), bv = *(const f32x4*)(cb + 3072 + jc);
#pragma unroll
            for (int ai = 0; ai < 2; ++ai) {
                const int rt0 = ai * 128 + wr * 64 + 4 * fr, row0 = u.pm * 256 + rt0, g = row0 >> 6;
                const f32x4 rs = *(const LAS f32x4*)(tab + ui * 256 + rt0);
                f32x4 cg[4], cv[4];
#pragma unroll
                for (int m = 0; m < 4; ++m) { cg[m] = acc[ai][0][m][n] * rs[m]; cv[m] = acc[ai][1][m][n] * rs[m]; }
                const f32x4 pg3 = dppz4<0x111>(cg[3]), pg2 = dppz4<0x111>(cg[2]), pv3 = dppz4<0x111>(cv[3]), pv2 = dppz4<0x111>(cv[2]);
#pragma unroll
                for (int m = 0; m < 4; ++m) {
                    const f32x4 xg1 = m == 0 ? pg3 : cg[m - 1], xg2 = m == 0 ? pg2 : (m == 1 ? pg3 : cg[m - 2]);
                    const f32x4 xv1 = m == 0 ? pv3 : cv[m - 1], xv2 = m == 0 ? pv2 : (m == 1 ? pv3 : cv[m - 2]);
                    const f32x4 og = bg + w0g * xg2 + w1g * xg1 + w2g * cg[m], ov = bv + w0v * xv2 + w1v * xv1 + w2v * cv[m];
                    const f32x4 av = gelu4(og) * ov;
                    const u32x2 pk = (u32x2){cvt_pk_bf16(av[0], av[1]), cvt_pk_bf16(av[2], av[3])};
                    if (n == 0) held[ai][m] = pk;
                    else if (!(m < 2 && fr == 0)) *(u32x4*)(ACT + (size_t)(row0 + m) * 3072 + jc0) = (u32x4){held[ai][m].x, held[ai][m].y, pk.x, pk.y};
                }
                if (fr == 0) {
#pragma unroll
                    for (int m = 0; m < 2; ++m) { bf16_t* hp = halo + (size_t)(g * 4 + m) * 6144 + jc;
                        *(u32x2*)hp = (u32x2){cvt_pk_bf16(cg[m][0], cg[m][1]), cvt_pk_bf16(cg[m][2], cg[m][3])}; *(u32x2*)(hp + 3072) = (u32x2){cvt_pk_bf16(cv[m][0], cv[m][1]), cvt_pk_bf16(cv[m][2], cv[m][3])}; } }
                if (fr == 15) {
#pragma unroll
                    for (int m = 2; m < 4; ++m) { bf16_t* hp = halo + (size_t)(g * 4 + m) * 6144 + jc;
                        *(u32x2*)hp = (u32x2){cvt_pk_bf16(cg[m][0], cg[m][1]), cvt_pk_bf16(cg[m][2], cg[m][3])}; *(u32x2*)(hp + 3072) = (u32x2){cvt_pk_bf16(cv[m][0], cv[m][1]), cvt_pk_bf16(cv[m][2], cv[m][3])};
                        const int row = row0 + m;
                        if ((row & 2047) >= 2046) { float* op = ofp + (size_t)((row >> 11) * 2 + (row & 2047) - 2046) * 6144 + jc; *(f32x4*)op = cg[m]; *(f32x4*)(op + 3072) = cv[m]; } } }
            }
        }
    }
};

template <int UN> struct Frags { bf16x8 a[UN][4], b[UN][4]; };
struct TileP { const bf16_t* ap; const bf16_t* bp[4]; int lda; };
__device__ __forceinline__ TileP st_tile(const bf16_t* A, int lda, int arow0, const bf16_t* Bt, int ldb, int b0, int b1, int b2, int b3, int K) {
    int tid_ = threadIdx.x; asm volatile("" : "+v"(tid_));
    const int wave = tid_ >> 6, lane = tid_ & 63, fr = lane & 15, fq = lane >> 4, kw = K >> 3;
    TileP t; t.lda = lda; t.ap = A + (size_t)(arow0 + fr) * lda + wave * kw + 8 * fq;
    const bf16_t* bb = Bt + (size_t)fr * ldb + wave * kw + 8 * fq;
    t.bp[0] = bb + (size_t)b0 * ldb; t.bp[1] = bb + (size_t)b1 * ldb; t.bp[2] = bb + (size_t)b2 * ldb; t.bp[3] = bb + (size_t)b3 * ldb;
    return t;
}
template <int UN> __device__ __forceinline__ void st_load(Frags<UN>& F, const TileP& t, int s0) {
#pragma unroll
    for (int s = 0; s < UN; ++s)
#pragma unroll
        for (int i = 0; i < 4; ++i) { F.a[s][i] = *(const bf16x8*)(t.ap + (size_t)(16 * i) * t.lda + (s0 + s) * 32); F.b[s][i] = *(const bf16x8*)(t.bp[i] + (s0 + s) * 32); }
}
template <int UN> __device__ __forceinline__ void st_mma(f32x4 (&acc)[4][4], const Frags<UN>& F) {
#pragma unroll
    for (int s = 0; s < UN; ++s)
#pragma unroll
        for (int i = 0; i < 4; ++i)
#pragma unroll
            for (int j = 0; j < 4; ++j) acc[i][j] = __builtin_amdgcn_mfma_f32_16x16x32_bf16(F.b[s][j], F.a[s][i], acc[i][j], 0, 0, 0);
}
__device__ __forceinline__ void st_zero(f32x4 (&acc)[4][4]) {
#pragma unroll
    for (int i = 0; i < 4; ++i)
#pragma unroll
        for (int j = 0; j < 4; ++j) acc[i][j] = (f32x4){0.f, 0.f, 0.f, 0.f};
}
__device__ __forceinline__ void st_reduce(LAS unsigned char* lds, const f32x4 (&acc)[4][4], f32x4& lo0, f32x4& lo1, f32x4& hi0, f32x4& hi1) {
    int tid_ = threadIdx.x; asm volatile("" : "+v"(tid_));
    const int tid = tid_, wave = tid >> 6, lane = tid & 63, fr = lane & 15, fq = lane >> 4;
    LAS float* P = (LAS float*)lds + wave * 4096;
#pragma unroll
    for (int i = 0; i < 4; ++i)
#pragma unroll
        for (int j = 0; j < 4; ++j) { const int r = 16 * i + fr, ch = (4 * j + fq) ^ fr; *(LAS f32x4*)(P + r * 64 + ch * 4) = acc[i][j]; }
    __syncthreads();
    {   const int r = tid >> 3, c = tid & 7; LAS const float* Q = (LAS const float*)lds + r * 64;
        const int c0 = ((2 * c) ^ (r & 15)) * 4, c1 = ((2 * c + 1) ^ (r & 15)) * 4;
        lo0 = (f32x4){0.f, 0.f, 0.f, 0.f}; lo1 = lo0; hi0 = lo0; hi1 = lo0;
#pragma unroll
        for (int w = 0; w < 4; ++w) { lo0 += *(LAS const f32x4*)(Q + w * 4096 + c0); lo1 += *(LAS const f32x4*)(Q + w * 4096 + c1);
            hi0 += *(LAS const f32x4*)(Q + (w + 4) * 4096 + c0); hi1 += *(LAS const f32x4*)(Q + (w + 4) * 4096 + c1); } }
    __syncthreads();
}
struct XpT { const float* src; const float* scale; bf16_t* dst; };
__device__ __forceinline__ XpT xp_desc(KP p, unsigned char* ws, int tt) {
    const int lane = threadIdx.x & 63, w = threadIdx.x >> 6;
    const float* src; int ldsrc, k0, scol0, lddst, drow0; const float* scale; bf16_t* dst;
    if (tt < 512) { const int kt = tt >> 5, nt = tt & 31; src = p->in[8]; ldsrc = 2048; k0 = kt * 64; scol0 = nt * 64; scale = p->in[7] + k0; dst = (bf16_t*)(ws + OFF_WIN); lddst = 1024; drow0 = nt * 64; }
    else if (tt < 768) { const int t2 = tt - 512, kt = t2 >> 4, nt = t2 & 15; src = p->in[22]; ldsrc = 1024; k0 = kt * 64; scol0 = nt * 64; scale = k0 < 512 ? p->in[16] + k0 : p->in[21] + (k0 - 512); dst = (bf16_t*)(ws + OFF_WOUT); lddst = 1024; drow0 = nt * 64; }
    else if (tt < 2304) { const int t2 = tt - 768, kt = t2 / 96, nt = t2 % 96, n0 = nt * 64; src = p->in[24]; ldsrc = 6144; k0 = kt * 64; scol0 = ((n0 & 255) >> 7) * 3072 + (n0 >> 8) * 128 + (n0 & 127); scale = p->in[23] + k0; dst = (bf16_t*)(ws + OFF_WUP); lddst = 1024; drow0 = n0; }
    else if (tt < 3072) { const int t2 = tt - 2304, kt = t2 >> 4, nt = t2 & 15; src = p->in[27]; ldsrc = 1024; k0 = kt * 64; scol0 = nt * 64; scale = nullptr; dst = (bf16_t*)(ws + OFF_WDN); lddst = 3072; drow0 = nt * 64; }
    else if (tt < 3328) { const int t2 = tt - 3072, kt = t2 >> 4, nt = t2 & 15; src = p->in[29]; ldsrc = 1024; k0 = kt * 64; scol0 = nt * 64; scale = p->in[28] + k0; dst = (bf16_t*)(ws + OFF_WPG); lddst = 1024; drow0 = nt * 64; }
    else { const int t2 = tt - 3328, kt = t2 >> 4, nt = t2 & 15; src = p->in[30]; ldsrc = 1024; k0 = kt * 64; scol0 = nt * 64; scale = nullptr; dst = (bf16_t*)(ws + OFF_WPLE); lddst = 256; drow0 = nt * 64; }
    XpT t; t.src = src + (size_t)(k0 + 8 * w) * ldsrc + scol0 + lane; t.scale = scale ? scale + 8 * w : nullptr; t.dst = dst + (size_t)(drow0 + lane) * lddst + k0 + 8 * w;
    return t;
}
__device__ __forceinline__ int xp_ld(int tt) { return tt < 512 ? 2048 : (tt >= 768 && tt < 2304) ? 6144 : 1024; }
__device__ __forceinline__ void p0_phase(KP p, LAS unsigned char* lds) {
    const int tid = threadIdx.x, lane = tid & 63, wave = tid >> 6, G = gridDim.x, blk = blockIdx.x;
    unsigned char* ws = p->ws;
    {   bf16_t* Xb = (bf16_t*)(ws + OFF_XB); float* rstd1 = (float*)(ws + OFF_RSTD1);
        for (int r0 = (blk * 8 + wave) * 2; r0 < NT; r0 += G * 16) {
            f32x4 v[2][4]; float ss[2];
#pragma unroll
            for (int h = 0; h < 2; ++h) { const int r = r0 + h; const float* src = r < NP ? p->in[0] + (size_t)r * D : p->in[1] + (size_t)(r - NP) * D;
#pragma unroll
                for (int i = 0; i < 4; ++i) v[h][i] = *(const f32x4*)(src + i * 256 + lane * 4); }
#pragma unroll
            for (int h = 0; h < 2; ++h) { ss[h] = 0.f;
#pragma unroll
                for (int i = 0; i < 4; ++i) ss[h] += sq4(v[h][i]);
                ss[h] = wave_sum(ss[h]);
                if (lane == 0) rstd1[r0 + h] = rsqrtf(ss[h] * (1.0f / 1024.0f) + EPS);
#pragma unroll
                for (int i = 0; i < 4; ++i) *(u32x2*)(Xb + (size_t)(r0 + h) * D + i * 256 + lane * 4) = (u32x2){cvt_pk_bf16(v[h][i][0], v[h][i][1]), cvt_pk_bf16(v[h][i][2], v[h][i][3])}; }
        } }
    {   bf16_t* Pb = (bf16_t*)(ws + OFF_PB);
        for (size_t i0 = ((size_t)blk * 512 + tid) * 4; i0 < (size_t)NT * 256; i0 += (size_t)G * 512 * 16) {
            f32x4 v[4];
#pragma unroll
            for (int h = 0; h < 4; ++h) { const size_t idx = i0 + (size_t)h * G * 512 * 4;
                if (idx < (size_t)NT * 256) v[h] = *(const f32x4*)(idx < (size_t)NP * 256 ? p->in[2] + idx : p->in[3] + (idx - (size_t)NP * 256)); }
#pragma unroll
            for (int h = 0; h < 4; ++h) { const size_t idx = i0 + (size_t)h * G * 512 * 4;
                if (idx < (size_t)NT * 256) *(u32x2*)(Pb + idx) = (u32x2){cvt_pk_bf16(v[h][0], v[h][1]), cvt_pk_bf16(v[h][2], v[h][3])}; }
        } }
    {   for (int tt = blk; tt < 3392; tt += 2 * G) {
            const int t1 = tt + G; const bool two = t1 < 3392;
            const XpT A = xp_desc(p, ws, tt), B = xp_desc(p, ws, two ? t1 : tt);
            const int la = xp_ld(tt), lb = xp_ld(two ? t1 : tt);
            float va[8], vb[8];
#pragma unroll
            for (int e = 0; e < 8; ++e) { va[e] = A.src[(size_t)e * la]; vb[e] = B.src[(size_t)e * lb]; }
            if (A.scale) {
#pragma unroll
                for (int e = 0; e < 8; ++e) va[e] *= A.scale[e]; }
            if (B.scale) {
#pragma unroll
                for (int e = 0; e < 8; ++e) vb[e] *= B.scale[e]; }
            *(u32x4*)A.dst = (u32x4){cvt_pk_bf16(va[0], va[1]), cvt_pk_bf16(va[2], va[3]), cvt_pk_bf16(va[4], va[5]), cvt_pk_bf16(va[6], va[7])};
            if (two) *(u32x4*)B.dst = (u32x4){cvt_pk_bf16(vb[0], vb[1]), cvt_pk_bf16(vb[2], vb[3]), cvt_pk_bf16(vb[4], vb[5]), cvt_pk_bf16(vb[6], vb[7])};
        } }
    {   u32x4* ag = (u32x4*)(ws + OFF_AGG); for (int i = blk * 512 + tid; i < 32768; i += G * 512) ag[i] = (u32x4){0u, 0u, 0u, 0u}; }
    {   bf16_t* Wg = (bf16_t*)(ws + OFF_WG); bf16_t* Ws = (bf16_t*)(ws + OFF_WSGU);
        if (blk == 0) ((float*)(ws + OFF_SP))[tid] = log1pf(expf(-p->in[15][tid]));
        for (int idx = blk * 512 + tid; idx < 65536; idx += G * 512) {
            const int hd = idx >> 13, n = (idx >> 6) & 127, k = idx & 63;
            const float v = n < 64 ? p->in[11][(hd * 64 + k) * 64 + n] : p->in[13][(hd * 64 + k) * 64 + (n - 64)];
            Wg[idx] = (bf16_t)(cvt_pk_bf16(v, 0.f) & 0xffffu);
            const int t = (idx >> 7) & 127, s = idx & 127;
            const float w = s <= t ? p->in[19][idx] : 0.f;
            Ws[idx] = (bf16_t)(cvt_pk_bf16(w, 0.f) & 0xffffu);
        } }
}

__device__ __forceinline__ float ald_f(const float* p) { return __uint_as_float(__hip_atomic_load((const unsigned*)p, __ATOMIC_RELAXED, __HIP_MEMORY_SCOPE_AGENT)); }
__device__ __forceinline__ void ast_f(float* p, float v) { __hip_atomic_store((unsigned*)p, __float_as_uint(v), __ATOMIC_RELAXED, __HIP_MEMORY_SCOPE_AGENT); }

__device__ __forceinline__ void p2_taskA(KP p, LAS unsigned char* lds, int task, int skip = 0) {
    int tid_ = threadIdx.x; asm volatile("" : "+v"(tid_));
    const int tid = tid_, lane = tid & 63, wave = tid >> 6;
    unsigned char* ws = p->ws;
    const bool samp = task >= 1024;
    const int hd = task & 7;
    const int c = samp ? 0 : (task >> 6), b = samp ? 0 : ((task >> 3) & 7), sc = samp ? ((task - 1024) >> 3) : 0;
    const int R0 = samp ? NP + sc * 128 : b * 2048 + c * 128;
    const bf16_t* Z = (const bf16_t*)(ws + OFF_Z);
    LAS bf16_t* xcb = (LAS bf16_t*)lds;
    LAS float* aS = (LAS float*)(lds + 18432);
    LAS float* uS = (LAS float*)(lds + 18432 + 34816);
    LAS float* Pseg = (LAS float*)(lds + 88064);
    LAS float* Sseg = Pseg + 512;
    LAS float* hin = Sseg + 512;
    const bf16_t* gap_ = Z + (size_t)(R0 + (tid >> 2)) * 2048 + 512 + hd * 64 + (tid & 3) * 16;
    const u32x4 gaw0 = *(const u32x4*)gap_, gaw1 = *(const u32x4*)(gap_ + 8);
    if (!(skip & 1))
    {   const int t = tid >> 2, cgp = tid & 3, ch0 = hd * 64 + cgp * 16;
        f32x4 xc[4];
#pragma unroll
        for (int i = 0; i < 4; ++i) xc[i] = *(const f32x4*)(p->in[10] + ch0 + 4 * i);
#pragma unroll
        for (int j = 0; j < 4; ++j) {
            f32x4 xv[4] = {{0.f, 0.f, 0.f, 0.f}, {0.f, 0.f, 0.f, 0.f}, {0.f, 0.f, 0.f, 0.f}, {0.f, 0.f, 0.f, 0.f}};
            const bf16_t* src = nullptr; const float* srcf = nullptr;
            if (!samp) { const int pos = c * 128 + t - 3 + j; if (pos >= 0) src = Z + (size_t)(b * 2048 + pos) * 2048 + ch0; }
            else { const int q = sc * 32 + (t >> 2), idx = (t & 3) + j; if (idx < 3) srcf = p->in[5] + ((size_t)q * 3 + idx) * 512 + ch0; else src = Z + (size_t)(NP + 4 * q + idx - 3) * 2048 + ch0; }
            if (src) { const u32x4 w0 = *(const u32x4*)src, w1 = *(const u32x4*)(src + 8); unpack8(w0, xv[0], xv[1]); unpack8(w1, xv[2], xv[3]); }
            else if (srcf) {
#pragma unroll
                for (int i = 0; i < 4; ++i) xv[i] = *(const f32x4*)(srcf + 4 * i); }
#pragma unroll
            for (int i = 0; i < 4; ++i) xc[i] += *(const f32x4*)(p->in[9] + j * 512 + ch0 + 4 * i) * xv[i];
            if (j == 3) {
                float* op = nullptr;
                if (!samp) { if (c == 15 && t >= 125) op = p->out + O_CP + (size_t)(b * 3 + t - 125) * 512 + ch0; }
                else { const int q = sc * 32 + (t >> 2), pos = t & 3; if (pos >= 1) op = p->out + O_CS + (size_t)(q * 3 + pos - 1) * 512 + ch0; }
                if (op) {
#pragma unroll
                    for (int i = 0; i < 4; ++i) *(f32x4*)(op + 4 * i) = xv[i]; }
            }
        }
        *(LAS u32x4*)(xcb + t * 72 + cgp * 16) = pack8(xc[0], xc[1]);
        *(LAS u32x4*)(xcb + t * 72 + cgp * 16 + 8) = pack8(xc[2], xc[3]);
    }
    __syncthreads();
    if (!(skip & 2))
    {   const int fr = lane & 15, fq = lane >> 4;
        bf16x8 af[2];
#pragma unroll
        for (int ks = 0; ks < 2; ++ks) af[ks] = *(const LAS bf16x8*)(xcb + (16 * wave + fr) * 72 + 32 * ks + 8 * fq);
        LAS const bf16_t* WgL = (LAS const bf16_t*)(lds + 98304);
        f32x4 acc[8];
#pragma unroll
        for (int nb = 0; nb < 8; ++nb) { acc[nb] = (f32x4){0.f, 0.f, 0.f, 0.f};
#pragma unroll
            for (int ks = 0; ks < 2; ++ks) { const bf16x8 bb = *(const LAS bf16x8*)(WgL + (16 * nb + fr) * 72 + 32 * ks + 8 * fq);
                acc[nb] = __builtin_amdgcn_mfma_f32_16x16x32_bf16(af[ks], bb, acc[nb], 0, 0, 0); } }
#pragma unroll
        for (int nb = 0; nb < 4; ++nb) {
            const int ch = 16 * nb + fr, chg = hd * 64 + ch;
            const float ba = p->in[12][chg], bx = p->in[14][chg], sp = ((const float*)(ws + OFF_SP))[chg];
#pragma unroll
            for (int j = 0; j < 4; ++j) {
                const int tok = 16 * wave + 4 * fq + j;
                const float rg = sigmoidf_(acc[nb][j] + ba), ig = sigmoidf_(acc[nb + 4][j] + bx);
                const float la = -8.0f * rg * sp;
                const float a = __builtin_amdgcn_exp2f(1.4426950409f * la);
                float mult = __builtin_amdgcn_sqrtf((1.0f - a) * (1.0f + a));
                if (!samp && c == 0 && tok == 0) mult = 1.0f;
                const float xcv = bf2f(xcb[tok * 72 + ch]);
                aS[tok * 68 + ch] = a; uS[tok * 68 + ch] = xcv * ig * mult;
            }
        }
    }
    __syncthreads();
    if (samp) {
        const int ch = lane;
#pragma unroll
        for (int s4 = 0; s4 < 4; ++s4) {
            const int q = sc * 32 + wave * 4 + s4;
            float h = p->in[4][(size_t)q * 512 + hd * 64 + ch];
#pragma unroll
            for (int i = 0; i < 4; ++i) { const int tok = 16 * wave + 4 * s4 + i; h = aS[tok * 68 + ch] * h + uS[tok * 68 + ch]; uS[tok * 68 + ch] = h; }
            p->out[O_HS + (size_t)q * 512 + hd * 64 + ch] = h;
        }
        __syncthreads();
    } else {
        {   const int ch = lane; float P = 1.f, S = 0.f;
#pragma unroll
            for (int i = 0; i < 16; ++i) { const int o = (16 * wave + i) * 68 + ch; const float a = aS[o]; S = a * S + uS[o]; P *= a; uS[o] = S; aS[o] = P; }
            Pseg[wave * 64 + ch] = P; Sseg[wave * 64 + ch] = S; }
        __syncthreads();
        if (wave == 0) {
            const int ch = lane;
            float Pc = 1.f, Sc = 0.f;
#pragma unroll
            for (int s = 0; s < 8; ++s) { const float P = Pseg[s * 64 + ch]; Sc = P * Sc + Sseg[s * 64 + ch]; Pc *= P; }
            unsigned long long* AGG = (unsigned long long*)(ws + OFF_AGG);
            if (c < 15 && !(skip & 3)) __hip_atomic_store(AGG + (size_t)task * 64 + ch, ((unsigned long long)__float_as_uint(Sc) << 32) | (unsigned long long)(__float_as_uint(Pc) | 0x80000000u), __ATOMIC_RELAXED, __HIP_MEMORY_SCOPE_AGENT);
            float h = 0.f;
            if (c > 0 && !(skip & 4)) {
                unsigned long long gv[15];
#pragma unroll
                for (int j = 0; j < 15; ++j) gv[j] = 1ull;
                unsigned sp = 0;
                for (;;) {
                    bool miss = false;
#pragma unroll
                    for (int j = 0; j < 15; ++j) if (j < c) { gv[j] = __hip_atomic_load(AGG + (size_t)(j * 64 + b * 8 + hd) * 64 + ch, __ATOMIC_RELAXED, __HIP_MEMORY_SCOPE_AGENT); }
#pragma unroll
                    for (int j = 0; j < 15; ++j) miss |= (gv[j] == 0ull);
                    if (__builtin_amdgcn_ballot_w64(miss) == 0ull) break;
                    __builtin_amdgcn_s_sleep(2); if (++sp > (1u << 20)) break;
                }
#pragma unroll
                for (int j = 0; j < 15; ++j) if (j < c) h = __uint_as_float((unsigned)gv[j] & 0x7fffffffu) * h + __uint_as_float((unsigned)(gv[j] >> 32));
            }
#pragma unroll
            for (int s = 0; s < 8; ++s) { hin[s * 64 + ch] = h; h = Pseg[s * 64 + ch] * h + Sseg[s * 64 + ch]; }
            if (c == 15) p->out[O_HP + (size_t)b * 512 + hd * 64 + ch] = h;
        }
        __syncthreads();
    }
    if (!(skip & 8))
    {   const int t = tid >> 2, part = tid & 3, row = R0 + t;
        f32x4 g[4]; unpack8(gaw0, g[0], g[1]); unpack8(gaw1, g[2], g[3]);
#pragma unroll
        for (int i = 0; i < 4; ++i) g[i] = gelu4(g[i]);
        float ss = 0.f;
#pragma unroll
        for (int i = 0; i < 4; ++i) { f32x4 h = *(const LAS f32x4*)(uS + t * 68 + part * 16 + 4 * i);
            if (!samp) h += *(const LAS f32x4*)(aS + t * 68 + part * 16 + 4 * i) * *(const LAS f32x4*)(hin + (t >> 4) * 64 + part * 16 + 4 * i);
            g[i] *= h; ss += sq4(g[i]); }
        ss += __shfl_xor(ss, 1); ss += __shfl_xor(ss, 2);
        if (part == 0) ((float*)(ws + OFF_SSQY))[(size_t)row * 16 + hd] = ss;
        bf16_t* yp = (bf16_t*)(ws + OFF_Y) + (size_t)row * 1024 + hd * 64 + part * 16;
        *(u32x4*)yp = pack8(g[0], g[1]); *(u32x4*)(yp + 8) = pack8(g[2], g[3]);
    }
    __syncthreads();
}

__device__ __forceinline__ void p2_taskB(KP p, LAS unsigned char* lds, int idx) {
    int tid_ = threadIdx.x; asm volatile("" : "+v"(tid_));
    const int tid = tid_, lane = tid & 63, wave = tid >> 6;
    unsigned char* ws = p->ws;
    const int chunk = idx >> 2, hb = idx & 3, R0 = chunk * 128;
    const bf16_t* Z = (const bf16_t*)(ws + OFF_Z);
    LAS bf16_t* vnT = (LAS bf16_t*)lds;
    {   const int s = tid >> 2, dg = tid & 3;
        float m_, r_;
        {   const float* lp = (const float*)(ws + OFF_LNSTAT) + (size_t)(R0 + s) * 16;
            float s1 = 0.f, s2 = 0.f;
#pragma unroll
            for (int i = 0; i < 4; ++i) { const f32x4 v = *(const f32x4*)(lp + 4 * i); s1 += v[0] + v[2]; s2 += v[1] + v[3]; }
            m_ = s1 * (1.0f / 512.0f); r_ = rsqrtf(s2 * (1.0f / 512.0f) - m_ * m_ + EPS); }
        const bf16_t* gp = Z + (size_t)(R0 + s) * 2048 + 1536 + hb * 128 + dg * 32;
#pragma unroll
        for (int q8 = 0; q8 < 4; ++q8) {
            f32x4 g0, g1; unpack8(*(const u32x4*)(gp + 8 * q8), g0, g1);
            const int d0 = dg * 32 + 8 * q8;
            const f32x4 lg0 = *(const f32x4*)(p->in[17] + hb * 128 + d0), lg1 = *(const f32x4*)(p->in[17] + hb * 128 + d0 + 4);
            const f32x4 lb0 = *(const f32x4*)(p->in[18] + hb * 128 + d0), lb1 = *(const f32x4*)(p->in[18] + hb * 128 + d0 + 4);
            g0 = (g0 - m_) * r_ * lg0 + lb0; g1 = (g1 - m_) * r_ * lg1 + lb1;
#pragma unroll
            for (int e = 0; e < 4; ++e) { vnT[(d0 + e) * 136 + s] = (bf16_t)(cvt_pk_bf16(g0[e], 0.f) & 0xffffu); vnT[(d0 + 4 + e) * 136 + s] = (bf16_t)(cvt_pk_bf16(g1[e], 0.f) & 0xffffu); }
        } }
    __syncthreads();
    {   const int fr = lane & 15, fq = lane >> 4, t = 16 * wave + fr, row = R0 + t;
        const bf16_t* W = (const bf16_t*)(ws + OFF_WSGU) + hb * 16384;
        f32x4 acc[8]; u32x2 gwv[8];
        const float bs = p->in[20][hb * 128 + t];
#pragma unroll
        for (int nb = 0; nb < 8; ++nb) { acc[nb] = (f32x4){0.f, 0.f, 0.f, 0.f}; gwv[nb] = *(const u32x2*)(Z + (size_t)row * 2048 + 1024 + hb * 128 + 16 * nb + 4 * fq); }
        for (int ks = 0; ks <= (wave >> 1); ++ks) {
            const bf16x8 wf = *(const bf16x8*)(W + t * 128 + 32 * ks + 8 * fq);
#pragma unroll
            for (int nb = 0; nb < 8; ++nb) { const bf16x8 vf = *(const LAS bf16x8*)(vnT + (16 * nb + fr) * 136 + 32 * ks + 8 * fq);
                acc[nb] = __builtin_amdgcn_mfma_f32_16x16x32_bf16(vf, wf, acc[nb], 0, 0, 0); } }
        float ss = 0.f;
#pragma unroll
        for (int nb = 0; nb < 8; ++nb) { const int d0 = hb * 128 + 16 * nb + 4 * fq; const u32x2 gw = gwv[nb];
            f32x4 v = (f32x4){bflo(gw.x), bfhi(gw.x), bflo(gw.y), bfhi(gw.y)} * (acc[nb] + bs);
            ss += sq4(v);
            *(u32x2*)((bf16_t*)(ws + OFF_Y) + (size_t)row * 1024 + 512 + d0) = (u32x2){cvt_pk_bf16(v[0], v[1]), cvt_pk_bf16(v[2], v[3])}; }
        ss = red_fq(ss);
        if (fq == 0) ((float*)(ws + OFF_SSQY))[(size_t)row * 16 + 8 + hb] = ss;
    }
    __syncthreads();
}
__device__ __forceinline__ void p2_taskBs(KP p, int q) {
    const int lane = threadIdx.x & 63, hb = lane >> 4;
    unsigned char* ws = p->ws;
    const bf16_t* Z = (const bf16_t*)(ws + OFF_Z);
    const f32x4 lg0 = *(const f32x4*)(p->in[17] + 8 * lane), lg1 = *(const f32x4*)(p->in[17] + 8 * lane + 4), lb0 = *(const f32x4*)(p->in[18] + 8 * lane), lb1 = *(const f32x4*)(p->in[18] + 8 * lane + 4);
    f32x4 vn[4][2];
#pragma unroll
    for (int t = 0; t < 4; ++t) {
        const int row = NP + 4 * q + t;
        const float* lp = (const float*)(ws + OFF_LNSTAT) + (size_t)row * 16;
        float s1 = 0.f, s2 = 0.f;
#pragma unroll
        for (int i = 0; i < 4; ++i) { const f32x4 v = *(const f32x4*)(lp + 4 * i); s1 += v[0] + v[2]; s2 += v[1] + v[3]; }
        const float mean = s1 * (1.0f / 512.0f), var = s2 * (1.0f / 512.0f) - mean * mean, r_ = rsqrtf(var + EPS);
        f32x4 g0, g1; unpack8(*(const u32x4*)(Z + (size_t)row * 2048 + 1536 + 8 * lane), g0, g1);
        vn[t][0] = (g0 - mean) * r_ * lg0 + lb0; vn[t][1] = (g1 - mean) * r_ * lg1 + lb1;
        float* op = p->out + O_VS + (size_t)(q * 4 + t) * 512 + 8 * lane;
        *(f32x4*)op = vn[t][0]; *(f32x4*)(op + 4) = vn[t][1];
    }
#pragma unroll
    for (int t = 0; t < 4; ++t) {
        const int row = NP + 4 * q + t;
        const float bs = p->in[20][hb * 128 + t];
        f32x4 m0 = {bs, bs, bs, bs}, m1 = m0;
#pragma unroll
        for (int s = 0; s <= t; ++s) { const float w = p->in[19][(size_t)(hb * 128 + t) * 128 + s]; m0 += w * vn[s][0]; m1 += w * vn[s][1]; }
        f32x4 g0, g1; unpack8(*(const u32x4*)(Z + (size_t)row * 2048 + 1024 + 8 * lane), g0, g1);
        g0 *= m0; g1 *= m1;
        float ss = sq4(g0) + sq4(g1);
        ss += __shfl_xor(ss, 1); ss += __shfl_xor(ss, 2); ss += __shfl_xor(ss, 4); ss += __shfl_xor(ss, 8);
        if ((lane & 15) == 0) ((float*)(ws + OFF_SSQY))[(size_t)row * 16 + 8 + hb] = ss;
        *(u32x4*)((bf16_t*)(ws + OFF_Y) + (size_t)row * 1024 + 512 + 8 * lane) = pack8(g0, g1);
    }
}
__device__ __forceinline__ void p2_phase(KP p, LAS unsigned char* lds, int lo = 0, int hi = 1584, int skip = 0) {
    int cur_hd = -1;
    for (int task = blockIdx.x; task < 1584; task += gridDim.x) {
        if (task < lo || task >= hi) continue;
        if (task < 1056 && (task & 7) != cur_hd) {
            cur_hd = task & 7;
            const bf16_t* Wg = (const bf16_t*)(p->ws + OFF_WG) + cur_hd * 8192;
            __syncthreads();
            for (int i = threadIdx.x; i < 1024; i += 512) { const int n = i >> 3, k8 = i & 7; *(LAS u32x4*)((LAS bf16_t*)(lds + 98304) + n * 72 + k8 * 8) = *(const u32x4*)(Wg + n * 64 + k8 * 8); }
            __syncthreads();
        }
        if (task < 1056) p2_taskA(p, lds, task, skip);
        else if (task < 1568) p2_taskB(p, lds, task - 1056);
        else p2_taskBs(p, (task - 1568) * 8 + (threadIdx.x >> 6));
    }
}

__device__ __forceinline__ f32x4 ld_bf4(const bf16_t* q) { const u32x2 w = *(const u32x2*)q; return (f32x4){bflo(w.x), bfhi(w.x), bflo(w.y), bfhi(w.y)}; }
__device__ __forceinline__ void p4b_tile(KP p, int pm) {
    unsigned char* ws = p->ws;
    const bf16_t* halo = (const bf16_t*)(ws + OFF_HALO); bf16_t* ACT = (bf16_t*)(ws + OFF_ACT);
    const float* cw = p->in[25]; const float* cb = p->in[26];
    for (int jj = threadIdx.x; jj < 768; jj += 512) {
        const int j = jj * 4;
        const f32x4 bg = *(const f32x4*)(cb + j), w0g = *(const f32x4*)(cw + j), w1g = *(const f32x4*)(cw + 6144 + j), w2g = *(const f32x4*)(cw + 12288 + j);
        const f32x4 bv = *(const f32x4*)(cb + 3072 + j), w0v = *(const f32x4*)(cw + 3072 + j), w1v = *(const f32x4*)(cw + 6144 + 3072 + j), w2v = *(const f32x4*)(cw + 12288 + 3072 + j);
#pragma unroll
        for (int gl = 0; gl < 4; ++gl) {
            const int g = pm * 4 + gl; const bool first = (g & 31) == 0;
            const f32x4 z4 = {0.f, 0.f, 0.f, 0.f};
            const bf16_t* hb = halo + (size_t)(g * 4) * 6144 + j; const bf16_t* tb = halo + (size_t)((g - 1) * 4 + 2) * 6144 + j;
            const f32x4 h0g = ld_bf4(hb), h1g = ld_bf4(hb + 6144), h0v = ld_bf4(hb + 3072), h1v = ld_bf4(hb + 6144 + 3072);
            const f32x4 t0g = first ? z4 : ld_bf4(tb), t1g = first ? z4 : ld_bf4(tb + 6144), t0v = first ? z4 : ld_bf4(tb + 3072), t1v = first ? z4 : ld_bf4(tb + 6144 + 3072);
            {   const f32x4 og = bg + w0g * t0g + w1g * t1g + w2g * h0g, ov = bv + w0v * t0v + w1v * t1v + w2v * h0v;
                *(u32x2*)(ACT + (size_t)(g * 64) * 3072 + j) = (u32x2){cvt_pk_bf16(gelu_t(og[0]) * ov[0], gelu_t(og[1]) * ov[1]), cvt_pk_bf16(gelu_t(og[2]) * ov[2], gelu_t(og[3]) * ov[3])}; }
            {   const f32x4 og = bg + w0g * t1g + w1g * h0g + w2g * h1g, ov = bv + w0v * t1v + w1v * h0v + w2v * h1v;
                *(u32x2*)(ACT + (size_t)(g * 64 + 1) * 3072 + j) = (u32x2){cvt_pk_bf16(gelu_t(og[0]) * ov[0], gelu_t(og[1]) * ov[1]), cvt_pk_bf16(gelu_t(og[2]) * ov[2], gelu_t(og[3]) * ov[3])}; }
        }
    }
}
__device__ __forceinline__ void p7_phase(KP p, int row_lo) {
    const int lane = threadIdx.x & 63, wave = threadIdx.x >> 6;
    const float* ssq = (const float*)(p->ws + OFF_SSQ3); const bf16_t* H3 = (const bf16_t*)(p->ws + OFF_H3);
    f32x4 gf[4];
#pragma unroll
    for (int i = 0; i < 2; ++i) { gf[2 * i] = *(const f32x4*)(p->in[31] + i * 512 + lane * 8); gf[2 * i + 1] = *(const f32x4*)(p->in[31] + i * 512 + lane * 8 + 4); }
    for (int r = row_lo + blockIdx.x * 8 + wave; r < NT; r += gridDim.x * 8) {
        const float rs = rsqrtf(sum16(ssq + (size_t)r * 16) * (1.0f / 1024.0f) + EPS);
        float* op = p->out + (size_t)r * 1024;
#pragma unroll
        for (int i = 0; i < 2; ++i) { f32x4 a, b; unpack8(*(const u32x4*)(H3 + (size_t)r * 1024 + i * 512 + lane * 8), a, b);
            *(f32x4*)(op + i * 512 + lane * 8) = a * rs * gf[2 * i]; *(f32x4*)(op + i * 512 + lane * 8 + 4) = b * rs * gf[2 * i + 1]; }
    }
}

__device__ __forceinline__ bool st_map(int i, int nct, int& rt, int& ct) {
    const int b = blockIdx.x;
    if (gridDim.x == 256) {
        const int xcd = b & 7, slot = b >> 3, cl = slot >> 3;
        rt = slot & 7;
        if (nct >= 32) { ct = i * 32 + xcd * 4 + cl; return ct < nct; }
        ct = xcd * 2 + cl; return i == 0 && cl < 2;
    }
    const int idx = i * gridDim.x + b; rt = idx & 7; ct = idx >> 3; return ct < nct;
}
#define ST_IDX(nct_) const int r = threadIdx.x >> 3, c = threadIdx.x & 7; (void)r; (void)c; int rt, ct; for (int it_ = 0; st_map(it_, (nct_), rt, ct); ++it_)
__device__ __forceinline__ void p1_small(KP p, LAS unsigned char* lds) {
    unsigned char* ws = p->ws;
    ST_IDX(32) {
        const int arow0 = NP + 64 * rt;
        const TileP T = st_tile((const bf16_t*)(ws + OFF_XB), 1024, arow0, (const bf16_t*)(ws + OFF_WIN), 1024, 64 * ct, 64 * ct + 16, 64 * ct + 32, 64 * ct + 48, 1024);
        Frags<4> F; st_load(F, T, 0);
        const int row = arow0 + r, col = 64 * ct + 8 * c, kind = ct >> 3;
        const float rs = ((const float*)(ws + OFF_RSTD1))[row];
        f32x4 acc[4][4]; st_zero(acc); st_mma(acc, F);
        f32x4 lo0, lo1, hi0, hi1; st_reduce(lds, acc, lo0, lo1, hi0, hi1);
        f32x4 v0 = lo0 + hi0, v1 = lo1 + hi1; float s1 = 0.f, s2 = 0.f;
        seg_z(kind, rs, v0, v1, s1, s2);
        *(u32x4*)((bf16_t*)(ws + OFF_Z) + (size_t)row * 2048 + col) = pack8(v0, v1);
        if (kind == 3) { s1 = red8(s1); s2 = red8(s2); if (c == 0) *(f32x2*)((float*)(ws + OFF_LNSTAT) + (size_t)row * 16 + (ct - 24) * 2) = (f32x2){s1, s2}; }
    }
}
__device__ __forceinline__ void p3_small(KP p, LAS unsigned char* lds) {
    unsigned char* ws = p->ws;
    ST_IDX(16) {
        const int arow0 = NP + 64 * rt;
        const TileP T = st_tile((const bf16_t*)(ws + OFF_Y), 1024, arow0, (const bf16_t*)(ws + OFF_WOUT), 1024, 64 * ct, 64 * ct + 16, 64 * ct + 32, 64 * ct + 48, 1024);
        Frags<4> F; st_load(F, T, 0);
        const int row = arow0 + r; const float* sp = (const float*)(ws + OFF_SSQY) + (size_t)row * 16;
        const f32x4 q0 = *(const f32x4*)sp, q1 = *(const f32x4*)(sp + 4), q2 = *(const f32x4*)(sp + 8);
        const size_t o = (size_t)row * 1024 + 64 * ct + 8 * c;
        const u32x4 xw = *(const u32x4*)((const bf16_t*)(ws + OFF_XB) + o);
        f32x4 acc[4][4]; st_zero(acc); st_mma(acc, F);
        f32x4 lo0, lo1, hi0, hi1; st_reduce(lds, acc, lo0, lo1, hi0, hi1);
        const float ra = rsqrtf((sum4(q0) + sum4(q1)) * (1.0f / 512.0f) + EPS), rb = rsqrtf(sum4(q2) * (1.0f / 512.0f) + EPS);
        f32x4 x0, x1; unpack8(xw, x0, x1);
        const f32x4 h0 = x0 + lo0 * ra + hi0 * rb, h1 = x1 + lo1 * ra + hi1 * rb;
        *(u32x4*)((bf16_t*)(ws + OFF_R3) + o) = pack8(h0, h1);
        const float ss = red8(sq4(h0) + sq4(h1));
        if (c == 0) ((float*)(ws + OFF_SSQ1))[(size_t)row * 16 + ct] = ss;
    }
}
__device__ __forceinline__ void p5_small(KP p, LAS unsigned char* lds, int mode = 0) {
    unsigned char* ws = p->ws;
    int tid_ = threadIdx.x; asm volatile("" : "+v"(tid_));
    const int tid = tid_, wave = tid >> 6, lane = tid & 63, fr = lane & 15, fq = lane >> 4;
    for (int idx = blockIdx.x; idx < 256; idx += gridDim.x) {
        int rt, ct;
        if (gridDim.x == 256) { const int xcd = idx & 7, slot = idx >> 3; rt = slot & 15; ct = xcd * 2 + (slot >> 4); } else { rt = idx & 15; ct = idx >> 4; }
        const int arow0 = NP + 32 * rt;
        const bf16_t* ap = (const bf16_t*)(ws + OFF_ACT) + (size_t)(arow0 + fr) * 3072 + wave * 384 + 8 * fq;
        const bf16_t* bp = (const bf16_t*)(ws + OFF_WDN) + (size_t)(64 * ct + fr) * 3072 + wave * 384 + 8 * fq;
        bf16x8 a0[2][2], b0[2][4], a1[2][2], b1[2][4];
#define P5S_LOAD(A_, B_, s0) do { _Pragma("unroll") for (int s = 0; s < 2; ++s) { _Pragma("unroll") for (int i = 0; i < 2; ++i) A_[s][i] = *(const bf16x8*)(ap + (size_t)(16 * i) * 3072 + ((s0) + s) * 32); \
            _Pragma("unroll") for (int j = 0; j < 4; ++j) B_[s][j] = *(const bf16x8*)(bp + (size_t)(16 * j) * 3072 + ((s0) + s) * 32); } } while (0)
#define P5S_MMA(A_, B_) do { _Pragma("unroll") for (int s = 0; s < 2; ++s) _Pragma("unroll") for (int i = 0; i < 2; ++i) _Pragma("unroll") for (int j = 0; j < 4; ++j) \
            acc[i][j] = __builtin_amdgcn_mfma_f32_16x16x32_bf16(B_[s][j], A_[s][i], acc[i][j], 0, 0, 0); } while (0)
        P5S_LOAD(a0, b0, 0); P5S_LOAD(a1, b1, 2);
        const int r = tid >> 4, c4 = tid & 15, row = arow0 + r;
        bf16_t* hp = (bf16_t*)(ws + OFF_R3) + (size_t)row * 1024 + 64 * ct + 4 * c4;
        const u32x2 xw = *(const u32x2*)hp;
        f32x4 acc[2][4];
#pragma unroll
        for (int i = 0; i < 2; ++i)
#pragma unroll
            for (int j = 0; j < 4; ++j) acc[i][j] = (f32x4){0.f, 0.f, 0.f, 0.f};
#pragma unroll
        for (int s0 = 0; s0 < 12; s0 += 4) { P5S_MMA(a0, b0); if (s0 + 4 < 12) P5S_LOAD(a0, b0, s0 + 4); P5S_MMA(a1, b1); if (s0 + 6 < 12) P5S_LOAD(a1, b1, s0 + 6); }
#undef P5S_LOAD
#undef P5S_MMA
        LAS float* P = (LAS float*)lds + wave * 2048;
#pragma unroll
        for (int i = 0; i < 2; ++i)
#pragma unroll
            for (int j = 0; j < 4; ++j) { const int rr = 16 * i + fr, ch = (4 * j + fq) ^ fr; *(LAS f32x4*)(P + rr * 64 + ch * 4) = acc[i][j]; }
        __syncthreads();
        f32x4 sum = {0.f, 0.f, 0.f, 0.f};
        {   LAS const float* Q = (LAS const float*)lds + r * 64 + ((c4 ^ (r & 15)) * 4);
#pragma unroll
            for (int w = 0; w < 8; ++w) sum += *(LAS const f32x4*)(Q + w * 2048); }
        __syncthreads();
        const f32x4 h = (f32x4){bflo(xw.x), bfhi(xw.x), bflo(xw.y), bfhi(xw.y)} + sum;
        float ss = sq4(h); ss += __shfl_xor(ss, 1); ss += __shfl_xor(ss, 2); ss += __shfl_xor(ss, 4); ss += __shfl_xor(ss, 8);
        if (mode) { asm volatile("" :: "v"(ss), "v"(h[0])); continue; }
        *(u32x2*)hp = (u32x2){cvt_pk_bf16(h[0], h[1]), cvt_pk_bf16(h[2], h[3])};
        if (c4 == 0) ((float*)(ws + OFF_SSQ2))[(size_t)row * 16 + ct] = ss;
    }
}
__device__ __forceinline__ void p6_small(KP p, LAS unsigned char* lds, bool fuse) {
    unsigned char* ws = p->ws;
    ST_IDX(16) {
        const int arow0 = NP + 64 * rt;
        const TileP T = st_tile((const bf16_t*)(ws + OFF_R3), 1024, arow0, (const bf16_t*)(ws + OFF_WPG), 1024, 64 * ct, 64 * ct + 16, 64 * ct + 32, 64 * ct + 48, 1024);
        Frags<4> F; st_load(F, T, 0);
        const int row = arow0 + r; const float* sp = (const float*)(ws + OFF_SSQ2) + (size_t)row * 16;
        const f32x4 q0 = *(const f32x4*)sp, q1 = *(const f32x4*)(sp + 4), q2 = *(const f32x4*)(sp + 8), q3 = *(const f32x4*)(sp + 12);
        const size_t o = (size_t)row * 1024 + 64 * ct + 8 * c;
        const u32x4 ew = *(const u32x4*)((const bf16_t*)(ws + OFF_E) + o), xw = *(const u32x4*)((const bf16_t*)(ws + OFF_R3) + o);
        f32x4 acc[4][4]; st_zero(acc); st_mma(acc, F);
        f32x4 lo0, lo1, hi0, hi1; st_reduce(lds, acc, lo0, lo1, hi0, hi1);
        const float rs = rsqrtf(((sum4(q0) + sum4(q1)) + (sum4(q2) + sum4(q3))) * (1.0f / 1024.0f) + EPS);
        f32x4 e0, e1, x0, x1; unpack8(ew, e0, e1); unpack8(xw, x0, x1);
        f32x4 g0 = (lo0 + hi0) * rs, g1 = (lo1 + hi1) * rs;
#pragma unroll
        for (int e = 0; e < 4; ++e) { g0[e] = sigmoidf_(g0[e]); g1[e] = sigmoidf_(g1[e]); }
        const f32x4 h0 = x0 + e0 * g0, h1 = x1 + e1 * g1;
        const float ss = red8(sq4(h0) + sq4(h1));
        if (!fuse) {
            *(u32x4*)((bf16_t*)(ws + OFF_H3) + o) = pack8(h0, h1);
            if (c == 0) ((float*)(ws + OFF_SSQ3))[(size_t)row * 16 + ct] = ss;
        } else {
            float* X2 = (float*)(ws + OFF_SSQ3) + 65536 + (size_t)rt * 1024;
            unsigned* cnt2 = (unsigned*)(ws + OFF_FLAG) + 1016 + rt;
            if (c == 0) __hip_atomic_store((unsigned*)(X2 + ct * 64 + r), __float_as_uint(ss), __ATOMIC_RELAXED, __HIP_MEMORY_SCOPE_AGENT);
            asm volatile("s_waitcnt vmcnt(0)" ::: "memory");
            __syncthreads();
            if (threadIdx.x == 0) { __hip_atomic_fetch_add(cnt2, 1u, __ATOMIC_RELAXED, __HIP_MEMORY_SCOPE_AGENT); unsigned sp = 0;
                while (__hip_atomic_load(cnt2, __ATOMIC_RELAXED, __HIP_MEMORY_SCOPE_AGENT) < 16u) { __builtin_amdgcn_s_sleep(1); if (++sp > (1u << 22)) break; } }
            __syncthreads();
            float tot = __uint_as_float(__hip_atomic_load((const unsigned*)(X2 + (2 * c) * 64 + r), __ATOMIC_RELAXED, __HIP_MEMORY_SCOPE_AGENT))
                      + __uint_as_float(__hip_atomic_load((const unsigned*)(X2 + (2 * c + 1) * 64 + r), __ATOMIC_RELAXED, __HIP_MEMORY_SCOPE_AGENT));
            tot = red8(tot);
            const float r4 = rsqrtf(tot * (1.0f / 1024.0f) + EPS);
            const int col = 64 * ct + 8 * c;
            float* yp = p->out + O_Y + (size_t)row * 1024 + col;
            *(f32x4*)yp = h0 * r4 * *(const f32x4*)(p->in[31] + col); *(f32x4*)(yp + 4) = h1 * r4 * *(const f32x4*)(p->in[31] + col + 4);
        }
    }
}
__device__ __forceinline__ void p4s_issue(unsigned char* ws, int rt, int s96, Frags<4>& F, int& arow0, int& jc0) {
    const int pn = s96 >> 2, s = s96 & 3, nb = 256 * pn + 32 * s;
    arow0 = NP + 64 * rt; jc0 = 128 * pn + 32 * s;
    const TileP T = st_tile((const bf16_t*)(ws + OFF_R3), 1024, arow0, (const bf16_t*)(ws + OFF_WUP), 1024, nb, nb + 16, nb + 128, nb + 144, 1024);
    st_load(F, T, 0);
}
__device__ __forceinline__ void pe_small(KP p, LAS unsigned char* lds) {
    unsigned char* ws = p->ws;
    ST_IDX(16) {
        const int arow0 = NP + 64 * rt;
        const TileP T = st_tile((const bf16_t*)(ws + OFF_PB), 256, arow0, (const bf16_t*)(ws + OFF_WPLE), 256, 64 * ct, 64 * ct + 16, 64 * ct + 32, 64 * ct + 48, 256);
        Frags<1> F; st_load(F, T, 0);
        f32x4 acc[4][4]; st_zero(acc); st_mma(acc, F);
        f32x4 lo0, lo1, hi0, hi1; st_reduce(lds, acc, lo0, lo1, hi0, hi1);
        *(u32x4*)((bf16_t*)(ws + OFF_E) + (size_t)(arow0 + r) * 1024 + 64 * ct + 8 * c) = pack8(lo0 + hi0, lo1 + hi1);
    }
}
__device__ __forceinline__ void p4_small(KP p, LAS unsigned char* lds, int mode = 0) {
    unsigned char* ws = p->ws; const int r = threadIdx.x >> 3, c = threadIdx.x & 7;
    const float* cw = p->in[25]; const float* cb = p->in[26]; const float* st = p->in[6];
    int it = 0, rt, ct; if (!st_map(0, 96, rt, ct)) return;
    Frags<4> F; int arow0, jc0; p4s_issue(ws, rt, ct, F, arow0, jc0);
    for (;;) {
        const int row = arow0 + r;
        const float rs = rsqrtf(sum16((const float*)(ws + OFF_SSQ1) + (size_t)row * 16) * (1.0f / 1024.0f) + EPS);
        f32x4 acc[4][4]; st_zero(acc); st_mma(acc, F);
        const bool more = st_map(it + 1, 96, rt, ct);
        int narow0 = 0, njc0 = 0; if (more) p4s_issue(ws, rt, ct, F, narow0, njc0);
        f32x4 lo0, lo1, hi0, hi1;
        if (mode == 2) { lo0 = acc[0][0]; lo1 = acc[0][1]; hi0 = acc[1][0]; hi1 = acc[1][1]; } else st_reduce(lds, acc, lo0, lo1, hi0, hi1);
        if (mode == 1) { asm volatile("" :: "v"(lo0[0] + lo1[0] + hi0[0] + hi1[0])); } else {
            LAS float* U = (LAS float*)lds;
            *(LAS f32x4*)(U + r * 68 + 8 * c) = (lo0 + hi0) * rs; *(LAS f32x4*)(U + r * 68 + 8 * c + 4) = (lo1 + hi1) * rs;
            __syncthreads();
            {   const int jc = jc0 + 4 * c, t = r & 3, q = (row - NP) >> 2;
                const f32x4 cg = *(LAS const f32x4*)(U + r * 68 + 4 * c), cv = *(LAS const f32x4*)(U + r * 68 + 32 + 4 * c);
                f32x4 x1g, x1v, x2g, x2v;
                if (t >= 1) { x1g = *(LAS const f32x4*)(U + (r - 1) * 68 + 4 * c); x1v = *(LAS const f32x4*)(U + (r - 1) * 68 + 32 + 4 * c); }
                else { x1g = *(const f32x4*)(st + (size_t)(q * 2 + 1) * 6144 + jc); x1v = *(const f32x4*)(st + (size_t)(q * 2 + 1) * 6144 + 3072 + jc); }
                if (t >= 2) { x2g = *(LAS const f32x4*)(U + (r - 2) * 68 + 4 * c); x2v = *(LAS const f32x4*)(U + (r - 2) * 68 + 32 + 4 * c); }
                else { x2g = *(const f32x4*)(st + (size_t)(q * 2 + t) * 6144 + jc); x2v = *(const f32x4*)(st + (size_t)(q * 2 + t) * 6144 + 3072 + jc); }
                const f32x4 og = *(const f32x4*)(cb + jc) + *(const f32x4*)(cw + jc) * x2g + *(const f32x4*)(cw + 6144 + jc) * x1g + *(const f32x4*)(cw + 12288 + jc) * cg;
                const f32x4 ov = *(const f32x4*)(cb + 3072 + jc) + *(const f32x4*)(cw + 3072 + jc) * x2v + *(const f32x4*)(cw + 6144 + 3072 + jc) * x1v + *(const f32x4*)(cw + 12288 + 3072 + jc) * cv;
                const float a0 = gelu_t(og[0]) * ov[0], a1 = gelu_t(og[1]) * ov[1], a2 = gelu_t(og[2]) * ov[2], a3 = gelu_t(og[3]) * ov[3];
                *(u32x2*)((bf16_t*)(ws + OFF_ACT) + (size_t)row * 3072 + jc) = (u32x2){cvt_pk_bf16(a0, a1), cvt_pk_bf16(a2, a3)};
                if (t >= 2) { float* op = p->out + O_FS + (size_t)(q * 2 + t - 2) * 6144 + jc; *(f32x4*)op = cg; *(f32x4*)(op + 3072) = cv; }
            }
            __syncthreads();
        }
        if (!more) break;
        arow0 = narow0; jc0 = njc0; ++it;
    }
}
#ifndef GP1_ALIGN
#define GP1_ALIGN true
#endif
#ifndef GP1_SP2
#define GP1_SP2 true
#endif
#ifndef GP3_ALIGN
#define GP3_ALIGN false
#endif
#ifndef GP3_SP2
#define GP3_SP2 true
#endif
#ifndef GP4_ALIGN
#define GP4_ALIGN true
#endif
#ifndef GP4_SP2
#define GP4_SP2 true
#endif
#ifndef GP5_ALIGN
#define GP5_ALIGN false
#endif
#ifndef GP5_SP2
#define GP5_SP2 true
#endif
#ifndef GPE_ALIGN
#define GPE_ALIGN false
#endif
#ifndef GPE_SP2
#define GPE_SP2 true
#endif
#ifndef GP6_ALIGN
#define GP6_ALIGN false
#endif
#ifndef GP6_SP2
#define GP6_SP2 true
#endif
#ifndef REP
#define REP 0
#endif
#if REP
__device__ __forceinline__ int rep_count(int bit) { int n = ((REP >> bit) & 1) ? 2 : 1; asm volatile("" : "+s"(n)); return n; }
#define REPEAT(bit) for (int nrep_ = rep_count(bit), rep_ = 0; rep_ < nrep_; ++rep_)
#else
#define REPEAT(bit)
#endif
template <class S> __device__ __forceinline__ void fill_tab_rstd(LAS float* tab, const S& sched, const float* ssq, float invn) {
    Unit u; const int r = threadIdx.x & 255;
    for (int i = threadIdx.x >> 8; sched.next(i, u); i += 2) {
        const float* sp = ssq + (size_t)(u.pm * 256 + r) * 16;
        tab[i * 256 + r] = rsqrtf(sum16(sp) * invn + EPS); }
    __syncthreads();
}

__global__ void __launch_bounds__(512) mega(Params p_) {
    KP p = (KP)__builtin_amdgcn_kernarg_segment_ptr();
#define FRESH_P() asm volatile("" : "+s"(p))
    extern __shared__ __attribute__((aligned(16))) unsigned char lds_raw[];
    LAS unsigned char* lds = (LAS unsigned char*)lds_raw;
    const int tid = threadIdx.x, G = gridDim.x, blk = blockIdx.x;
    volatile LAS unsigned* st = (volatile LAS unsigned*)(lds + LDS_X);
    if (tid < 4) st[tid] = 0u;
    __syncthreads();
    unsigned char* ws = p->ws;
    XcdBarrier bar = xcd_barrier_post((unsigned*)(ws + OFF_BAR), st);
    LAS float* tab = (LAS float*)(lds + LDS_X + 256);
#define GRID_BAR() do { if (p_.use_cg) cg::this_grid().sync(); else xcd_barrier(bar); } while (0)

    REPEAT(0) { p0_phase(p, lds); __syncthreads(); }
    GRID_BAR();
    FRESH_P(); ws = p->ws;
    {   pg8::Gemm g{(const bf16_t*)(ws + OFF_XB), (const bf16_t*)(ws + OFF_WIN), NP, 2048, 1024};
        pg8::StaticOrder S; S.init(NP, 2048, G, blk);
        EpiZ E{(bf16_t*)(ws + OFF_Z), (const float*)(ws + OFF_RSTD1), (float*)(ws + OFF_LNSTAT)};
        pg8::gemm_phase<EpiZ, pg8::StaticOrder, GP1_ALIGN, GP1_SP2>(lds, g, S, E);
        p1_small(p, lds);
    }
    GRID_BAR();
    FRESH_P(); ws = p->ws;
#if REP & 4
    { int lo = (PMODE == 1) ? 0 : 1056, hi = (PMODE == 1) ? 1024 : 1568; int sk = PSKIP; asm volatile("" : "+s"(lo), "+s"(hi), "+s"(sk)); p2_phase(p, lds, lo, hi, sk); __syncthreads(); }
#endif
    p2_phase(p, lds);
    GRID_BAR();
    FRESH_P(); ws = p->ws;
    {   pg8::StaticOrder S; S.init(NP, 1024, G, blk);
        LAS f32x2* tab2 = (LAS f32x2*)tab;
        {   Unit u; const float* sq = (const float*)(ws + OFF_SSQY);
            for (int i = 0; S.next(i, u); ++i)
                if (tid < 256) { const float* sp = sq + (size_t)(u.pm * 256 + tid) * 16;
                    const float sa = sum4(*(const f32x4*)sp) + sum4(*(const f32x4*)(sp + 4)), sb = sum4(*(const f32x4*)(sp + 8));
                    const float ra = rsqrtf(sa * (1.0f / 512.0f) + EPS), rb = rsqrtf(sb * (1.0f / 512.0f) + EPS);
                    tab2[i * 256 + tid] = (f32x2){ra / rb, rb}; }
            __syncthreads(); }
        pg8::Gemm g{(const bf16_t*)(ws + OFF_Y), (const bf16_t*)(ws + OFF_WOUT), NP, 1024, 1024};
        EpiH1 E{(const bf16_t*)(ws + OFF_XB), (bf16_t*)(ws + OFF_R3), (float*)(ws + OFF_SSQ1), tab2};
        REPEAT(3) { pg8::gemm_phase<EpiH1, pg8::StaticOrder, GP3_ALIGN, GP3_SP2>(lds, g, S, E); }
        REPEAT(10) { p3_small(p, lds); }
    }
    GRID_BAR();
    FRESH_P(); ws = p->ws;
    {   pg8::StaticOrder S; S.init(NP, 6144, G, blk);
        fill_tab_rstd(tab, S, (const float*)(ws + OFF_SSQ1), 1.0f / 1024.0f);
        pg8::Gemm g{(const bf16_t*)(ws + OFF_R3), (const bf16_t*)(ws + OFF_WUP), NP, 6144, 1024};
        EpiUp E{(bf16_t*)(ws + OFF_ACT), tab, p->in[25], p->in[26], (bf16_t*)(ws + OFF_HALO), p->out + O_FP, 0};
        pg8::gemm_phase<EpiUp, pg8::StaticOrder, GP4_ALIGN, GP4_SP2>(lds, g, S, E);
#if REP & 4096
        { int md = PMODE; asm volatile("" : "+s"(md)); p4_small(p, lds, md); }
#endif
        p4_small(p, lds);
    }
    GRID_BAR();
    FRESH_P(); ws = p->ws;
    {   pg8::StaticOrder S; S.init(NP, 1024, G, blk);
        {   Unit u; int last = -1;
            for (int i = 0; S.next(i, u); ++i) if (u.pm != last) { p4b_tile(p, u.pm); last = u.pm; }
            asm volatile("s_waitcnt vmcnt(0)" ::: "memory"); __syncthreads(); }
        pg8::Gemm g{(const bf16_t*)(ws + OFF_ACT), (const bf16_t*)(ws + OFF_WDN), NP, 1024, 3072};
        EpiH2 E{(bf16_t*)(ws + OFF_R3), (float*)(ws + OFF_SSQ2)};
        pg8::gemm_phase<EpiH2, pg8::StaticOrder, GP5_ALIGN, GP5_SP2>(lds, g, S, E);
#if REP & 8192
        { int md = 1; asm volatile("" : "+s"(md)); p5_small(p, lds, md); }
#endif
        p5_small(p, lds);
        pg8::Gemm g2{(const bf16_t*)(ws + OFF_PB), (const bf16_t*)(ws + OFF_WPLE), NP, 1024, 256};
        pg8::StaticOrder S2; S2.init(NP, 1024, G, blk);
        EpiE E2{(bf16_t*)(ws + OFF_E)};
        REPEAT(11) { pg8::gemm_phase<EpiE, pg8::StaticOrder, GPE_ALIGN, GPE_SP2>(lds, g2, S2, E2); }
        pe_small(p, lds);
    }
    GRID_BAR();
    FRESH_P(); ws = p->ws;
    {   pg8::StaticOrder S; S.init(NP, 1024, G, blk);
        fill_tab_rstd(tab, S, (const float*)(ws + OFF_SSQ2), 1.0f / 1024.0f);
        pg8::Gemm g{(const bf16_t*)(ws + OFF_R3), (const bf16_t*)(ws + OFF_WPG), NP, 1024, 1024};
        if (G == 256) {
            EpiGF E{(const bf16_t*)(ws + OFF_R3), (const bf16_t*)(ws + OFF_E), p->out + O_Y, p->in[31], (float*)(ws + OFF_SSQ3), (unsigned*)(ws + OFF_FLAG), tab};
            pg8::gemm_phase<EpiGF, pg8::StaticOrder, false, GP6_SP2>(lds, g, S, E);
        } else {
            EpiG E{(const bf16_t*)(ws + OFF_R3), (const bf16_t*)(ws + OFF_E), (bf16_t*)(ws + OFF_H3), (float*)(ws + OFF_SSQ3), tab};
            pg8::gemm_phase<EpiG, pg8::StaticOrder, GP6_ALIGN, GP6_SP2>(lds, g, S, E);
        }
        p6_small(p, lds, G == 256);
    }
    if (G != 256) {
        GRID_BAR();
        FRESH_P(); ws = p->ws;
        p7_phase(p, 0);
    }
}

extern "C" void kernel_launch(void* const* d_in, const int* in_sizes, int n_in, void* d_out, int out_size, void* d_ws, size_t ws_size, hipStream_t stream) {
    static int grid = 0;
    if (grid == 0) {
        if (n_in != 32 || out_size != (int)O_END || ws_size < WS_END) { fprintf(stderr, "kernel_launch: unexpected shapes (n_in %d out %d ws %zu, need ws %zu)\n", n_in, out_size, ws_size, (size_t)WS_END); grid = -1; return; }
        int dev = 0, cus = 0, per_cu = 0;
        if (hipGetDevice(&dev) != hipSuccess || hipDeviceGetAttribute(&cus, hipDeviceAttributeMultiprocessorCount, dev) != hipSuccess) { grid = -1; return; }
        if (hipFuncSetAttribute((const void*)mega, hipFuncAttributeMaxDynamicSharedMemorySize, LDS_BYTES) != hipSuccess) { fprintf(stderr, "kernel_launch: hipFuncSetAttribute failed\n"); grid = -1; return; }
        if (hipOccupancyMaxActiveBlocksPerMultiprocessor(&per_cu, (const void*)mega, 512, LDS_BYTES) != hipSuccess || per_cu < 1) { fprintf(stderr, "kernel_launch: occupancy query says %d\n", per_cu); (void)hipGetLastError(); grid = -1; return; }
        grid = cus;
    }
    if (grid < 0) return;
    (void)hipMemsetAsync(d_ws, 0, CTL_BYTES, stream);
    Params hp{};
    for (int i = 0; i < 32; ++i) hp.in[i] = (const float*)d_in[i];
    hp.out = (float*)d_out; hp.ws = (unsigned char*)d_ws; hp.use_cg = 0; hp.pad = 0;
    void* args[] = {&hp};
    hipError_t e = hipLaunchCooperativeKernel((const void*)mega, dim3(grid), dim3(512), args, LDS_BYTES, stream);
    if (e != hipSuccess) fprintf(stderr, "kernel_launch: cooperative launch failed: %s (grid %d)\n", hipGetErrorString(e), grid);
}
```

```cpp
#ifndef REP
#define REP 0
#endif
#ifndef PSKIP
#define PSKIP 0
#endif
#ifndef PMODE
#define PMODE 0
#endif
#include <hip/hip_runtime.h>
#include <hip/hip_cooperative_groups.h>
#include <cstdio>
namespace cg = cooperative_groups;
#define LAS __attribute__((address_space(3)))
typedef unsigned short bf16_t;
typedef short bf16x8 __attribute__((ext_vector_type(8)));
typedef float f32x4 __attribute__((ext_vector_type(4)));
typedef float f32x2 __attribute__((ext_vector_type(2)));
typedef unsigned u32x4 __attribute__((ext_vector_type(4)));
typedef unsigned u32x2 __attribute__((ext_vector_type(2)));

constexpr int D = 1024, NP = 16384, NS = 512, NT = 16896, SEQ = 2048, NBP = 8, NBS = 128;
constexpr int WA = 512, DFF = 3072, PLE = 256;
constexpr float EPS = 1e-6f;
constexpr size_t O_Y = 0;
constexpr size_t O_HP = 17301504, O_HS = 17305600, O_CP = 17371136, O_CS = 17383424, O_VS = 17580032, O_FP = 17842176, O_FS = 17940480, O_END = 19513344;
constexpr size_t OFF_BAR = 0, OFF_FLAG = 16384, CTL_BYTES = 32768;
constexpr size_t OFF_WIN = 32768;
constexpr size_t OFF_WOUT = OFF_WIN + (size_t)2048 * 1024 * 2;
constexpr size_t OFF_WUP = OFF_WOUT + (size_t)1024 * 1024 * 2;
constexpr size_t OFF_WDN = OFF_WUP + (size_t)6144 * 1024 * 2;
constexpr size_t OFF_WPG = OFF_WDN + (size_t)1024 * 3072 * 2;
constexpr size_t OFF_WPLE = OFF_WPG + (size_t)1024 * 1024 * 2;
constexpr size_t OFF_WG = OFF_WPLE + (size_t)1024 * 256 * 2;
constexpr size_t OFF_WSGU = OFF_WG + (size_t)8 * 128 * 64 * 2;
constexpr size_t OFF_RSTD1 = OFF_WSGU + (size_t)4 * 128 * 128 * 2;
constexpr size_t OFF_SP = OFF_RSTD1 + 98304;
constexpr size_t OFF_LNSTAT = OFF_RSTD1 + 131072;
constexpr size_t STAT_BYTES = (size_t)NT * 16 * 4;
constexpr size_t OFF_SSQY = OFF_LNSTAT + STAT_BYTES;
constexpr size_t OFF_SSQ1 = OFF_SSQY + STAT_BYTES;
constexpr size_t OFF_SSQ2 = OFF_SSQ1 + STAT_BYTES;
constexpr size_t OFF_SSQ3 = OFF_SSQ2 + STAT_BYTES;
constexpr size_t OFF_AGG = OFF_SSQ3 + STAT_BYTES;
constexpr size_t OFF_HALO = OFF_AGG + (size_t)1024 * 128 * 4;
constexpr size_t OFF_PB = OFF_HALO + (size_t)264 * 4 * 6144 * 4;
constexpr size_t OFF_R1 = OFF_PB + (size_t)NT * 256 * 2;
constexpr size_t OFF_XB = OFF_R1, OFF_Z = OFF_R1 + (size_t)NT * 1024 * 2, OFF_ACT = OFF_R1, OFF_H3 = OFF_R1;
constexpr size_t OFF_R3 = OFF_R1 + (size_t)NT * 3072 * 2;
constexpr size_t OFF_E = OFF_R3 + (size_t)NT * 1024 * 2, OFF_Y = OFF_E;
constexpr size_t WS_END = OFF_E + (size_t)NT * 1024 * 2;

constexpr int LDS_BYTES = 155648, LDS_X = 131072;

struct Params {
    const float* in[32];
    float* out;
    unsigned char* ws;
    int use_cg;
    int pad;
};

typedef const __attribute__((address_space(4))) Params* KP;

__device__ __forceinline__ unsigned cvt_pk_bf16(float lo, float hi) { unsigned r; asm volatile("v_cvt_pk_bf16_f32 %0, %1, %2" : "=v"(r) : "v"(lo), "v"(hi)); return r; }
__device__ __forceinline__ float bflo(unsigned w) { return __uint_as_float(w << 16); }
__device__ __forceinline__ float bfhi(unsigned w) { return __uint_as_float(w & 0xffff0000u); }
__device__ __forceinline__ float bf2f(bf16_t v) { return __uint_as_float((unsigned)v << 16); }
__device__ __forceinline__ float sigmoidf_(float x) { return __builtin_amdgcn_rcpf(1.0f + __builtin_amdgcn_exp2f(-1.4426950409f * x)); }
__device__ __forceinline__ float gelu_t(float x) {
    const float u = x * (-2.3022082f - 0.1029432f * x * x);
    return x * __builtin_amdgcn_rcpf(1.0f + __builtin_amdgcn_exp2f(u));
}
__device__ __forceinline__ f32x2 gelu2(f32x2 x) {
    const f32x2 u = x * ((x * x) * (-0.1029432f) + (-2.3022082f));
    f32x2 e; e.x = __builtin_amdgcn_exp2f(u.x); e.y = __builtin_amdgcn_exp2f(u.y);
    const f32x2 d = e + 1.0f;
    f32x2 r; r.x = __builtin_amdgcn_rcpf(d.x); r.y = __builtin_amdgcn_rcpf(d.y);
    return x * r;
}
__device__ __forceinline__ f32x4 gelu4(f32x4 v) { const f32x2 a = gelu2((f32x2){v[0], v[1]}), b = gelu2((f32x2){v[2], v[3]}); return (f32x4){a.x, a.y, b.x, b.y}; }
__device__ __forceinline__ float wave_sum(float v) {
#pragma unroll
    for (int o = 32; o >= 1; o >>= 1) v += __shfl_xor(v, o);
    return v;
}
template <int CTRL> __device__ __forceinline__ float dppf(float v) { return __int_as_float(__builtin_amdgcn_update_dpp(0, __float_as_int(v), CTRL, 0xf, 0xf, false)); }

#define XB_TMO      128
#define XB_XCNT(j)  (256  + 64 * (j))
#define XB_XSUB(j)  (1280 + 64 * (j))
#define XB_XGEN(j)  (2304 + 64 * (j))
#define XB_TOP      3328
#define XB_TOPGEN   3392
#define XCD_BAR_WORDS 3456
#define XB_SPIN_CAP (1u << 20)
__device__ __forceinline__ unsigned xb_ld(unsigned* p)              { return __hip_atomic_load(p, __ATOMIC_RELAXED, __HIP_MEMORY_SCOPE_AGENT); }
__device__ __forceinline__ unsigned xb_add(unsigned* p, unsigned v) { return __hip_atomic_fetch_add(p, v, __ATOMIC_RELAXED, __HIP_MEMORY_SCOPE_AGENT); }
__device__ __forceinline__ unsigned xb_xcc_id() { return (unsigned)__builtin_amdgcn_s_getreg((3 << 11) | 20) & 0xFu; }
#define XB_SPIN(cond, bar) do { unsigned _sp = 0; while (cond) { __builtin_amdgcn_s_sleep(1); \
    if ((++_sp & 255u) == 0u) { if (xb_ld(&(bar)[XB_TMO])) break; if (_sp > XB_SPIN_CAP) { atomicAdd(&(bar)[XB_TMO], 1u); break; } } } } while (0)
struct XcdBarrier { unsigned* bar; unsigned x; volatile LAS unsigned* st; };
__device__ __forceinline__ XcdBarrier xcd_barrier_post(unsigned* bar, volatile LAS unsigned* st) {
    XcdBarrier b; b.bar = bar; b.x = xb_xcc_id(); b.st = st;
    if (threadIdx.x == 0) (void)xb_add(&bar[XB_XCNT(b.x)], 1u);
    return b;
}
__device__ __forceinline__ void xcd_barrier_complete(unsigned* bar, unsigned x, unsigned& nloc, unsigned& nx) {
    const unsigned G = gridDim.x * gridDim.y * gridDim.z;
    unsigned sum, cnt, mine, sp = 0u;
    for (;;) {
        sum = 0u; cnt = 0u; mine = 0u;
#pragma unroll
        for (unsigned j = 0; j < 16; ++j) { const unsigned c = xb_ld(&bar[XB_XCNT(j)]); sum += c; cnt += (c > 0u) ? 1u : 0u; mine = (j == x) ? c : mine; }
        if (sum == G) break;
        __builtin_amdgcn_s_sleep(1);
        if ((++sp & 255u) == 0u) { if (xb_ld(&bar[XB_TMO])) break; if (sp > XB_SPIN_CAP) { atomicAdd(&bar[XB_TMO], 1u); break; } }
    }
    nloc = mine > 0u ? mine : 1u; nx = cnt > 0u ? cnt : 1u;
}
__device__ __forceinline__ void xcd_barrier(const XcdBarrier& b) {
    asm volatile("s_waitcnt vmcnt(0)" ::: "memory");
    __syncthreads();
    if (threadIdx.x == 0) {
        unsigned* bar = b.bar;
        __builtin_amdgcn_s_waitcnt(0);
        unsigned nloc = b.st[0], nx = b.st[1];
        if (nloc == 0u) { xcd_barrier_complete(bar, b.x, nloc, nx); b.st[0] = nloc; b.st[1] = nx; }
        const unsigned old = xb_add(&bar[XB_XSUB(b.x)], 1u);
        const unsigned gen = old / nloc;
        if (old + 1u == (gen + 1u) * nloc) {
            __builtin_amdgcn_fence(__ATOMIC_RELEASE, "agent");
            asm volatile("s_waitcnt vmcnt(0)" ::: "memory");
            const unsigned og = xb_add(&bar[XB_TOP], 1u);
            const unsigned tg = og / nx;
            if (og + 1u == (tg + 1u) * nx) xb_add(&bar[XB_TOPGEN], 1u);
            else XB_SPIN(xb_ld(&bar[XB_TOPGEN]) == tg, bar);
            __builtin_amdgcn_fence(__ATOMIC_ACQUIRE, "agent");
            xb_add(&bar[XB_XGEN(b.x)], 1u);
            asm volatile("s_waitcnt vmcnt(0)" ::: "memory");
        } else {
            XB_SPIN(xb_ld(&bar[XB_XGEN(b.x)]) == gen, bar);
            __builtin_amdgcn_fence(__ATOMIC_ACQUIRE, "agent");
            asm volatile("s_waitcnt vmcnt(0)" ::: "memory");
        }
    }
    __syncthreads();
}
namespace pg8 {
constexpr int BM = 256, BK = 64, HALF = 128, HTB = HALF * BK * 2, STAGE_BYTES = 8 * HTB, NXCD = 8, WGM = 8;
__device__ __forceinline__ int lds_byte(int r, int c) { const int st = (r >> 4) * 2 + (c >> 5), rr = r & 15, cc = c & 31, ob = rr * 64 + cc * 2; return st * 1024 + (ob ^ (((ob >> 9) & 1) << 5)); }
__device__ __forceinline__ void stage_rc(int b, int& R, int& C) { const int st = b / 1024, sb = b % 1024, swz = sb ^ (((sb >> 9) & 1) << 5); R = (st >> 1) * 16 + swz / 64; C = (st & 1) * 32 + (swz % 64) / 2; }
__device__ __forceinline__ int perm32(int rho) { const int n = rho >> 4, i = rho & 15; return 8 * (i >> 2) + 4 * n + (i & 3); }
struct Unit { int pm, pn; };
struct Gemm { const bf16_t* A; const bf16_t* Bt; int M, N, K; };
struct StaticOrder {
    int nM, nN, nwg, G, c;
    __device__ void init(int M, int N, int G_, int c_) { nM = M / BM; nN = N / BM; nwg = nM * nN; G = G_; c = c_; }
    __device__ bool next(int i, Unit& u) const {
        const long L = (long)i * G + c; if (L >= nwg) return false;
        int wgid = (int)L; { const int q = nwg / NXCD, r = nwg % NXCD, xcd = wgid % NXCD, off = wgid / NXCD; wgid = (xcd < r ? xcd * (q + 1) : r * (q + 1) + (xcd - r) * q) + off; }
        const int nig = WGM * nN, gid = wgid / nig, fm = gid * WGM, gsz = (nM - fm) < WGM ? (nM - fm) : WGM;
        u.pm = fm + ((wgid % nig) % gsz); u.pn = (wgid % nig) / gsz; return true;
    }
};

template <class Epi, class Sched, bool ALIGN_EPI = false, bool SP2 = false>
__device__ __forceinline__ void gemm_phase(LAS unsigned char* lds, const Gemm g, const Sched& S, const Epi& E) {
    int tid_ = threadIdx.x; asm volatile("" : "+v"(tid_));
    const int tid = tid_, wid = __builtin_amdgcn_readfirstlane(tid >> 6), lane = tid & 63, wr = wid >> 2, wc = wid & 3, fr = lane & 15, fq = lane >> 4;
    const int K = g.K, nt = K / BK;
    unsigned voffA[2], voffB[2];
#pragma unroll
    for (int i = 0; i < 2; ++i) { int R, C; stage_rc(tid * 16 + i * 8192, R, C); const int Rb = Epi::PERM ? ((R & ~31) + perm32(R & 31)) : R;
        const int Ra = Epi::APERM ? ((R & 64) + 4 * (R & 15) + ((R >> 4) & 3)) : R;
        voffA[i] = (unsigned)(Ra * K + C) * 2u; voffB[i] = (unsigned)(Rb * K + C) * 2u; }
    const size_t kstep = (size_t)(BK * 2);
    const size_t hstep = (size_t)HALF * K * 2;
    const size_t tstep = 2 * hstep;
    const unsigned ldsw = (unsigned)wid * 1024u;
    const int aoff = lds_byte(wr * 64 + fr, fq * 8), boff = lds_byte(wc * 32 + fr, fq * 8);
#define PG8_SA(b, h) (((b) * 2 + (h)) * HTB)
#define PG8_SB(b, h) ((4 + (b) * 2 + (h)) * HTB)
#define PG8_STAGE(bufoff, gbase, voff) do { _Pragma("unroll") for (int _i = 0; _i < 2; ++_i) \
        __builtin_amdgcn_global_load_lds((const unsigned*)((const char*)(gbase) + (voff)[_i]), (LAS unsigned*)(lds + (bufoff) + ldsw + _i * 8192), 16, 0, 0); } while (0)
#define PG8_LDA(dst, b, h) do { _Pragma("unroll") for (int m = 0; m < 4; ++m) _Pragma("unroll") for (int k = 0; k < 2; ++k) dst[m][k] = *(const LAS bf16x8*)(lds + PG8_SA(b, h) + aoff + m * 2048 + k * 1024); } while (0)
#define PG8_LDB(dst, b, h) do { _Pragma("unroll") for (int n = 0; n < 2; ++n) _Pragma("unroll") for (int k = 0; k < 2; ++k) dst[n][k] = *(const LAS bf16x8*)(lds + PG8_SB(b, h) + boff + n * 2048 + k * 1024); } while (0)
#define PG8_MMA(ai, bj, At, Bt) do { __builtin_amdgcn_s_setprio(1); _Pragma("unroll") for (int m = 0; m < 4; ++m) _Pragma("unroll") for (int n = 0; n < 2; ++n) _Pragma("unroll") for (int k = 0; k < 2; ++k) \
        acc[ai][bj][m][n] = __builtin_amdgcn_mfma_f32_16x16x32_bf16(Bt[n][k], At[m][k], acc[ai][bj][m][n], 0, 0, 0); __builtin_amdgcn_s_setprio(0); } while (0)
#define PG8_WAIT_V(n) asm volatile("s_waitcnt vmcnt(" #n ")" ::: "memory")
#define PG8_WAIT_L(n) asm volatile("s_waitcnt lgkmcnt(" #n ")" ::: "memory")
#define PG8_BAR __builtin_amdgcn_s_barrier()
#define PG8_SCHED __builtin_amdgcn_sched_barrier(0)
    Unit cur, nxt; int ui = 0;
    if (!S.next(0, cur)) return;
    f32x4 acc[2][2][4][2];
#pragma unroll
    for (int a = 0; a < 2; ++a)
#pragma unroll
        for (int b = 0; b < 2; ++b)
#pragma unroll
            for (int m = 0; m < 4; ++m)
#pragma unroll
                for (int n = 0; n < 2; ++n) acc[a][b][m][n] = (f32x4){0.f, 0.f, 0.f, 0.f};
    bf16x8 At[4][2], B0[2][2], B1[2][2];
    const char* cA = (const char*)g.A + (size_t)cur.pm * tstep; const char* cB = (const char*)g.Bt + (size_t)cur.pn * tstep;
    if constexpr (SP2) {
        PG8_STAGE(PG8_SB(0, 0), cB, voffB); PG8_STAGE(PG8_SB(0, 1), cB + hstep, voffB); PG8_STAGE(PG8_SA(0, 0), cA, voffA); PG8_STAGE(PG8_SA(0, 1), cA + hstep, voffA);
        if (wr == 1) PG8_BAR;
        PG8_WAIT_V(2); PG8_BAR;
        PG8_STAGE(PG8_SB(1, 0), cB + kstep, voffB); PG8_STAGE(PG8_SA(1, 0), cA + kstep, voffA); PG8_STAGE(PG8_SB(1, 1), cB + hstep + kstep, voffB);
        PG8_WAIT_V(6); PG8_BAR;
    } else {
        PG8_STAGE(PG8_SB(0, 0), cB, voffB); PG8_STAGE(PG8_SA(0, 0), cA, voffA); PG8_STAGE(PG8_SB(0, 1), cB + hstep, voffB); PG8_STAGE(PG8_SA(0, 1), cA + hstep, voffA);
        if (wr == 1) PG8_BAR;
        PG8_WAIT_V(4); PG8_BAR;
        PG8_STAGE(PG8_SB(1, 0), cB + kstep, voffB); PG8_STAGE(PG8_SA(1, 0), cA + kstep, voffA); PG8_STAGE(PG8_SB(1, 1), cB + hstep + kstep, voffB);
        PG8_WAIT_V(6); PG8_BAR;
    }
    for (;;) {
        const bool has_next = S.next(ui + 1, nxt);
        const char* nA = has_next ? (const char*)g.A + (size_t)nxt.pm * tstep : cA; const char* nB = has_next ? (const char*)g.Bt + (size_t)nxt.pn * tstep : cB;
        for (int t = 0; t < nt; t += 2) {
            const bool last = (t == nt - 2);
            const char* a1 = cA + (size_t)(t + 1) * kstep;
            const char* a2 = last ? nA : cA + (size_t)(t + 2) * kstep; const char* b2 = last ? nB : cB + (size_t)(t + 2) * kstep;
            const char* a3 = a2 + kstep; const char* b3 = b2 + kstep;
            if constexpr (Epi::HAS_MID) { if (t == (nt >> 1)) E.mid(acc, cur, ui, wr, fr); }
            if constexpr (SP2) {
            PG8_LDB(B0, 0, 0); PG8_LDB(B1, 0, 1); PG8_SCHED; PG8_LDA(At, 0, 0); PG8_STAGE(PG8_SA(1, 1), a1 + hstep, voffA);
            PG8_WAIT_V(8); PG8_WAIT_L(0); PG8_BAR; PG8_MMA(0, 0, At, B0); PG8_MMA(0, 1, At, B1); PG8_BAR; PG8_SCHED;
            PG8_LDA(At, 0, 1); PG8_STAGE(PG8_SB(0, 0), b2, voffB); PG8_STAGE(PG8_SB(0, 1), b2 + hstep, voffB); PG8_STAGE(PG8_SA(0, 0), a2, voffA);
            PG8_WAIT_V(8); PG8_WAIT_L(0); PG8_BAR; PG8_MMA(1, 0, At, B0); PG8_MMA(1, 1, At, B1); PG8_BAR; PG8_SCHED;
            PG8_LDB(B0, 1, 0); PG8_LDB(B1, 1, 1); PG8_SCHED; PG8_LDA(At, 1, 0); PG8_STAGE(PG8_SA(0, 1), a2 + hstep, voffA);
            PG8_WAIT_V(8); PG8_WAIT_L(0); PG8_BAR; PG8_MMA(0, 0, At, B0); PG8_MMA(0, 1, At, B1); PG8_BAR; PG8_SCHED;
            PG8_LDA(At, 1, 1); PG8_STAGE(PG8_SB(1, 0), b3, voffB); PG8_STAGE(PG8_SB(1, 1), b3 + hstep, voffB); PG8_STAGE(PG8_SA(1, 0), a3, voffA);
            PG8_WAIT_V(8); PG8_WAIT_L(0); PG8_BAR; PG8_MMA(1, 0, At, B0); PG8_MMA(1, 1, At, B1); PG8_BAR; PG8_SCHED;
            } else {
            PG8_LDB(B0, 0, 0); PG8_SCHED; PG8_LDA(At, 0, 0); PG8_STAGE(PG8_SA(1, 1), a1 + hstep, voffA);
            PG8_WAIT_L(8); PG8_BAR; PG8_WAIT_L(0); PG8_MMA(0, 0, At, B0); PG8_BAR; PG8_SCHED;
            PG8_LDB(B1, 0, 1); PG8_STAGE(PG8_SB(0, 0), b2, voffB);
            PG8_BAR; PG8_WAIT_L(0); PG8_MMA(0, 1, At, B1); PG8_BAR;
            PG8_LDA(At, 0, 1); PG8_STAGE(PG8_SA(0, 0), a2, voffA);
            PG8_BAR; PG8_WAIT_L(0); PG8_MMA(1, 0, At, B0); PG8_BAR; PG8_SCHED;
            PG8_STAGE(PG8_SB(0, 1), b2 + hstep, voffB);
            PG8_WAIT_V(6); PG8_BAR; PG8_MMA(1, 1, At, B1); PG8_BAR;
            PG8_LDB(B0, 1, 0); PG8_SCHED; PG8_LDA(At, 1, 0); PG8_STAGE(PG8_SA(0, 1), a2 + hstep, voffA);
            PG8_WAIT_L(8); PG8_BAR; PG8_WAIT_L(0); PG8_MMA(0, 0, At, B0); PG8_BAR; PG8_SCHED;
            PG8_LDB(B1, 1, 1); PG8_STAGE(PG8_SB(1, 0), b3, voffB);
            PG8_BAR; PG8_WAIT_L(0); PG8_MMA(0, 1, At, B1); PG8_BAR;
            PG8_LDA(At, 1, 1); PG8_STAGE(PG8_SA(1, 0), a3, voffA);
            PG8_BAR; PG8_WAIT_L(0); PG8_MMA(1, 0, At, B0); PG8_BAR; PG8_SCHED;
            PG8_STAGE(PG8_SB(1, 1), b3 + hstep, voffB);
            PG8_WAIT_V(6); PG8_BAR; PG8_MMA(1, 1, At, B1); PG8_BAR;
            }
        }
        if constexpr (ALIGN_EPI) { if (wr == 0) PG8_BAR; }
        if constexpr (!Epi::AFTER_DRAIN) E(acc, cur, ui, wr, wc, fr, fq);
        if (!has_next) break;
#pragma unroll
        for (int a = 0; a < 2; ++a)
#pragma unroll
            for (int b = 0; b < 2; ++b)
#pragma unroll
                for (int m = 0; m < 4; ++m)
#pragma unroll
                    for (int n = 0; n < 2; ++n) acc[a][b][m][n] = (f32x4){0.f, 0.f, 0.f, 0.f};
        cur = nxt; cA = nA; cB = nB; ++ui;
        if constexpr (ALIGN_EPI) { if (wr == 1) PG8_BAR; }
    }
    PG8_WAIT_V(0);
    if constexpr (!ALIGN_EPI) { if (wr == 0) PG8_BAR; }
    PG8_BAR;
    if constexpr (Epi::AFTER_DRAIN) E.fused(acc, cur, ui, wr, wc, fr, fq, lds);
#undef PG8_SA
#undef PG8_SB
#undef PG8_STAGE
#undef PG8_LDA
#undef PG8_LDB
#undef PG8_MMA
#undef PG8_WAIT_V
#undef PG8_WAIT_L
#undef PG8_BAR
#undef PG8_SCHED
}
}
using pg8::Unit;
typedef f32x4 Acc[2][2][4][2];

__device__ __forceinline__ u32x4 pack8(f32x4 a, f32x4 b) { u32x4 w; w.x = cvt_pk_bf16(a[0], a[1]); w.y = cvt_pk_bf16(a[2], a[3]); w.z = cvt_pk_bf16(b[0], b[1]); w.w = cvt_pk_bf16(b[2], b[3]); return w; }
__device__ __forceinline__ void unpack8(u32x4 w, f32x4& a, f32x4& b) { a = (f32x4){bflo(w.x), bfhi(w.x), bflo(w.y), bfhi(w.y)}; b = (f32x4){bflo(w.z), bfhi(w.z), bflo(w.w), bfhi(w.w)}; }
__device__ __forceinline__ float red_fq(float v) { v += __shfl_xor(v, 16); v += __shfl_xor(v, 32); return v; }
__device__ __forceinline__ float red8(float v) { v += __shfl_xor(v, 1); v += __shfl_xor(v, 2); v += __shfl_xor(v, 4); return v; }
__device__ __forceinline__ float sq4(f32x4 a) { return a[0] * a[0] + a[1] * a[1] + a[2] * a[2] + a[3] * a[3]; }
__device__ __forceinline__ float sum4(f32x4 a) { return (a[0] + a[1]) + (a[2] + a[3]); }
__device__ __forceinline__ float sum16(const float* sp) { return (sum4(*(const f32x4*)sp) + sum4(*(const f32x4*)(sp + 4))) + (sum4(*(const f32x4*)(sp + 8)) + sum4(*(const f32x4*)(sp + 12))); }

__device__ __forceinline__ void seg_z(int kind, float rs, f32x4& v0, f32x4& v1, float& s1, float& s2) {
    v0 *= rs; v1 *= rs;
    if (kind != 0) { v0 = gelu4(v0); v1 = gelu4(v1); }
    if (kind == 3) { s1 += sum4(v0) + sum4(v1); s2 += sq4(v0) + sq4(v1); }
}
struct EpiZ {
    static constexpr bool PERM = true, HAS_MID = false, AFTER_DRAIN = false, APERM = false;
    bf16_t* Z; const float* rstd1; float* lnstat;
    __device__ __forceinline__ void operator()(const Acc& acc, const Unit& u, int ui, int wr, int wc, int fr, int fq) const {
        const int row0 = u.pm * 256 + wr * 64 + fr, col0 = u.pn * 256 + wc * 32 + 8 * fq, kind = u.pn >> 1;
#pragma unroll
        for (int ai = 0; ai < 2; ++ai)
#pragma unroll
            for (int m = 0; m < 4; ++m) {
                const int row = row0 + ai * 128 + m * 16; const float rs = rstd1[row];
                float s1 = 0.f, s2 = 0.f;
#pragma unroll
                for (int bj = 0; bj < 2; ++bj) {
                    f32x4 v0 = acc[ai][bj][m][0], v1 = acc[ai][bj][m][1];
                    seg_z(kind, rs, v0, v1, s1, s2);
                    *(u32x4*)(Z + (size_t)row * 2048 + col0 + bj * 128) = pack8(v0, v1);
                }
                if (kind == 3) { s1 = red_fq(s1); s2 = red_fq(s2);
                    if (fq == 0) *(f32x2*)(lnstat + (size_t)row * 16 + (((u.pn - 6) * 4 + wc) * 2)) = (f32x2){s1, s2}; }
            }
    }
};
struct EpiE {
    static constexpr bool PERM = true, HAS_MID = false, AFTER_DRAIN = false, APERM = false;
    bf16_t* O;
    __device__ __forceinline__ void operator()(const Acc& acc, const Unit& u, int ui, int wr, int wc, int fr, int fq) const {
        const int row0 = u.pm * 256 + wr * 64 + fr, col0 = u.pn * 256 + wc * 32 + 8 * fq;
#pragma unroll
        for (int ai = 0; ai < 2; ++ai)
#pragma unroll
            for (int m = 0; m < 4; ++m)
#pragma unroll
                for (int bj = 0; bj < 2; ++bj)
                    *(u32x4*)(O + (size_t)(row0 + ai * 128 + m * 16) * 1024 + col0 + bj * 128) = pack8(acc[ai][bj][m][0], acc[ai][bj][m][1]);
    }
};
struct EpiH1 {
    static constexpr bool PERM = true, HAS_MID = true, AFTER_DRAIN = false, APERM = false;
    const bf16_t* Xb; bf16_t* Hb; float* ssq; const LAS f32x2* tab;
    __device__ __forceinline__ void mid(Acc& acc, const Unit& u, int ui, int wr, int fr) const {
#pragma unroll
        for (int ai = 0; ai < 2; ++ai)
#pragma unroll
            for (int m = 0; m < 4; ++m) { const float r = tab[ui * 256 + ai * 128 + wr * 64 + m * 16 + fr].x;
#pragma unroll
                for (int bj = 0; bj < 2; ++bj)
#pragma unroll
                    for (int n = 0; n < 2; ++n) acc[ai][bj][m][n] *= r; }
    }
    __device__ __forceinline__ void operator()(const Acc& acc, const Unit& u, int ui, int wr, int wc, int fr, int fq) const {
        const int rt0 = wr * 64 + fr, col0 = u.pn * 256 + wc * 32 + 8 * fq;
#pragma unroll
        for (int ai = 0; ai < 2; ++ai)
#pragma unroll
            for (int m = 0; m < 4; ++m) {
                const int rt = rt0 + ai * 128 + m * 16, row = u.pm * 256 + rt; const float rs = tab[ui * 256 + rt].y;
                float ss = 0.f;
#pragma unroll
                for (int bj = 0; bj < 2; ++bj) { const size_t o = (size_t)row * 1024 + col0 + bj * 128;
                    f32x4 x0, x1; unpack8(*(const u32x4*)(Xb + o), x0, x1);
                    const f32x4 h0 = x0 + acc[ai][bj][m][0] * rs, h1 = x1 + acc[ai][bj][m][1] * rs;
                    ss += sq4(h0) + sq4(h1);
                    *(u32x4*)(Hb + o) = pack8(h0, h1); }
                ss = red_fq(ss);
                if (fq == 0) ssq[(size_t)row * 16 + u.pn * 4 + wc] = ss;
            }
    }
};
struct EpiH2 {
    static constexpr bool PERM = true, HAS_MID = false, AFTER_DRAIN = false, APERM = false;
    bf16_t* Hb; float* ssq;
    __device__ __forceinline__ void operator()(const Acc& acc, const Unit& u, int ui, int wr, int wc, int fr, int fq) const {
        const int row0 = u.pm * 256 + wr * 64 + fr, col0 = u.pn * 256 + wc * 32 + 8 * fq;
#pragma unroll
        for (int ai = 0; ai < 2; ++ai)
#pragma unroll
            for (int m = 0; m < 4; ++m) {
                const int row = row0 + ai * 128 + m * 16; float ss = 0.f;
#pragma unroll
                for (int bj = 0; bj < 2; ++bj) { bf16_t* hp = Hb + (size_t)row * 1024 + col0 + bj * 128;
                    f32x4 x0, x1; unpack8(*(const u32x4*)hp, x0, x1);
                    const f32x4 h0 = x0 + acc[ai][bj][m][0], h1 = x1 + acc[ai][bj][m][1];
                    ss += sq4(h0) + sq4(h1);
                    *(u32x4*)hp = pack8(h0, h1); }
                ss = red_fq(ss);
                if (fq == 0) ssq[(size_t)row * 16 + u.pn * 4 + wc] = ss;
            }
    }
};
struct EpiG {
    static constexpr bool PERM = true, HAS_MID = false, AFTER_DRAIN = false, APERM = false;
    const bf16_t* Hb; const bf16_t* E; bf16_t* H3; float* ssq; const LAS float* tab;
    __device__ __forceinline__ void operator()(const Acc& acc, const Unit& u, int ui, int wr, int wc, int fr, int fq) const {
        const int rt0 = wr * 64 + fr, col0 = u.pn * 256 + wc * 32 + 8 * fq;
#pragma unroll
        for (int ai = 0; ai < 2; ++ai)
#pragma unroll
            for (int m = 0; m < 4; ++m) {
                const int rt = rt0 + ai * 128 + m * 16, row = u.pm * 256 + rt; const float rs = tab[ui * 256 + rt]; float ss = 0.f;
#pragma unroll
                for (int bj = 0; bj < 2; ++bj) { const size_t o = (size_t)row * 1024 + col0 + bj * 128;
                    f32x4 e0, e1, x0, x1; unpack8(*(const u32x4*)(E + o), e0, e1); unpack8(*(const u32x4*)(Hb + o), x0, x1);
                    f32x4 g0 = acc[ai][bj][m][0] * rs, g1 = acc[ai][bj][m][1] * rs;
#pragma unroll
                    for (int e = 0; e < 4; ++e) { g0[e] = sigmoidf_(g0[e]); g1[e] = sigmoidf_(g1[e]); }
                    const f32x4 h0 = x0 + e0 * g0, h1 = x1 + e1 * g1;
                    ss += sq4(h0) + sq4(h1);
                    *(u32x4*)(H3 + o) = pack8(h0, h1); }
                ss = red_fq(ss);
                if (fq == 0) ssq[(size_t)row * 16 + u.pn * 4 + wc] = ss;
            }
    }
};
struct EpiGF {
    static constexpr bool PERM = true, HAS_MID = false, AFTER_DRAIN = true, APERM = false;
    const bf16_t* Hb; const bf16_t* E; float* Y; const float* gfin; float* X; unsigned* cnt; const LAS float* tab;
    __device__ __forceinline__ void operator()(const Acc& acc, const Unit& u, int ui, int wr, int wc, int fr, int fq) const {}
    __device__ __forceinline__ void fused(Acc& acc, const Unit& u, int ui, int wr, int wc, int fr, int fq, LAS unsigned char* lds) const {
        const int rt0 = wr * 64 + fr, col0 = u.pn * 256 + wc * 32 + 8 * fq, tid = threadIdx.x;
        LAS float* Pw = (LAS float*)lds;
        LAS float* Rs = (LAS float*)lds + 1024;
#pragma unroll
        for (int ai = 0; ai < 2; ++ai)
#pragma unroll
            for (int m = 0; m < 4; ++m) {
                const int rt = rt0 + ai * 128 + m * 16, row = u.pm * 256 + rt; const float rs = tab[ui * 256 + rt]; float ss = 0.f;
#pragma unroll
                for (int bj = 0; bj < 2; ++bj) { const size_t o = (size_t)row * 1024 + col0 + bj * 128;
                    f32x4 e0, e1, x0, x1; unpack8(*(const u32x4*)(E + o), e0, e1); unpack8(*(const u32x4*)(Hb + o), x0, x1);
                    f32x4 g0 = acc[ai][bj][m][0] * rs, g1 = acc[ai][bj][m][1] * rs;
#pragma unroll
                    for (int e = 0; e < 4; ++e) { g0[e] = sigmoidf_(g0[e]); g1[e] = sigmoidf_(g1[e]); }
                    const f32x4 h0 = x0 + e0 * g0, h1 = x1 + e1 * g1;
                    ss += sq4(h0) + sq4(h1);
                    acc[ai][bj][m][0] = h0; acc[ai][bj][m][1] = h1; }
                ss = red_fq(ss);
                if (fq == 0) Pw[rt * 4 + wc] = ss;
            }
        __syncthreads();
        if (tid < 256) { const f32x4 q = *(const LAS f32x4*)(Pw + tid * 4);
            __hip_atomic_store((unsigned*)(X + ((size_t)u.pm * 4 + u.pn) * 256 + tid), __float_as_uint(sum4(q)), __ATOMIC_RELAXED, __HIP_MEMORY_SCOPE_AGENT); }
        asm volatile("s_waitcnt vmcnt(0)" ::: "memory");
        __syncthreads();
        if (tid == 0) { __hip_atomic_fetch_add(cnt + u.pm * 16, 1u, __ATOMIC_RELAXED, __HIP_MEMORY_SCOPE_AGENT); unsigned sp = 0;
            while (__hip_atomic_load(cnt + u.pm * 16, __ATOMIC_RELAXED, __HIP_MEMORY_SCOPE_AGENT) < 4u) { __builtin_amdgcn_s_sleep(1); if (++sp > (1u << 22)) break; } }
        __syncthreads();
        if (tid < 256) { float s = 0.f;
#pragma unroll
            for (int k = 0; k < 4; ++k) s += __uint_as_float(__hip_atomic_load((const unsigned*)(X + ((size_t)u.pm * 4 + k) * 256 + tid), __ATOMIC_RELAXED, __HIP_MEMORY_SCOPE_AGENT));
            Rs[tid] = rsqrtf(s * (1.0f / 1024.0f) + EPS); }
        __syncthreads();
        f32x4 gv[2][2];
#pragma unroll
        for (int bj = 0; bj < 2; ++bj) { gv[bj][0] = *(const f32x4*)(gfin + col0 + bj * 128); gv[bj][1] = *(const f32x4*)(gfin + col0 + bj * 128 + 4); }
#pragma unroll
        for (int ai = 0; ai < 2; ++ai)
#pragma unroll
            for (int m = 0; m < 4; ++m) {
                const int rt = rt0 + ai * 128 + m * 16, row = u.pm * 256 + rt; const float rs = Rs[rt];
#pragma unroll
                for (int bj = 0; bj < 2; ++bj) { float* yp = Y + (size_t)row * 1024 + col0 + bj * 128;
                    *(f32x4*)yp = acc[ai][bj][m][0] * rs * gv[bj][0]; *(f32x4*)(yp + 4) = acc[ai][bj][m][1] * rs * gv[bj][1]; }
            }
        __syncthreads();
    }
};
template <int C> __device__ __forceinline__ f32x4 dpp4(f32x4 v) { return (f32x4){dppf<C>(v[0]), dppf<C>(v[1]), dppf<C>(v[2]), dppf<C>(v[3])}; }
__device__ __forceinline__ f32x4 sel4(bool c, f32x4 a, f32x4 b) { return c ? a : b; }
template <int C> __device__ __forceinline__ float dppo(float old, float v) { return __int_as_float(__builtin_amdgcn_update_dpp(__float_as_int(old), __float_as_int(v), C, 0xf, 0xf, false)); }
template <int C> __device__ __forceinline__ f32x4 dppo4(f32x4 o, f32x4 v) { return (f32x4){dppo<C>(o[0], v[0]), dppo<C>(o[1], v[1]), dppo<C>(o[2], v[2]), dppo<C>(o[3], v[3])}; }
template <int C> __device__ __forceinline__ float dppz(float v) { return __int_as_float(__builtin_amdgcn_update_dpp(0, __float_as_int(v), C, 0xf, 0xf, true)); }
template <int C> __device__ __forceinline__ f32x4 dppz4(f32x4 v) { return (f32x4){dppz<C>(v[0]), dppz<C>(v[1]), dppz<C>(v[2]), dppz<C>(v[3])}; }
struct EpiUp {
    static constexpr bool PERM = true, HAS_MID = false, AFTER_DRAIN = false, APERM = true;
    bf16_t* ACT; const LAS float* tab; const float* cw; const float* cb; bf16_t* halo; float* ofp; int mode;
    __device__ __forceinline__ void operator()(const Acc& acc, const Unit& u, int ui, int wr, int wc, int fr, int fq) const {
        const int jc0 = u.pn * 128 + wc * 32 + 8 * fq;
        u32x2 held[2][4];
#pragma unroll
        for (int n = 0; n < 2; ++n) {
            const int jc = jc0 + 4 * n;
            const f32x4 w0g = *(const f32x4*)(cw + jc), w1g = *(const f32x4*)(cw + 6144 + jc), w2g = *(const f32x4*)(cw + 12288 + jc), bg = *(const f32x4*)(cb + jc);
            const f32x4 w0v = *(const f32x4*)(cw + 3072 + jc), w1v = *(const f32x4*)(cw + 6144 + 3072 + jc), w2v = *(const f32x4*)(cw + 12288 + 3072 + jc), bv = *(const f32x4*)(cb + 3072 + jc);
#pragma unroll
            for (int ai = 0; ai < 2; ++ai) {
                const int rt0 = ai * 128 + wr * 64 + 4 * fr, row0 = u.pm * 256 + rt0, g = row0 >> 6;
                const f32x4 rs = *(const LAS f32x4*)(tab + ui * 256 + rt0);
                f32x4 cg[4], cv[4];
#pragma unroll
                for (int m = 0; m < 4; ++m) { cg[m] = acc[ai][0][m][n] * rs[m]; cv[m] = acc[ai][1][m][n] * rs[m]; }
                const f32x4 pg3 = dppz4<0x111>(cg[3]), pg2 = dppz4<0x111>(cg[2]), pv3 = dppz4<0x111>(cv[3]), pv2 = dppz4<0x111>(cv[2]);
#pragma unroll
                for (int m = 0; m < 4; ++m) {
                    const f32x4 xg1 = m == 0 ? pg3 : cg[m - 1], xg2 = m == 0 ? pg2 : (m == 1 ? pg3 : cg[m - 2]);
                    const f32x4 xv1 = m == 0 ? pv3 : cv[m - 1], xv2 = m == 0 ? pv2 : (m == 1 ? pv3 : cv[m - 2]);
                    const f32x4 og = bg + w0g * xg2 + w1g * xg1 + w2g * cg[m], ov = bv + w0v * xv2 + w1v * xv1 + w2v * cv[m];
                    const f32x4 av = gelu4(og) * ov;
                    const u32x2 pk = (u32x2){cvt_pk_bf16(av[0], av[1]), cvt_pk_bf16(av[2], av[3])};
                    if (n == 0) held[ai][m] = pk;
                    else if (!(m < 2 && fr == 0)) *(u32x4*)(ACT + (size_t)(row0 + m) * 3072 + jc0) = (u32x4){held[ai][m].x, held[ai][m].y, pk.x, pk.y};
                }
                if (fr == 0) {
#pragma unroll
                    for (int m = 0; m < 2; ++m) { bf16_t* hp = halo + (size_t)(g * 4 + m) * 6144 + jc;
                        *(u32x2*)hp = (u32x2){cvt_pk_bf16(cg[m][0], cg[m][1]), cvt_pk_bf16(cg[m][2], cg[m][3])}; *(u32x2*)(hp + 3072) = (u32x2){cvt_pk_bf16(cv[m][0], cv[m][1]), cvt_pk_bf16(cv[m][2], cv[m][3])}; } }
                if (fr == 15) {
#pragma unroll
                    for (int m = 2; m < 4; ++m) { bf16_t* hp = halo + (size_t)(g * 4 + m) * 6144 + jc;
                        *(u32x2*)hp = (u32x2){cvt_pk_bf16(cg[m][0], cg[m][1]), cvt_pk_bf16(cg[m][2], cg[m][3])}; *(u32x2*)(hp + 3072) = (u32x2){cvt_pk_bf16(cv[m][0], cv[m][1]), cvt_pk_bf16(cv[m][2], cv[m][3])};
                        const int row = row0 + m;
                        if ((row & 2047) >= 2046) { float* op = ofp + (size_t)((row >> 11) * 2 + (row & 2047) - 2046) * 6144 + jc; *(f32x4*)op = cg[m]; *(f32x4*)(op + 3072) = cv[m]; } } }
            }
        }
    }
};

template <int UN> struct Frags { bf16x8 a[UN][4], b[UN][4]; };
struct TileP { const bf16_t* ap; const bf16_t* bp[4]; int lda; };
__device__ __forceinline__ TileP st_tile(const bf16_t* A, int lda, int arow0, const bf16_t* Bt, int ldb, int b0, int b1, int b2, int b3, int K) {
    int tid_ = threadIdx.x; asm volatile("" : "+v"(tid_));
    const int wave = tid_ >> 6, lane = tid_ & 63, fr = lane & 15, fq = lane >> 4, kw = K >> 3;
    TileP t; t.lda = lda; t.ap = A + (size_t)(arow0 + fr) * lda + wave * kw + 8 * fq;
    const bf16_t* bb = Bt + (size_t)fr * ldb + wave * kw + 8 * fq;
    t.bp[0] = bb + (size_t)b0 * ldb; t.bp[1] = bb + (size_t)b1 * ldb; t.bp[2] = bb + (size_t)b2 * ldb; t.bp[3] = bb + (size_t)b3 * ldb;
    return t;
}
template <int UN> __device__ __forceinline__ void st_load(Frags<UN>& F, const TileP& t, int s0) {
#pragma unroll
    for (int s = 0; s < UN; ++s)
#pragma unroll
        for (int i = 0; i < 4; ++i) { F.a[s][i] = *(const bf16x8*)(t.ap + (size_t)(16 * i) * t.lda + (s0 + s) * 32); F.b[s][i] = *(const bf16x8*)(t.bp[i] + (s0 + s) * 32); }
}
template <int UN> __device__ __forceinline__ void st_mma(f32x4 (&acc)[4][4], const Frags<UN>& F) {
#pragma unroll
    for (int s = 0; s < UN; ++s)
#pragma unroll
        for (int i = 0; i < 4; ++i)
#pragma unroll
            for (int j = 0; j < 4; ++j) acc[i][j] = __builtin_amdgcn_mfma_f32_16x16x32_bf16(F.b[s][j], F.a[s][i], acc[i][j], 0, 0, 0);
}
__device__ __forceinline__ void st_zero(f32x4 (&acc)[4][4]) {
#pragma unroll
    for (int i = 0; i < 4; ++i)
#pragma unroll
        for (int j = 0; j < 4; ++j) acc[i][j] = (f32x4){0.f, 0.f, 0.f, 0.f};
}
__device__ __forceinline__ void st_reduce(LAS unsigned char* lds, const f32x4 (&acc)[4][4], f32x4& lo0, f32x4& lo1, f32x4& hi0, f32x4& hi1) {
    int tid_ = threadIdx.x; asm volatile("" : "+v"(tid_));
    const int tid = tid_, wave = tid >> 6, lane = tid & 63, fr = lane & 15, fq = lane >> 4;
    LAS float* P = (LAS float*)lds + wave * 4096;
#pragma unroll
    for (int i = 0; i < 4; ++i)
#pragma unroll
        for (int j = 0; j < 4; ++j) { const int r = 16 * i + fr, ch = (4 * j + fq) ^ fr; *(LAS f32x4*)(P + r * 64 + ch * 4) = acc[i][j]; }
    __syncthreads();
    {   const int r = tid >> 3, c = tid & 7; LAS const float* Q = (LAS const float*)lds + r * 64;
        const int c0 = ((2 * c) ^ (r & 15)) * 4, c1 = ((2 * c + 1) ^ (r & 15)) * 4;
        lo0 = (f32x4){0.f, 0.f, 0.f, 0.f}; lo1 = lo0; hi0 = lo0; hi1 = lo0;
#pragma unroll
        for (int w = 0; w < 4; ++w) { lo0 += *(LAS const f32x4*)(Q + w * 4096 + c0); lo1 += *(LAS const f32x4*)(Q + w * 4096 + c1);
            hi0 += *(LAS const f32x4*)(Q + (w + 4) * 4096 + c0); hi1 += *(LAS const f32x4*)(Q + (w + 4) * 4096 + c1); } }
    __syncthreads();
}
struct XpT { const float* src; const float* scale; bf16_t* dst; };
__device__ __forceinline__ XpT xp_desc(KP p, unsigned char* ws, int tt) {
    const int lane = threadIdx.x & 63, w = threadIdx.x >> 6;
    const float* src; int ldsrc, k0, scol0, lddst, drow0; const float* scale; bf16_t* dst;
    if (tt < 512) { const int kt = tt >> 5, nt = tt & 31; src = p->in[8]; ldsrc = 2048; k0 = kt * 64; scol0 = nt * 64; scale = p->in[7] + k0; dst = (bf16_t*)(ws + OFF_WIN); lddst = 1024; drow0 = nt * 64; }
    else if (tt < 768) { const int t2 = tt - 512, kt = t2 >> 4, nt = t2 & 15; src = p->in[22]; ldsrc = 1024; k0 = kt * 64; scol0 = nt * 64; scale = k0 < 512 ? p->in[16] + k0 : p->in[21] + (k0 - 512); dst = (bf16_t*)(ws + OFF_WOUT); lddst = 1024; drow0 = nt * 64; }
    else if (tt < 2304) { const int t2 = tt - 768, kt = t2 / 96, nt = t2 % 96, n0 = nt * 64; src = p->in[24]; ldsrc = 6144; k0 = kt * 64; scol0 = ((n0 & 255) >> 7) * 3072 + (n0 >> 8) * 128 + (n0 & 127); scale = p->in[23] + k0; dst = (bf16_t*)(ws + OFF_WUP); lddst = 1024; drow0 = n0; }
    else if (tt < 3072) { const int t2 = tt - 2304, kt = t2 >> 4, nt = t2 & 15; src = p->in[27]; ldsrc = 1024; k0 = kt * 64; scol0 = nt * 64; scale = nullptr; dst = (bf16_t*)(ws + OFF_WDN); lddst = 3072; drow0 = nt * 64; }
    else if (tt < 3328) { const int t2 = tt - 3072, kt = t2 >> 4, nt = t2 & 15; src = p->in[29]; ldsrc = 1024; k0 = kt * 64; scol0 = nt * 64; scale = p->in[28] + k0; dst = (bf16_t*)(ws + OFF_WPG); lddst = 1024; drow0 = nt * 64; }
    else { const int t2 = tt - 3328, kt = t2 >> 4, nt = t2 & 15; src = p->in[30]; ldsrc = 1024; k0 = kt * 64; scol0 = nt * 64; scale = nullptr; dst = (bf16_t*)(ws + OFF_WPLE); lddst = 256; drow0 = nt * 64; }
    XpT t; t.src = src + (size_t)(k0 + 8 * w) * ldsrc + scol0 + lane; t.scale = scale ? scale + 8 * w : nullptr; t.dst = dst + (size_t)(drow0 + lane) * lddst + k0 + 8 * w;
    return t;
}
__device__ __forceinline__ int xp_ld(int tt) { return tt < 512 ? 2048 : (tt >= 768 && tt < 2304) ? 6144 : 1024; }
__device__ __forceinline__ void p0_phase(KP p, LAS unsigned char* lds) {
    const int tid = threadIdx.x, lane = tid & 63, wave = tid >> 6, G = gridDim.x, blk = blockIdx.x;
    unsigned char* ws = p->ws;
    {   bf16_t* Xb = (bf16_t*)(ws + OFF_XB); float* rstd1 = (float*)(ws + OFF_RSTD1);
        for (int r0 = (blk * 8 + wave) * 2; r0 < NT; r0 += G * 16) {
            f32x4 v[2][4]; float ss[2];
#pragma unroll
            for (int h = 0; h < 2; ++h) { const int r = r0 + h; const float* src = r < NP ? p->in[0] + (size_t)r * D : p->in[1] + (size_t)(r - NP) * D;
#pragma unroll
                for (int i = 0; i < 4; ++i) v[h][i] = __builtin_nontemporal_load((const f32x4*)(src + i * 256 + lane * 4)); }
#pragma unroll
            for (int h = 0; h < 2; ++h) { ss[h] = 0.f;
#pragma unroll
                for (int i = 0; i < 4; ++i) ss[h] += sq4(v[h][i]);
                ss[h] = wave_sum(ss[h]);
                if (lane == 0) rstd1[r0 + h] = rsqrtf(ss[h] * (1.0f / 1024.0f) + EPS);
#pragma unroll
                for (int i = 0; i < 4; ++i) *(u32x2*)(Xb + (size_t)(r0 + h) * D + i * 256 + lane * 4) = (u32x2){cvt_pk_bf16(v[h][i][0], v[h][i][1]), cvt_pk_bf16(v[h][i][2], v[h][i][3])}; }
        } }
    {   bf16_t* Pb = (bf16_t*)(ws + OFF_PB);
        for (size_t i0 = ((size_t)blk * 512 + tid) * 4; i0 < (size_t)NT * 256; i0 += (size_t)G * 512 * 16) {
            f32x4 v[4];
#pragma unroll
            for (int h = 0; h < 4; ++h) { const size_t idx = i0 + (size_t)h * G * 512 * 4;
                if (idx < (size_t)NT * 256) v[h] = __builtin_nontemporal_load((const f32x4*)(idx < (size_t)NP * 256 ? p->in[2] + idx : p->in[3] + (idx - (size_t)NP * 256))); }
#pragma unroll
            for (int h = 0; h < 4; ++h) { const size_t idx = i0 + (size_t)h * G * 512 * 4;
                if (idx < (size_t)NT * 256) *(u32x2*)(Pb + idx) = (u32x2){cvt_pk_bf16(v[h][0], v[h][1]), cvt_pk_bf16(v[h][2], v[h][3])}; }
        } }
    {   for (int tt = blk; tt < 3392; tt += 2 * G) {
            const int t1 = tt + G; const bool two = t1 < 3392;
            const XpT A = xp_desc(p, ws, tt), B = xp_desc(p, ws, two ? t1 : tt);
            const int la = xp_ld(tt), lb = xp_ld(two ? t1 : tt);
            float va[8], vb[8];
#pragma unroll
            for (int e = 0; e < 8; ++e) { va[e] = __builtin_nontemporal_load(A.src + (size_t)e * la); vb[e] = __builtin_nontemporal_load(B.src + (size_t)e * lb); }
            if (A.scale) {
#pragma unroll
                for (int e = 0; e < 8; ++e) va[e] *= A.scale[e]; }
            if (B.scale) {
#pragma unroll
                for (int e = 0; e < 8; ++e) vb[e] *= B.scale[e]; }
            *(u32x4*)A.dst = (u32x4){cvt_pk_bf16(va[0], va[1]), cvt_pk_bf16(va[2], va[3]), cvt_pk_bf16(va[4], va[5]), cvt_pk_bf16(va[6], va[7])};
            if (two) *(u32x4*)B.dst = (u32x4){cvt_pk_bf16(vb[0], vb[1]), cvt_pk_bf16(vb[2], vb[3]), cvt_pk_bf16(vb[4], vb[5]), cvt_pk_bf16(vb[6], vb[7])};
        } }
    {   u32x4* ag = (u32x4*)(ws + OFF_AGG); for (int i = blk * 512 + tid; i < 32768; i += G * 512) ag[i] = (u32x4){0u, 0u, 0u, 0u}; }
    {   bf16_t* Wg = (bf16_t*)(ws + OFF_WG); bf16_t* Ws = (bf16_t*)(ws + OFF_WSGU);
        if (blk == 0) ((float*)(ws + OFF_SP))[tid] = log1pf(expf(-p->in[15][tid]));
        for (int idx = blk * 512 + tid; idx < 65536; idx += G * 512) {
            const int hd = idx >> 13, n = (idx >> 6) & 127, k = idx & 63;
            const float v = n < 64 ? p->in[11][(hd * 64 + k) * 64 + n] : p->in[13][(hd * 64 + k) * 64 + (n - 64)];
            Wg[idx] = (bf16_t)(cvt_pk_bf16(v, 0.f) & 0xffffu);
            const int t = (idx >> 7) & 127, s = idx & 127;
            const float w = s <= t ? p->in[19][idx] : 0.f;
            Ws[idx] = (bf16_t)(cvt_pk_bf16(w, 0.f) & 0xffffu);
        } }
}

__device__ __forceinline__ float ald_f(const float* p) { return __uint_as_float(__hip_atomic_load((const unsigned*)p, __ATOMIC_RELAXED, __HIP_MEMORY_SCOPE_AGENT)); }
__device__ __forceinline__ void ast_f(float* p, float v) { __hip_atomic_store((unsigned*)p, __float_as_uint(v), __ATOMIC_RELAXED, __HIP_MEMORY_SCOPE_AGENT); }

__device__ __forceinline__ void p2_taskA(KP p, LAS unsigned char* lds, int task, int skip = 0) {
    int tid_ = threadIdx.x; asm volatile("" : "+v"(tid_));
    const int tid = tid_, lane = tid & 63, wave = tid >> 6;
    unsigned char* ws = p->ws;
    const bool samp = task >= 1024;
    const int hd = task & 7;
    const int c = samp ? 0 : (task >> 6), b = samp ? 0 : ((task >> 3) & 7), sc = samp ? ((task - 1024) >> 3) : 0;
    const int R0 = samp ? NP + sc * 128 : b * 2048 + c * 128;
    const bf16_t* Z = (const bf16_t*)(ws + OFF_Z);
    LAS bf16_t* xcb = (LAS bf16_t*)lds;
    LAS float* aS = (LAS float*)(lds + 18432);
    LAS float* uS = (LAS float*)(lds + 18432 + 34816);
    LAS float* Pseg = (LAS float*)(lds + 88064);
    LAS float* Sseg = Pseg + 512;
    LAS float* hin = Sseg + 512;
    const bf16_t* gap_ = Z + (size_t)(R0 + (tid >> 2)) * 2048 + 512 + hd * 64 + (tid & 3) * 16;
    const u32x4 gaw0 = *(const u32x4*)gap_, gaw1 = *(const u32x4*)(gap_ + 8);
    if (!(skip & 1))
    {   const int t = tid >> 2, cgp = tid & 3, ch0 = hd * 64 + cgp * 16;
        f32x4 xc[4];
#pragma unroll
        for (int i = 0; i < 4; ++i) xc[i] = *(const f32x4*)(p->in[10] + ch0 + 4 * i);
#pragma unroll
        for (int j = 0; j < 4; ++j) {
            f32x4 xv[4] = {{0.f, 0.f, 0.f, 0.f}, {0.f, 0.f, 0.f, 0.f}, {0.f, 0.f, 0.f, 0.f}, {0.f, 0.f, 0.f, 0.f}};
            const bf16_t* src = nullptr; const float* srcf = nullptr;
            if (!samp) { const int pos = c * 128 + t - 3 + j; if (pos >= 0) src = Z + (size_t)(b * 2048 + pos) * 2048 + ch0; }
            else { const int q = sc * 32 + (t >> 2), idx = (t & 3) + j; if (idx < 3) srcf = p->in[5] + ((size_t)q * 3 + idx) * 512 + ch0; else src = Z + (size_t)(NP + 4 * q + idx - 3) * 2048 + ch0; }
            if (src) { const u32x4 w0 = *(const u32x4*)src, w1 = *(const u32x4*)(src + 8); unpack8(w0, xv[0], xv[1]); unpack8(w1, xv[2], xv[3]); }
            else if (srcf) {
#pragma unroll
                for (int i = 0; i < 4; ++i) xv[i] = *(const f32x4*)(srcf + 4 * i); }
#pragma unroll
            for (int i = 0; i < 4; ++i) xc[i] += *(const f32x4*)(p->in[9] + j * 512 + ch0 + 4 * i) * xv[i];
            if (j == 3) {
                float* op = nullptr;
                if (!samp) { if (c == 15 && t >= 125) op = p->out + O_CP + (size_t)(b * 3 + t - 125) * 512 + ch0; }
                else { const int q = sc * 32 + (t >> 2), pos = t & 3; if (pos >= 1) op = p->out + O_CS + (size_t)(q * 3 + pos - 1) * 512 + ch0; }
                if (op) {
#pragma unroll
                    for (int i = 0; i < 4; ++i) *(f32x4*)(op + 4 * i) = xv[i]; }
            }
        }
        *(LAS u32x4*)(xcb + t * 72 + cgp * 16) = pack8(xc[0], xc[1]);
        *(LAS u32x4*)(xcb + t * 72 + cgp * 16 + 8) = pack8(xc[2], xc[3]);
    }
    __syncthreads();
    if (!(skip & 2))
    {   const int fr = lane & 15, fq = lane >> 4;
        bf16x8 af[2];
#pragma unroll
        for (int ks = 0; ks < 2; ++ks) af[ks] = *(const LAS bf16x8*)(xcb + (16 * wave + fr) * 72 + 32 * ks + 8 * fq);
        LAS const bf16_t* WgL = (LAS const bf16_t*)(lds + 98304);
        f32x4 acc[8];
#pragma unroll
        for (int nb = 0; nb < 8; ++nb) { acc[nb] = (f32x4){0.f, 0.f, 0.f, 0.f};
#pragma unroll
            for (int ks = 0; ks < 2; ++ks) { const bf16x8 bb = *(const LAS bf16x8*)(WgL + (16 * nb + fr) * 72 + 32 * ks + 8 * fq);
                acc[nb] = __builtin_amdgcn_mfma_f32_16x16x32_bf16(af[ks], bb, acc[nb], 0, 0, 0); } }
#pragma unroll
        for (int nb = 0; nb < 4; ++nb) {
            const int ch = 16 * nb + fr, chg = hd * 64 + ch;
            const float ba = p->in[12][chg], bx = p->in[14][chg], sp = ((const float*)(ws + OFF_SP))[chg];
#pragma unroll
            for (int j = 0; j < 4; ++j) {
                const int tok = 16 * wave + 4 * fq + j;
                const float rg = sigmoidf_(acc[nb][j] + ba), ig = sigmoidf_(acc[nb + 4][j] + bx);
                const float la = -8.0f * rg * sp;
                const float a = __builtin_amdgcn_exp2f(1.4426950409f * la);
                float mult = __builtin_amdgcn_sqrtf((1.0f - a) * (1.0f + a));
                if (!samp && c == 0 && tok == 0) mult = 1.0f;
                const float xcv = bf2f(xcb[tok * 72 + ch]);
                aS[tok * 68 + ch] = a; uS[tok * 68 + ch] = xcv * ig * mult;
            }
        }
    }
    __syncthreads();
    if (samp) {
        const int ch = lane;
#pragma unroll
        for (int s4 = 0; s4 < 4; ++s4) {
            const int q = sc * 32 + wave * 4 + s4;
            float h = p->in[4][(size_t)q * 512 + hd * 64 + ch];
#pragma unroll
            for (int i = 0; i < 4; ++i) { const int tok = 16 * wave + 4 * s4 + i; h = aS[tok * 68 + ch] * h + uS[tok * 68 + ch]; uS[tok * 68 + ch] = h; }
            p->out[O_HS + (size_t)q * 512 + hd * 64 + ch] = h;
        }
        __syncthreads();
    } else {
        {   const int ch = lane; float P = 1.f, S = 0.f;
#pragma unroll
            for (int i = 0; i < 16; ++i) { const int o = (16 * wave + i) * 68 + ch; const float a = aS[o]; S = a * S + uS[o]; P *= a; uS[o] = S; aS[o] = P; }
            Pseg[wave * 64 + ch] = P; Sseg[wave * 64 + ch] = S; }
        __syncthreads();
        if (wave == 0) {
            const int ch = lane;
            float Pc = 1.f, Sc = 0.f;
#pragma unroll
            for (int s = 0; s < 8; ++s) { const float P = Pseg[s * 64 + ch]; Sc = P * Sc + Sseg[s * 64 + ch]; Pc *= P; }
            unsigned long long* AGG = (unsigned long long*)(ws + OFF_AGG);
            if (c < 15 && !(skip & 3)) __hip_atomic_store(AGG + (size_t)task * 64 + ch, ((unsigned long long)__float_as_uint(Sc) << 32) | (unsigned long long)(__float_as_uint(Pc) | 0x80000000u), __ATOMIC_RELAXED, __HIP_MEMORY_SCOPE_AGENT);
            float h = 0.f;
            if (c > 0 && !(skip & 4)) {
                unsigned long long gv[15];
#pragma unroll
                for (int j = 0; j < 15; ++j) gv[j] = 1ull;
                unsigned sp = 0;
                for (;;) {
                    bool miss = false;
#pragma unroll
                    for (int j = 0; j < 15; ++j) if (j < c) { gv[j] = __hip_atomic_load(AGG + (size_t)(j * 64 + b * 8 + hd) * 64 + ch, __ATOMIC_RELAXED, __HIP_MEMORY_SCOPE_AGENT); }
#pragma unroll
                    for (int j = 0; j < 15; ++j) miss |= (gv[j] == 0ull);
                    if (__builtin_amdgcn_ballot_w64(miss) == 0ull) break;
                    __builtin_amdgcn_s_sleep(2); if (++sp > (1u << 20)) break;
                }
#pragma unroll
                for (int j = 0; j < 15; ++j) if (j < c) h = __uint_as_float((unsigned)gv[j] & 0x7fffffffu) * h + __uint_as_float((unsigned)(gv[j] >> 32));
            }
#pragma unroll
            for (int s = 0; s < 8; ++s) { hin[s * 64 + ch] = h; h = Pseg[s * 64 + ch] * h + Sseg[s * 64 + ch]; }
            if (c == 15) p->out[O_HP + (size_t)b * 512 + hd * 64 + ch] = h;
        }
        __syncthreads();
    }
    if (!(skip & 8))
    {   const int t = tid >> 2, part = tid & 3, row = R0 + t;
        f32x4 g[4]; unpack8(gaw0, g[0], g[1]); unpack8(gaw1, g[2], g[3]);
        float ss = 0.f;
#pragma unroll
        for (int i = 0; i < 4; ++i) { f32x4 h = *(const LAS f32x4*)(uS + t * 68 + part * 16 + 4 * i);
            if (!samp) h += *(const LAS f32x4*)(aS + t * 68 + part * 16 + 4 * i) * *(const LAS f32x4*)(hin + (t >> 4) * 64 + part * 16 + 4 * i);
            g[i] *= h; ss += sq4(g[i]); }
        ss += __shfl_xor(ss, 1); ss += __shfl_xor(ss, 2);
        if (part == 0) ((float*)(ws + OFF_SSQY))[(size_t)row * 16 + hd] = ss;
        bf16_t* yp = (bf16_t*)(ws + OFF_Y) + (size_t)row * 1024 + hd * 64 + part * 16;
        *(u32x4*)yp = pack8(g[0], g[1]); *(u32x4*)(yp + 8) = pack8(g[2], g[3]);
    }
    __syncthreads();
}

__device__ __forceinline__ void p2_taskB(KP p, LAS unsigned char* lds, int idx) {
    int tid_ = threadIdx.x; asm volatile("" : "+v"(tid_));
    const int tid = tid_, lane = tid & 63, wave = tid >> 6;
    unsigned char* ws = p->ws;
    const int chunk = idx >> 2, hb = idx & 3, R0 = chunk * 128;
    const bf16_t* Z = (const bf16_t*)(ws + OFF_Z);
    LAS bf16_t* vnT = (LAS bf16_t*)lds;
    {   const int s = tid >> 2, dg = tid & 3;
        float m_, r_;
        {   const float* lp = (const float*)(ws + OFF_LNSTAT) + (size_t)(R0 + s) * 16;
            float s1 = 0.f, s2 = 0.f;
#pragma unroll
            for (int i = 0; i < 4; ++i) { const f32x4 v = *(const f32x4*)(lp + 4 * i); s1 += v[0] + v[2]; s2 += v[1] + v[3]; }
            m_ = s1 * (1.0f / 512.0f); r_ = rsqrtf(s2 * (1.0f / 512.0f) - m_ * m_ + EPS); }
        const bf16_t* gp = Z + (size_t)(R0 + s) * 2048 + 1536 + hb * 128 + dg * 32;
#pragma unroll
        for (int q8 = 0; q8 < 4; ++q8) {
            f32x4 g0, g1; unpack8(*(const u32x4*)(gp + 8 * q8), g0, g1);
            const int d0 = dg * 32 + 8 * q8;
            const f32x4 lg0 = *(const f32x4*)(p->in[17] + hb * 128 + d0), lg1 = *(const f32x4*)(p->in[17] + hb * 128 + d0 + 4);
            const f32x4 lb0 = *(const f32x4*)(p->in[18] + hb * 128 + d0), lb1 = *(const f32x4*)(p->in[18] + hb * 128 + d0 + 4);
            g0 = (g0 - m_) * r_ * lg0 + lb0; g1 = (g1 - m_) * r_ * lg1 + lb1;
#pragma unroll
            for (int e = 0; e < 4; ++e) { vnT[(d0 + e) * 136 + s] = (bf16_t)(cvt_pk_bf16(g0[e], 0.f) & 0xffffu); vnT[(d0 + 4 + e) * 136 + s] = (bf16_t)(cvt_pk_bf16(g1[e], 0.f) & 0xffffu); }
        } }
    __syncthreads();
    {   const int fr = lane & 15, fq = lane >> 4, t = 16 * wave + fr, row = R0 + t;
        const bf16_t* W = (const bf16_t*)(ws + OFF_WSGU) + hb * 16384;
        f32x4 acc[8]; u32x2 gwv[8];
        const float bs = p->in[20][hb * 128 + t];
#pragma unroll
        for (int nb = 0; nb < 8; ++nb) { acc[nb] = (f32x4){0.f, 0.f, 0.f, 0.f}; gwv[nb] = *(const u32x2*)(Z + (size_t)row * 2048 + 1024 + hb * 128 + 16 * nb + 4 * fq); }
        for (int ks = 0; ks <= (wave >> 1); ++ks) {
            const bf16x8 wf = *(const bf16x8*)(W + t * 128 + 32 * ks + 8 * fq);
#pragma unroll
            for (int nb = 0; nb < 8; ++nb) { const bf16x8 vf = *(const LAS bf16x8*)(vnT + (16 * nb + fr) * 136 + 32 * ks + 8 * fq);
                acc[nb] = __builtin_amdgcn_mfma_f32_16x16x32_bf16(vf, wf, acc[nb], 0, 0, 0); } }
        float ss = 0.f;
#pragma unroll
        for (int nb = 0; nb < 8; ++nb) { const int d0 = hb * 128 + 16 * nb + 4 * fq; const u32x2 gw = gwv[nb];
            f32x4 v = (f32x4){bflo(gw.x), bfhi(gw.x), bflo(gw.y), bfhi(gw.y)} * (acc[nb] + bs);
            ss += sq4(v);
            *(u32x2*)((bf16_t*)(ws + OFF_Y) + (size_t)row * 1024 + 512 + d0) = (u32x2){cvt_pk_bf16(v[0], v[1]), cvt_pk_bf16(v[2], v[3])}; }
        ss = red_fq(ss);
        if (fq == 0) ((float*)(ws + OFF_SSQY))[(size_t)row * 16 + 8 + hb] = ss;
    }
    __syncthreads();
}
__device__ __forceinline__ void p2_taskBs(KP p, int q) {
    const int lane = threadIdx.x & 63, hb = lane >> 4;
    unsigned char* ws = p->ws;
    const bf16_t* Z = (const bf16_t*)(ws + OFF_Z);
    const f32x4 lg0 = *(const f32x4*)(p->in[17] + 8 * lane), lg1 = *(const f32x4*)(p->in[17] + 8 * lane + 4), lb0 = *(const f32x4*)(p->in[18] + 8 * lane), lb1 = *(const f32x4*)(p->in[18] + 8 * lane + 4);
    f32x4 vn[4][2];
#pragma unroll
    for (int t = 0; t < 4; ++t) {
        const int row = NP + 4 * q + t;
        const float* lp = (const float*)(ws + OFF_LNSTAT) + (size_t)row * 16;
        float s1 = 0.f, s2 = 0.f;
#pragma unroll
        for (int i = 0; i < 4; ++i) { const f32x4 v = *(const f32x4*)(lp + 4 * i); s1 += v[0] + v[2]; s2 += v[1] + v[3]; }
        const float mean = s1 * (1.0f / 512.0f), var = s2 * (1.0f / 512.0f) - mean * mean, r_ = rsqrtf(var + EPS);
        f32x4 g0, g1; unpack8(*(const u32x4*)(Z + (size_t)row * 2048 + 1536 + 8 * lane), g0, g1);
        vn[t][0] = (g0 - mean) * r_ * lg0 + lb0; vn[t][1] = (g1 - mean) * r_ * lg1 + lb1;
        float* op = p->out + O_VS + (size_t)(q * 4 + t) * 512 + 8 * lane;
        *(f32x4*)op = vn[t][0]; *(f32x4*)(op + 4) = vn[t][1];
    }
#pragma unroll
    for (int t = 0; t < 4; ++t) {
        const int row = NP + 4 * q + t;
        const float bs = p->in[20][hb * 128 + t];
        f32x4 m0 = {bs, bs, bs, bs}, m1 = m0;
#pragma unroll
        for (int s = 0; s <= t; ++s) { const float w = p->in[19][(size_t)(hb * 128 + t) * 128 + s]; m0 += w * vn[s][0]; m1 += w * vn[s][1]; }
        f32x4 g0, g1; unpack8(*(const u32x4*)(Z + (size_t)row * 2048 + 1024 + 8 * lane), g0, g1);
        g0 *= m0; g1 *= m1;
        float ss = sq4(g0) + sq4(g1);
        ss += __shfl_xor(ss, 1); ss += __shfl_xor(ss, 2); ss += __shfl_xor(ss, 4); ss += __shfl_xor(ss, 8);
        if ((lane & 15) == 0) ((float*)(ws + OFF_SSQY))[(size_t)row * 16 + 8 + hb] = ss;
        *(u32x4*)((bf16_t*)(ws + OFF_Y) + (size_t)row * 1024 + 512 + 8 * lane) = pack8(g0, g1);
    }
}
__device__ __forceinline__ void p2_phase(KP p, LAS unsigned char* lds, int lo = 0, int hi = 1584, int skip = 0) {
    int cur_hd = -1;
    for (int task = blockIdx.x; task < 1584; task += gridDim.x) {
        if (task < lo || task >= hi) continue;
        if (task < 1056 && (task & 7) != cur_hd) {
            cur_hd = task & 7;
            const bf16_t* Wg = (const bf16_t*)(p->ws + OFF_WG) + cur_hd * 8192;
            __syncthreads();
            for (int i = threadIdx.x; i < 1024; i += 512) { const int n = i >> 3, k8 = i & 7; *(LAS u32x4*)((LAS bf16_t*)(lds + 98304) + n * 72 + k8 * 8) = *(const u32x4*)(Wg + n * 64 + k8 * 8); }
            __syncthreads();
        }
        if (task < 1056) p2_taskA(p, lds, task, skip);
        else if (task < 1568) p2_taskB(p, lds, task - 1056);
        else p2_taskBs(p, (task - 1568) * 8 + (threadIdx.x >> 6));
    }
}

__device__ __forceinline__ f32x4 ld_bf4(const bf16_t* q) { const u32x2 w = *(const u32x2*)q; return (f32x4){bflo(w.x), bfhi(w.x), bflo(w.y), bfhi(w.y)}; }
__device__ __forceinline__ void p4b_tile(KP p, int pm) {
    unsigned char* ws = p->ws;
    const bf16_t* halo = (const bf16_t*)(ws + OFF_HALO); bf16_t* ACT = (bf16_t*)(ws + OFF_ACT);
    const float* cw = p->in[25]; const float* cb = p->in[26];
    for (int jj = threadIdx.x; jj < 768; jj += 512) {
        const int j = jj * 4;
        const f32x4 bg = *(const f32x4*)(cb + j), w0g = *(const f32x4*)(cw + j), w1g = *(const f32x4*)(cw + 6144 + j), w2g = *(const f32x4*)(cw + 12288 + j);
        const f32x4 bv = *(const f32x4*)(cb + 3072 + j), w0v = *(const f32x4*)(cw + 3072 + j), w1v = *(const f32x4*)(cw + 6144 + 3072 + j), w2v = *(const f32x4*)(cw + 12288 + 3072 + j);
#pragma unroll
        for (int gl = 0; gl < 4; ++gl) {
            const int g = pm * 4 + gl; const bool first = (g & 31) == 0;
            const f32x4 z4 = {0.f, 0.f, 0.f, 0.f};
            const bf16_t* hb = halo + (size_t)(g * 4) * 6144 + j; const bf16_t* tb = halo + (size_t)((g - 1) * 4 + 2) * 6144 + j;
            const f32x4 h0g = ld_bf4(hb), h1g = ld_bf4(hb + 6144), h0v = ld_bf4(hb + 3072), h1v = ld_bf4(hb + 6144 + 3072);
            const f32x4 t0g = first ? z4 : ld_bf4(tb), t1g = first ? z4 : ld_bf4(tb + 6144), t0v = first ? z4 : ld_bf4(tb + 3072), t1v = first ? z4 : ld_bf4(tb + 6144 + 3072);
            {   const f32x4 og = bg + w0g * t0g + w1g * t1g + w2g * h0g, ov = bv + w0v * t0v + w1v * t1v + w2v * h0v;
                *(u32x2*)(ACT + (size_t)(g * 64) * 3072 + j) = (u32x2){cvt_pk_bf16(gelu_t(og[0]) * ov[0], gelu_t(og[1]) * ov[1]), cvt_pk_bf16(gelu_t(og[2]) * ov[2], gelu_t(og[3]) * ov[3])}; }
            {   const f32x4 og = bg + w0g * t1g + w1g * h0g + w2g * h1g, ov = bv + w0v * t1v + w1v * h0v + w2v * h1v;
                *(u32x2*)(ACT + (size_t)(g * 64 + 1) * 3072 + j) = (u32x2){cvt_pk_bf16(gelu_t(og[0]) * ov[0], gelu_t(og[1]) * ov[1]), cvt_pk_bf16(gelu_t(og[2]) * ov[2], gelu_t(og[3]) * ov[3])}; }
        }
    }
}
__device__ __forceinline__ void p7_phase(KP p, int row_lo) {
    const int lane = threadIdx.x & 63, wave = threadIdx.x >> 6;
    const float* ssq = (const float*)(p->ws + OFF_SSQ3); const bf16_t* H3 = (const bf16_t*)(p->ws + OFF_H3);
    f32x4 gf[4];
#pragma unroll
    for (int i = 0; i < 2; ++i) { gf[2 * i] = *(const f32x4*)(p->in[31] + i * 512 + lane * 8); gf[2 * i + 1] = *(const f32x4*)(p->in[31] + i * 512 + lane * 8 + 4); }
    for (int r = row_lo + blockIdx.x * 8 + wave; r < NT; r += gridDim.x * 8) {
        const float rs = rsqrtf(sum16(ssq + (size_t)r * 16) * (1.0f / 1024.0f) + EPS);
        float* op = p->out + (size_t)r * 1024;
#pragma unroll
        for (int i = 0; i < 2; ++i) { f32x4 a, b; unpack8(*(const u32x4*)(H3 + (size_t)r * 1024 + i * 512 + lane * 8), a, b);
            *(f32x4*)(op + i * 512 + lane * 8) = a * rs * gf[2 * i]; *(f32x4*)(op + i * 512 + lane * 8 + 4) = b * rs * gf[2 * i + 1]; }
    }
}

__device__ __forceinline__ bool st_map(int i, int nct, int& rt, int& ct) {
    const int b = blockIdx.x;
    if (gridDim.x == 256) {
        const int xcd = b & 7, slot = b >> 3, cl = slot >> 3;
        rt = slot & 7;
        if (nct >= 32) { ct = i * 32 + xcd * 4 + cl; return ct < nct; }
        ct = xcd * 2 + cl; return i == 0 && cl < 2;
    }
    const int idx = i * gridDim.x + b; rt = idx & 7; ct = idx >> 3; return ct < nct;
}
#define ST_IDX(nct_) const int r = threadIdx.x >> 3, c = threadIdx.x & 7; (void)r; (void)c; int rt, ct; for (int it_ = 0; st_map(it_, (nct_), rt, ct); ++it_)
__device__ __forceinline__ void p1_small(KP p, LAS unsigned char* lds) {
    unsigned char* ws = p->ws;
    ST_IDX(32) {
        const int arow0 = NP + 64 * rt;
        const TileP T = st_tile((const bf16_t*)(ws + OFF_XB), 1024, arow0, (const bf16_t*)(ws + OFF_WIN), 1024, 64 * ct, 64 * ct + 16, 64 * ct + 32, 64 * ct + 48, 1024);
        Frags<4> F; st_load(F, T, 0);
        const int row = arow0 + r, col = 64 * ct + 8 * c, kind = ct >> 3;
        const float rs = ((const float*)(ws + OFF_RSTD1))[row];
        f32x4 acc[4][4]; st_zero(acc); st_mma(acc, F);
        f32x4 lo0, lo1, hi0, hi1; st_reduce(lds, acc, lo0, lo1, hi0, hi1);
        f32x4 v0 = lo0 + hi0, v1 = lo1 + hi1; float s1 = 0.f, s2 = 0.f;
        seg_z(kind, rs, v0, v1, s1, s2);
        *(u32x4*)((bf16_t*)(ws + OFF_Z) + (size_t)row * 2048 + col) = pack8(v0, v1);
        if (kind == 3) { s1 = red8(s1); s2 = red8(s2); if (c == 0) *(f32x2*)((float*)(ws + OFF_LNSTAT) + (size_t)row * 16 + (ct - 24) * 2) = (f32x2){s1, s2}; }
    }
}
__device__ __forceinline__ void p3_small(KP p, LAS unsigned char* lds) {
    unsigned char* ws = p->ws;
    ST_IDX(16) {
        const int arow0 = NP + 64 * rt;
        const TileP T = st_tile((const bf16_t*)(ws + OFF_Y), 1024, arow0, (const bf16_t*)(ws + OFF_WOUT), 1024, 64 * ct, 64 * ct + 16, 64 * ct + 32, 64 * ct + 48, 1024);
        Frags<4> F; st_load(F, T, 0);
        const int row = arow0 + r; const float* sp = (const float*)(ws + OFF_SSQY) + (size_t)row * 16;
        const f32x4 q0 = *(const f32x4*)sp, q1 = *(const f32x4*)(sp + 4), q2 = *(const f32x4*)(sp + 8);
        const size_t o = (size_t)row * 1024 + 64 * ct + 8 * c;
        const u32x4 xw = *(const u32x4*)((const bf16_t*)(ws + OFF_XB) + o);
        f32x4 acc[4][4]; st_zero(acc); st_mma(acc, F);
        f32x4 lo0, lo1, hi0, hi1; st_reduce(lds, acc, lo0, lo1, hi0, hi1);
        const float ra = rsqrtf((sum4(q0) + sum4(q1)) * (1.0f / 512.0f) + EPS), rb = rsqrtf(sum4(q2) * (1.0f / 512.0f) + EPS);
        f32x4 x0, x1; unpack8(xw, x0, x1);
        const f32x4 h0 = x0 + lo0 * ra + hi0 * rb, h1 = x1 + lo1 * ra + hi1 * rb;
        *(u32x4*)((bf16_t*)(ws + OFF_R3) + o) = pack8(h0, h1);
        const float ss = red8(sq4(h0) + sq4(h1));
        if (c == 0) ((float*)(ws + OFF_SSQ1))[(size_t)row * 16 + ct] = ss;
    }
}
__device__ __forceinline__ void p5_small(KP p, LAS unsigned char* lds, int mode = 0) {
    unsigned char* ws = p->ws;
    int tid_ = threadIdx.x; asm volatile("" : "+v"(tid_));
    const int tid = tid_, wave = tid >> 6, lane = tid & 63, fr = lane & 15, fq = lane >> 4;
    for (int idx = blockIdx.x; idx < 256; idx += gridDim.x) {
        int rt, ct;
        if (gridDim.x == 256) { const int xcd = idx & 7, slot = idx >> 3; rt = slot & 15; ct = xcd * 2 + (slot >> 4); } else { rt = idx & 15; ct = idx >> 4; }
        const int arow0 = NP + 32 * rt;
        const bf16_t* ap = (const bf16_t*)(ws + OFF_ACT) + (size_t)(arow0 + fr) * 3072 + wave * 384 + 8 * fq;
        const bf16_t* bp = (const bf16_t*)(ws + OFF_WDN) + (size_t)(64 * ct + fr) * 3072 + wave * 384 + 8 * fq;
        bf16x8 a0[2][2], b0[2][4], a1[2][2], b1[2][4];
#define P5S_LOAD(A_, B_, s0) do { _Pragma("unroll") for (int s = 0; s < 2; ++s) { _Pragma("unroll") for (int i = 0; i < 2; ++i) A_[s][i] = *(const bf16x8*)(ap + (size_t)(16 * i) * 3072 + ((s0) + s) * 32); \
            _Pragma("unroll") for (int j = 0; j < 4; ++j) B_[s][j] = *(const bf16x8*)(bp + (size_t)(16 * j) * 3072 + ((s0) + s) * 32); } } while (0)
#define P5S_MMA(A_, B_) do { _Pragma("unroll") for (int s = 0; s < 2; ++s) _Pragma("unroll") for (int i = 0; i < 2; ++i) _Pragma("unroll") for (int j = 0; j < 4; ++j) \
            acc[i][j] = __builtin_amdgcn_mfma_f32_16x16x32_bf16(B_[s][j], A_[s][i], acc[i][j], 0, 0, 0); } while (0)
        P5S_LOAD(a0, b0, 0); P5S_LOAD(a1, b1, 2);
        const int r = tid >> 4, c4 = tid & 15, row = arow0 + r;
        bf16_t* hp = (bf16_t*)(ws + OFF_R3) + (size_t)row * 1024 + 64 * ct + 4 * c4;
        const u32x2 xw = *(const u32x2*)hp;
        f32x4 acc[2][4];
#pragma unroll
        for (int i = 0; i < 2; ++i)
#pragma unroll
            for (int j = 0; j < 4; ++j) acc[i][j] = (f32x4){0.f, 0.f, 0.f, 0.f};
#pragma unroll
        for (int s0 = 0; s0 < 12; s0 += 4) { P5S_MMA(a0, b0); if (s0 + 4 < 12) P5S_LOAD(a0, b0, s0 + 4); P5S_MMA(a1, b1); if (s0 + 6 < 12) P5S_LOAD(a1, b1, s0 + 6); }
#undef P5S_LOAD
#undef P5S_MMA
        LAS float* P = (LAS float*)lds + wave * 2048;
#pragma unroll
        for (int i = 0; i < 2; ++i)
#pragma unroll
            for (int j = 0; j < 4; ++j) { const int rr = 16 * i + fr, ch = (4 * j + fq) ^ fr; *(LAS f32x4*)(P + rr * 64 + ch * 4) = acc[i][j]; }
        __syncthreads();
        f32x4 sum = {0.f, 0.f, 0.f, 0.f};
        {   LAS const float* Q = (LAS const float*)lds + r * 64 + ((c4 ^ (r & 15)) * 4);
#pragma unroll
            for (int w = 0; w < 8; ++w) sum += *(LAS const f32x4*)(Q + w * 2048); }
        __syncthreads();
        const f32x4 h = (f32x4){bflo(xw.x), bfhi(xw.x), bflo(xw.y), bfhi(xw.y)} + sum;
        float ss = sq4(h); ss += __shfl_xor(ss, 1); ss += __shfl_xor(ss, 2); ss += __shfl_xor(ss, 4); ss += __shfl_xor(ss, 8);
        if (mode) { asm volatile("" :: "v"(ss), "v"(h[0])); continue; }
        *(u32x2*)hp = (u32x2){cvt_pk_bf16(h[0], h[1]), cvt_pk_bf16(h[2], h[3])};
        if (c4 == 0) ((float*)(ws + OFF_SSQ2))[(size_t)row * 16 + ct] = ss;
    }
}
__device__ __forceinline__ void p6_small(KP p, LAS unsigned char* lds, bool fuse) {
    unsigned char* ws = p->ws;
    ST_IDX(16) {
        const int arow0 = NP + 64 * rt;
        const TileP T = st_tile((const bf16_t*)(ws + OFF_R3), 1024, arow0, (const bf16_t*)(ws + OFF_WPG), 1024, 64 * ct, 64 * ct + 16, 64 * ct + 32, 64 * ct + 48, 1024);
        Frags<4> F; st_load(F, T, 0);
        const int row = arow0 + r; const float* sp = (const float*)(ws + OFF_SSQ2) + (size_t)row * 16;
        const f32x4 q0 = *(const f32x4*)sp, q1 = *(const f32x4*)(sp + 4), q2 = *(const f32x4*)(sp + 8), q3 = *(const f32x4*)(sp + 12);
        const size_t o = (size_t)row * 1024 + 64 * ct + 8 * c;
        const u32x4 ew = *(const u32x4*)((const bf16_t*)(ws + OFF_E) + o), xw = *(const u32x4*)((const bf16_t*)(ws + OFF_R3) + o);
        f32x4 acc[4][4]; st_zero(acc); st_mma(acc, F);
        f32x4 lo0, lo1, hi0, hi1; st_reduce(lds, acc, lo0, lo1, hi0, hi1);
        const float rs = rsqrtf(((sum4(q0) + sum4(q1)) + (sum4(q2) + sum4(q3))) * (1.0f / 1024.0f) + EPS);
        f32x4 e0, e1, x0, x1; unpack8(ew, e0, e1); unpack8(xw, x0, x1);
        f32x4 g0 = (lo0 + hi0) * rs, g1 = (lo1 + hi1) * rs;
#pragma unroll
        for (int e = 0; e < 4; ++e) { g0[e] = sigmoidf_(g0[e]); g1[e] = sigmoidf_(g1[e]); }
        const f32x4 h0 = x0 + e0 * g0, h1 = x1 + e1 * g1;
        const float ss = red8(sq4(h0) + sq4(h1));
        if (!fuse) {
            *(u32x4*)((bf16_t*)(ws + OFF_H3) + o) = pack8(h0, h1);
            if (c == 0) ((float*)(ws + OFF_SSQ3))[(size_t)row * 16 + ct] = ss;
        } else {
            float* X2 = (float*)(ws + OFF_SSQ3) + 65536 + (size_t)rt * 1024;
            unsigned* cnt2 = (unsigned*)(ws + OFF_FLAG) + 1016 + rt;
            if (c == 0) __hip_atomic_store((unsigned*)(X2 + ct * 64 + r), __float_as_uint(ss), __ATOMIC_RELAXED, __HIP_MEMORY_SCOPE_AGENT);
            asm volatile("s_waitcnt vmcnt(0)" ::: "memory");
            __syncthreads();
            if (threadIdx.x == 0) { __hip_atomic_fetch_add(cnt2, 1u, __ATOMIC_RELAXED, __HIP_MEMORY_SCOPE_AGENT); unsigned sp = 0;
                while (__hip_atomic_load(cnt2, __ATOMIC_RELAXED, __HIP_MEMORY_SCOPE_AGENT) < 16u) { __builtin_amdgcn_s_sleep(1); if (++sp > (1u << 22)) break; } }
            __syncthreads();
            float tot = __uint_as_float(__hip_atomic_load((const unsigned*)(X2 + (2 * c) * 64 + r), __ATOMIC_RELAXED, __HIP_MEMORY_SCOPE_AGENT))
                      + __uint_as_float(__hip_atomic_load((const unsigned*)(X2 + (2 * c + 1) * 64 + r), __ATOMIC_RELAXED, __HIP_MEMORY_SCOPE_AGENT));
            tot = red8(tot);
            const float r4 = rsqrtf(tot * (1.0f / 1024.0f) + EPS);
            const int col = 64 * ct + 8 * c;
            float* yp = p->out + O_Y + (size_t)row * 1024 + col;
            *(f32x4*)yp = h0 * r4 * *(const f32x4*)(p->in[31] + col); *(f32x4*)(yp + 4) = h1 * r4 * *(const f32x4*)(p->in[31] + col + 4);
        }
    }
}
__device__ __forceinline__ void p4s_issue(unsigned char* ws, int rt, int s96, Frags<4>& F, int& arow0, int& jc0) {
    const int pn = s96 >> 2, s = s96 & 3, nb = 256 * pn + 32 * s;
    arow0 = NP + 64 * rt; jc0 = 128 * pn + 32 * s;
    const TileP T = st_tile((const bf16_t*)(ws + OFF_R3), 1024, arow0, (const bf16_t*)(ws + OFF_WUP), 1024, nb, nb + 16, nb + 128, nb + 144, 1024);
    st_load(F, T, 0);
}
__device__ __forceinline__ void pe_small(KP p, LAS unsigned char* lds) {
    unsigned char* ws = p->ws;
    ST_IDX(16) {
        const int arow0 = NP + 64 * rt;
        const TileP T = st_tile((const bf16_t*)(ws + OFF_PB), 256, arow0, (const bf16_t*)(ws + OFF_WPLE), 256, 64 * ct, 64 * ct + 16, 64 * ct + 32, 64 * ct + 48, 256);
        Frags<1> F; st_load(F, T, 0);
        f32x4 acc[4][4]; st_zero(acc); st_mma(acc, F);
        f32x4 lo0, lo1, hi0, hi1; st_reduce(lds, acc, lo0, lo1, hi0, hi1);
        *(u32x4*)((bf16_t*)(ws + OFF_E) + (size_t)(arow0 + r) * 1024 + 64 * ct + 8 * c) = pack8(lo0 + hi0, lo1 + hi1);
    }
}
__device__ __forceinline__ void p4_small(KP p, LAS unsigned char* lds, int mode = 0) {
    unsigned char* ws = p->ws; const int r = threadIdx.x >> 3, c = threadIdx.x & 7;
    const float* cw = p->in[25]; const float* cb = p->in[26]; const float* st = p->in[6];
    int it = 0, rt, ct; if (!st_map(0, 96, rt, ct)) return;
    Frags<4> F; int arow0, jc0; p4s_issue(ws, rt, ct, F, arow0, jc0);
    for (;;) {
        const int row = arow0 + r;
        const float rs = rsqrtf(sum16((const float*)(ws + OFF_SSQ1) + (size_t)row * 16) * (1.0f / 1024.0f) + EPS);
        f32x4 acc[4][4]; st_zero(acc); st_mma(acc, F);
        const bool more = st_map(it + 1, 96, rt, ct);
        int narow0 = 0, njc0 = 0; if (more) p4s_issue(ws, rt, ct, F, narow0, njc0);
        f32x4 lo0, lo1, hi0, hi1;
        if (mode == 2) { lo0 = acc[0][0]; lo1 = acc[0][1]; hi0 = acc[1][0]; hi1 = acc[1][1]; } else st_reduce(lds, acc, lo0, lo1, hi0, hi1);
        if (mode == 1) { asm volatile("" :: "v"(lo0[0] + lo1[0] + hi0[0] + hi1[0])); } else {
            LAS float* U = (LAS float*)lds;
            *(LAS f32x4*)(U + r * 68 + 8 * c) = (lo0 + hi0) * rs; *(LAS f32x4*)(U + r * 68 + 8 * c + 4) = (lo1 + hi1) * rs;
            __syncthreads();
            {   const int jc = jc0 + 4 * c, t = r & 3, q = (row - NP) >> 2;
                const f32x4 cg = *(LAS const f32x4*)(U + r * 68 + 4 * c), cv = *(LAS const f32x4*)(U + r * 68 + 32 + 4 * c);
                f32x4 x1g, x1v, x2g, x2v;
                if (t >= 1) { x1g = *(LAS const f32x4*)(U + (r - 1) * 68 + 4 * c); x1v = *(LAS const f32x4*)(U + (r - 1) * 68 + 32 + 4 * c); }
                else { x1g = *(const f32x4*)(st + (size_t)(q * 2 + 1) * 6144 + jc); x1v = *(const f32x4*)(st + (size_t)(q * 2 + 1) * 6144 + 3072 + jc); }
                if (t >= 2) { x2g = *(LAS const f32x4*)(U + (r - 2) * 68 + 4 * c); x2v = *(LAS const f32x4*)(U + (r - 2) * 68 + 32 + 4 * c); }
                else { x2g = *(const f32x4*)(st + (size_t)(q * 2 + t) * 6144 + jc); x2v = *(const f32x4*)(st + (size_t)(q * 2 + t) * 6144 + 3072 + jc); }
                const f32x4 og = *(const f32x4*)(cb + jc) + *(const f32x4*)(cw + jc) * x2g + *(const f32x4*)(cw + 6144 + jc) * x1g + *(const f32x4*)(cw + 12288 + jc) * cg;
                const f32x4 ov = *(const f32x4*)(cb + 3072 + jc) + *(const f32x4*)(cw + 3072 + jc) * x2v + *(const f32x4*)(cw + 6144 + 3072 + jc) * x1v + *(const f32x4*)(cw + 12288 + 3072 + jc) * cv;
                const float a0 = gelu_t(og[0]) * ov[0], a1 = gelu_t(og[1]) * ov[1], a2 = gelu_t(og[2]) * ov[2], a3 = gelu_t(og[3]) * ov[3];
                *(u32x2*)((bf16_t*)(ws + OFF_ACT) + (size_t)row * 3072 + jc) = (u32x2){cvt_pk_bf16(a0, a1), cvt_pk_bf16(a2, a3)};
                if (t >= 2) { float* op = p->out + O_FS + (size_t)(q * 2 + t - 2) * 6144 + jc; *(f32x4*)op = cg; *(f32x4*)(op + 3072) = cv; }
            }
            __syncthreads();
        }
        if (!more) break;
        arow0 = narow0; jc0 = njc0; ++it;
    }
}
#ifndef GP1_ALIGN
#define GP1_ALIGN true
#endif
#ifndef GP1_SP2
#define GP1_SP2 true
#endif
#ifndef GP3_ALIGN
#define GP3_ALIGN false
#endif
#ifndef GP3_SP2
#define GP3_SP2 true
#endif
#ifndef GP4_ALIGN
#define GP4_ALIGN true
#endif
#ifndef GP4_SP2
#define GP4_SP2 true
#endif
#ifndef GP5_ALIGN
#define GP5_ALIGN false
#endif
#ifndef GP5_SP2
#define GP5_SP2 true
#endif
#ifndef GPE_ALIGN
#define GPE_ALIGN false
#endif
#ifndef GPE_SP2
#define GPE_SP2 true
#endif
#ifndef GP6_ALIGN
#define GP6_ALIGN false
#endif
#ifndef GP6_SP2
#define GP6_SP2 true
#endif
#ifndef REP
#define REP 0
#endif
#if REP
__device__ __forceinline__ int rep_count(int bit) { int n = ((REP >> bit) & 1) ? 2 : 1; asm volatile("" : "+s"(n)); return n; }
#define REPEAT(bit) for (int nrep_ = rep_count(bit), rep_ = 0; rep_ < nrep_; ++rep_)
#else
#define REPEAT(bit)
#endif
template <class S> __device__ __forceinline__ void fill_tab_rstd(LAS float* tab, const S& sched, const float* ssq, float invn) {
    Unit u; const int r = threadIdx.x & 255;
    for (int i = threadIdx.x >> 8; sched.next(i, u); i += 2) {
        const float* sp = ssq + (size_t)(u.pm * 256 + r) * 16;
        tab[i * 256 + r] = rsqrtf(sum16(sp) * invn + EPS); }
    __syncthreads();
}

__global__ void __launch_bounds__(512) mega(Params p_) {
    KP p = (KP)__builtin_amdgcn_kernarg_segment_ptr();
#define FRESH_P() asm volatile("" : "+s"(p))
    extern __shared__ __attribute__((aligned(16))) unsigned char lds_raw[];
    LAS unsigned char* lds = (LAS unsigned char*)lds_raw;
    const int tid = threadIdx.x, G = gridDim.x, blk = blockIdx.x;
    volatile LAS unsigned* st = (volatile LAS unsigned*)(lds + LDS_X);
    if (tid < 4) st[tid] = 0u;
    __syncthreads();
    unsigned char* ws = p->ws;
    XcdBarrier bar = xcd_barrier_post((unsigned*)(ws + OFF_BAR), st);
    LAS float* tab = (LAS float*)(lds + LDS_X + 256);
#define GRID_BAR() do { if (p_.use_cg) cg::this_grid().sync(); else xcd_barrier(bar); } while (0)

    REPEAT(0) { p0_phase(p, lds); __syncthreads(); }
    GRID_BAR();
    FRESH_P(); ws = p->ws;
    {   pg8::Gemm g{(const bf16_t*)(ws + OFF_XB), (const bf16_t*)(ws + OFF_WIN), NP, 2048, 1024};
        pg8::StaticOrder S; S.init(NP, 2048, G, blk);
        EpiZ E{(bf16_t*)(ws + OFF_Z), (const float*)(ws + OFF_RSTD1), (float*)(ws + OFF_LNSTAT)};
        pg8::gemm_phase<EpiZ, pg8::StaticOrder, GP1_ALIGN, GP1_SP2>(lds, g, S, E);
        p1_small(p, lds);
    }
    GRID_BAR();
    FRESH_P(); ws = p->ws;
#if REP & 4
    { int lo = (PMODE == 1) ? 0 : 1056, hi = (PMODE == 1) ? 1024 : 1568; int sk = PSKIP; asm volatile("" : "+s"(lo), "+s"(hi), "+s"(sk)); p2_phase(p, lds, lo, hi, sk); __syncthreads(); }
#endif
    p2_phase(p, lds);
    GRID_BAR();
    FRESH_P(); ws = p->ws;
    {   pg8::StaticOrder S; S.init(NP, 1024, G, blk);
        LAS f32x2* tab2 = (LAS f32x2*)tab;
        {   Unit u; const float* sq = (const float*)(ws + OFF_SSQY);
            for (int i = 0; S.next(i, u); ++i)
                if (tid < 256) { const float* sp = sq + (size_t)(u.pm * 256 + tid) * 16;
                    const float sa = sum4(*(const f32x4*)sp) + sum4(*(const f32x4*)(sp + 4)), sb = sum4(*(const f32x4*)(sp + 8));
                    const float ra = rsqrtf(sa * (1.0f / 512.0f) + EPS), rb = rsqrtf(sb * (1.0f / 512.0f) + EPS);
                    tab2[i * 256 + tid] = (f32x2){ra / rb, rb}; }
            __syncthreads(); }
        pg8::Gemm g{(const bf16_t*)(ws + OFF_Y), (const bf16_t*)(ws + OFF_WOUT), NP, 1024, 1024};
        EpiH1 E{(const bf16_t*)(ws + OFF_XB), (bf16_t*)(ws + OFF_R3), (float*)(ws + OFF_SSQ1), tab2};
        REPEAT(3) { pg8::gemm_phase<EpiH1, pg8::StaticOrder, GP3_ALIGN, GP3_SP2>(lds, g, S, E); }
        REPEAT(10) { p3_small(p, lds); }
    }
    GRID_BAR();
    FRESH_P(); ws = p->ws;
    {   pg8::StaticOrder S; S.init(NP, 6144, G, blk);
        fill_tab_rstd(tab, S, (const float*)(ws + OFF_SSQ1), 1.0f / 1024.0f);
        pg8::Gemm g{(const bf16_t*)(ws + OFF_R3), (const bf16_t*)(ws + OFF_WUP), NP, 6144, 1024};
        EpiUp E{(bf16_t*)(ws + OFF_ACT), tab, p->in[25], p->in[26], (bf16_t*)(ws + OFF_HALO), p->out + O_FP, 0};
        pg8::gemm_phase<EpiUp, pg8::StaticOrder, GP4_ALIGN, GP4_SP2>(lds, g, S, E);
#if REP & 4096
        { int md = PMODE; asm volatile("" : "+s"(md)); p4_small(p, lds, md); }
#endif
        p4_small(p, lds);
    }
    GRID_BAR();
    FRESH_P(); ws = p->ws;
    {   pg8::StaticOrder S; S.init(NP, 1024, G, blk);
        {   Unit u; int last = -1;
            for (int i = 0; S.next(i, u); ++i) if (u.pm != last) { p4b_tile(p, u.pm); last = u.pm; }
            asm volatile("s_waitcnt vmcnt(0)" ::: "memory"); __syncthreads(); }
        pg8::Gemm g{(const bf16_t*)(ws + OFF_ACT), (const bf16_t*)(ws + OFF_WDN), NP, 1024, 3072};
        EpiH2 E{(bf16_t*)(ws + OFF_R3), (float*)(ws + OFF_SSQ2)};
        pg8::gemm_phase<EpiH2, pg8::StaticOrder, GP5_ALIGN, GP5_SP2>(lds, g, S, E);
#if REP & 8192
        { int md = 1; asm volatile("" : "+s"(md)); p5_small(p, lds, md); }
#endif
        p5_small(p, lds);
        pg8::Gemm g2{(const bf16_t*)(ws + OFF_PB), (const bf16_t*)(ws + OFF_WPLE), NP, 1024, 256};
        pg8::StaticOrder S2; S2.init(NP, 1024, G, blk);
        EpiE E2{(bf16_t*)(ws + OFF_E)};
        REPEAT(11) { pg8::gemm_phase<EpiE, pg8::StaticOrder, GPE_ALIGN, GPE_SP2>(lds, g2, S2, E2); }
        pe_small(p, lds);
    }
    GRID_BAR();
    FRESH_P(); ws = p->ws;
    {   pg8::StaticOrder S; S.init(NP, 1024, G, blk);
        fill_tab_rstd(tab, S, (const float*)(ws + OFF_SSQ2), 1.0f / 1024.0f);
        pg8::Gemm g{(const bf16_t*)(ws + OFF_R3), (const bf16_t*)(ws + OFF_WPG), NP, 1024, 1024};
        if (G == 256) {
            EpiGF E{(const bf16_t*)(ws + OFF_R3), (const bf16_t*)(ws + OFF_E), p->out + O_Y, p->in[31], (float*)(ws + OFF_SSQ3), (unsigned*)(ws + OFF_FLAG), tab};
            pg8::gemm_phase<EpiGF, pg8::StaticOrder, false, GP6_SP2>(lds, g, S, E);
        } else {
            EpiG E{(const bf16_t*)(ws + OFF_R3), (const bf16_t*)(ws + OFF_E), (bf16_t*)(ws + OFF_H3), (float*)(ws + OFF_SSQ3), tab};
            pg8::gemm_phase<EpiG, pg8::StaticOrder, GP6_ALIGN, GP6_SP2>(lds, g, S, E);
        }
        p6_small(p, lds, G == 256);
    }
    if (G != 256) {
        GRID_BAR();
        FRESH_P(); ws = p->ws;
        p7_phase(p, 0);
    }
}

extern "C" void kernel_launch(void* const* d_in, const int* in_sizes, int n_in, void* d_out, int out_size, void* d_ws, size_t ws_size, hipStream_t stream) {
    static int grid = 0;
    if (grid == 0) {
        if (n_in != 32 || out_size != (int)O_END || ws_size < WS_END) { fprintf(stderr, "kernel_launch: unexpected shapes (n_in %d out %d ws %zu, need ws %zu)\n", n_in, out_size, ws_size, (size_t)WS_END); grid = -1; return; }
        int dev = 0, cus = 0, per_cu = 0;
        if (hipGetDevice(&dev) != hipSuccess || hipDeviceGetAttribute(&cus, hipDeviceAttributeMultiprocessorCount, dev) != hipSuccess) { grid = -1; return; }
        if (hipFuncSetAttribute((const void*)mega, hipFuncAttributeMaxDynamicSharedMemorySize, LDS_BYTES) != hipSuccess) { fprintf(stderr, "kernel_launch: hipFuncSetAttribute failed\n"); grid = -1; return; }
        if (hipOccupancyMaxActiveBlocksPerMultiprocessor(&per_cu, (const void*)mega, 512, LDS_BYTES) != hipSuccess || per_cu < 1) { fprintf(stderr, "kernel_launch: occupancy query says %d\n", per_cu); (void)hipGetLastError(); grid = -1; return; }
        grid = cus;
    }
    if (grid < 0) return;
    (void)hipMemsetAsync(d_ws, 0, CTL_BYTES, stream);
    Params hp{};
    for (int i = 0; i < 32; ++i) hp.in[i] = (const float*)d_in[i];
    hp.out = (float*)d_out; hp.ws = (unsigned char*)d_ws; hp.use_cg = 0; hp.pad = 0;
    void* args[] = {&hp};
    hipError_t e = hipLaunchCooperativeKernel((const void*)mega, dim3(grid), dim3(512), args, LDS_BYTES, stream);
    if (e != hipSuccess) fprintf(stderr, "kernel_launch: cooperative launch failed: %s (grid %d)\n", hipGetErrorString(e), grid);
}
```

```cpp
#ifndef REP
#define REP 0
#endif
#ifndef PSKIP
#define PSKIP 0
#endif
#ifndef PMODE
#define PMODE 0
#endif
#include <hip/hip_runtime.h>
#include <hip/hip_cooperative_groups.h>
#include <cstdio>
namespace cg = cooperative_groups;
#define LAS __attribute__((address_space(3)))
typedef unsigned short bf16_t;
typedef short bf16x8 __attribute__((ext_vector_type(8)));
typedef float f32x4 __attribute__((ext_vector_type(4)));
typedef float f32x2 __attribute__((ext_vector_type(2)));
typedef unsigned u32x4 __attribute__((ext_vector_type(4)));
typedef unsigned u32x2 __attribute__((ext_vector_type(2)));

constexpr int D = 1024, NP = 16384, NS = 512, NT = 16896, SEQ = 2048, NBP = 8, NBS = 128;
constexpr int WA = 512, DFF = 3072, PLE = 256;
constexpr float EPS = 1e-6f;
constexpr size_t O_Y = 0;
constexpr size_t O_HP = 17301504, O_HS = 17305600, O_CP = 17371136, O_CS = 17383424, O_VS = 17580032, O_FP = 17842176, O_FS = 17940480, O_END = 19513344;
constexpr size_t OFF_BAR = 0, OFF_FLAG = 16384, CTL_BYTES = 32768;
constexpr size_t OFF_WIN = 32768;
constexpr size_t OFF_WOUT = OFF_WIN + (size_t)2048 * 1024 * 2;
constexpr size_t OFF_WUP = OFF_WOUT + (size_t)1024 * 1024 * 2;
constexpr size_t OFF_WDN = OFF_WUP + (size_t)6144 * 1024 * 2;
constexpr size_t OFF_WPG = OFF_WDN + (size_t)1024 * 3072 * 2;
constexpr size_t OFF_WPLE = OFF_WPG + (size_t)1024 * 1024 * 2;
constexpr size_t OFF_WG = OFF_WPLE + (size_t)1024 * 256 * 2;
constexpr size_t OFF_WSGU = OFF_WG + (size_t)8 * 128 * 64 * 2;
constexpr size_t OFF_RSTD1 = OFF_WSGU + (size_t)4 * 128 * 128 * 2;
constexpr size_t OFF_SP = OFF_RSTD1 + 98304;
constexpr size_t OFF_LNSTAT = OFF_RSTD1 + 131072;
constexpr size_t STAT_BYTES = (size_t)NT * 16 * 4;
constexpr size_t OFF_SSQY = OFF_LNSTAT + STAT_BYTES;
constexpr size_t OFF_SSQ1 = OFF_SSQY + STAT_BYTES;
constexpr size_t OFF_SSQ2 = OFF_SSQ1 + STAT_BYTES;
constexpr size_t OFF_SSQ3 = OFF_SSQ2 + STAT_BYTES;
constexpr size_t OFF_AGG = OFF_SSQ3 + STAT_BYTES;
constexpr size_t OFF_HALO = OFF_AGG + (size_t)1024 * 128 * 4;
constexpr size_t OFF_PB = OFF_HALO + (size_t)264 * 4 * 6144 * 4;
constexpr size_t OFF_R1 = OFF_PB + (size_t)NT * 256 * 2;
constexpr size_t OFF_XB = OFF_R1, OFF_Z = OFF_R1 + (size_t)NT * 1024 * 2, OFF_ACT = OFF_R1, OFF_H3 = OFF_R1;
constexpr size_t OFF_R3 = OFF_R1 + (size_t)NT * 3072 * 2;
constexpr size_t OFF_E = OFF_R3 + (size_t)NT * 1024 * 2, OFF_Y = OFF_E;
constexpr size_t WS_END = OFF_E + (size_t)NT * 1024 * 2;

constexpr int LDS_BYTES = 155648, LDS_X = 131072;

struct Params {
    const float* in[32];
    float* out;
    unsigned char* ws;
    int use_cg;
    int pad;
};

typedef const __attribute__((address_space(4))) Params* KP;

__device__ __forceinline__ unsigned cvt_pk_bf16(float lo, float hi) { unsigned r; asm volatile("v_cvt_pk_bf16_f32 %0, %1, %2" : "=v"(r) : "v"(lo), "v"(hi)); return r; }
__device__ __forceinline__ float bflo(unsigned w) { return __uint_as_float(w << 16); }
__device__ __forceinline__ float bfhi(unsigned w) { return __uint_as_float(w & 0xffff0000u); }
__device__ __forceinline__ float bf2f(bf16_t v) { return __uint_as_float((unsigned)v << 16); }
__device__ __forceinline__ float sigmoidf_(float x) { return __builtin_amdgcn_rcpf(1.0f + __builtin_amdgcn_exp2f(-1.4426950409f * x)); }
__device__ __forceinline__ float gelu_t(float x) {
    const float u = x * (-2.3022082f - 0.1029432f * x * x);
    return x * __builtin_amdgcn_rcpf(1.0f + __builtin_amdgcn_exp2f(u));
}
__device__ __forceinline__ f32x2 gelu2(f32x2 x) {
    const f32x2 u = x * ((x * x) * (-0.1029432f) + (-2.3022082f));
    f32x2 e; e.x = __builtin_amdgcn_exp2f(u.x); e.y = __builtin_amdgcn_exp2f(u.y);
    const f32x2 d = e + 1.0f;
    f32x2 r; r.x = __builtin_amdgcn_rcpf(d.x); r.y = __builtin_amdgcn_rcpf(d.y);
    return x * r;
}
__device__ __forceinline__ f32x4 gelu4(f32x4 v) { const f32x2 a = gelu2((f32x2){v[0], v[1]}), b = gelu2((f32x2){v[2], v[3]}); return (f32x4){a.x, a.y, b.x, b.y}; }
__device__ __forceinline__ float wave_sum(float v) {
#pragma unroll
    for (int o = 32; o >= 1; o >>= 1) v += __shfl_xor(v, o);
    return v;
}
template <int CTRL> __device__ __forceinline__ float dppf(float v) { return __int_as_float(__builtin_amdgcn_update_dpp(0, __float_as_int(v), CTRL, 0xf, 0xf, false)); }

#define XB_TMO      128
#define XB_XCNT(j)  (256  + 64 * (j))
#define XB_XSUB(j)  (1280 + 64 * (j))
#define XB_XGEN(j)  (2304 + 64 * (j))
#define XB_TOP      3328
#define XB_TOPGEN   3392
#define XCD_BAR_WORDS 3456
#define XB_SPIN_CAP (1u << 20)
__device__ __forceinline__ unsigned xb_ld(unsigned* p)              { return __hip_atomic_load(p, __ATOMIC_RELAXED, __HIP_MEMORY_SCOPE_AGENT); }
__device__ __forceinline__ unsigned xb_add(unsigned* p, unsigned v) { return __hip_atomic_fetch_add(p, v, __ATOMIC_RELAXED, __HIP_MEMORY_SCOPE_AGENT); }
__device__ __forceinline__ unsigned xb_xcc_id() { return (unsigned)__builtin_amdgcn_s_getreg((3 << 11) | 20) & 0xFu; }
#define XB_SPIN(cond, bar) do { unsigned _sp = 0; while (cond) { __builtin_amdgcn_s_sleep(1); \
    if ((++_sp & 255u) == 0u) { if (xb_ld(&(bar)[XB_TMO])) break; if (_sp > XB_SPIN_CAP) { atomicAdd(&(bar)[XB_TMO], 1u); break; } } } } while (0)
struct XcdBarrier { unsigned* bar; unsigned x; volatile LAS unsigned* st; };
__device__ __forceinline__ XcdBarrier xcd_barrier_post(unsigned* bar, volatile LAS unsigned* st) {
    XcdBarrier b; b.bar = bar; b.x = xb_xcc_id(); b.st = st;
    if (threadIdx.x == 0) (void)xb_add(&bar[XB_XCNT(b.x)], 1u);
    return b;
}
__device__ __forceinline__ void xcd_barrier_complete(unsigned* bar, unsigned x, unsigned& nloc, unsigned& nx) {
    const unsigned G = gridDim.x * gridDim.y * gridDim.z;
    unsigned sum, cnt, mine, sp = 0u;
    for (;;) {
        sum = 0u; cnt = 0u; mine = 0u;
#pragma unroll
        for (unsigned j = 0; j < 16; ++j) { const unsigned c = xb_ld(&bar[XB_XCNT(j)]); sum += c; cnt += (c > 0u) ? 1u : 0u; mine = (j == x) ? c : mine; }
        if (sum == G) break;
        __builtin_amdgcn_s_sleep(1);
        if ((++sp & 255u) == 0u) { if (xb_ld(&bar[XB_TMO])) break; if (sp > XB_SPIN_CAP) { atomicAdd(&bar[XB_TMO], 1u); break; } }
    }
    nloc = mine > 0u ? mine : 1u; nx = cnt > 0u ? cnt : 1u;
}
__device__ __forceinline__ void xcd_barrier(const XcdBarrier& b) {
    asm volatile("s_waitcnt vmcnt(0)" ::: "memory");
    __syncthreads();
    if (threadIdx.x == 0) {
        unsigned* bar = b.bar;
        __builtin_amdgcn_s_waitcnt(0);
        unsigned nloc = b.st[0], nx = b.st[1];
        if (nloc == 0u) { xcd_barrier_complete(bar, b.x, nloc, nx); b.st[0] = nloc; b.st[1] = nx; }
        const unsigned old = xb_add(&bar[XB_XSUB(b.x)], 1u);
        const unsigned gen = old / nloc;
        if (old + 1u == (gen + 1u) * nloc) {
            __builtin_amdgcn_fence(__ATOMIC_RELEASE, "agent");
            asm volatile("s_waitcnt vmcnt(0)" ::: "memory");
            const unsigned og = xb_add(&bar[XB_TOP], 1u);
            const unsigned tg = og / nx;
            if (og + 1u == (tg + 1u) * nx) xb_add(&bar[XB_TOPGEN], 1u);
            else XB_SPIN(xb_ld(&bar[XB_TOPGEN]) == tg, bar);
            __builtin_amdgcn_fence(__ATOMIC_ACQUIRE, "agent");
            xb_add(&bar[XB_XGEN(b.x)], 1u);
            asm volatile("s_waitcnt vmcnt(0)" ::: "memory");
        } else {
            XB_SPIN(xb_ld(&bar[XB_XGEN(b.x)]) == gen, bar);
            __builtin_amdgcn_fence(__ATOMIC_ACQUIRE, "agent");
            asm volatile("s_waitcnt vmcnt(0)" ::: "memory");
        }
    }
    __syncthreads();
}
namespace pg8 {
constexpr int BM = 256, BK = 64, HALF = 128, HTB = HALF * BK * 2, STAGE_BYTES = 8 * HTB, NXCD = 8, WGM = 8;
__device__ __forceinline__ int lds_byte(int r, int c) { const int st = (r >> 4) * 2 + (c >> 5), rr = r & 15, cc = c & 31, ob = rr * 64 + cc * 2; return st * 1024 + (ob ^ (((ob >> 9) & 1) << 5)); }
__device__ __forceinline__ void stage_rc(int b, int& R, int& C) { const int st = b / 1024, sb = b % 1024, swz = sb ^ (((sb >> 9) & 1) << 5); R = (st >> 1) * 16 + swz / 64; C = (st & 1) * 32 + (swz % 64) / 2; }
__device__ __forceinline__ int perm32(int rho) { const int n = rho >> 4, i = rho & 15; return 8 * (i >> 2) + 4 * n + (i & 3); }
struct Unit { int pm, pn; };
struct Gemm { const bf16_t* A; const bf16_t* Bt; int M, N, K; };
struct StaticOrder {
    int nM, nN, nwg, G, c;
    __device__ void init(int M, int N, int G_, int c_) { nM = M / BM; nN = N / BM; nwg = nM * nN; G = G_; c = c_; }
    __device__ bool next(int i, Unit& u) const {
        const long L = (long)i * G + c; if (L >= nwg) return false;
        int wgid = (int)L; { const int q = nwg / NXCD, r = nwg % NXCD, xcd = wgid % NXCD, off = wgid / NXCD; wgid = (xcd < r ? xcd * (q + 1) : r * (q + 1) + (xcd - r) * q) + off; }
        const int nig = WGM * nN, gid = wgid / nig, fm = gid * WGM, gsz = (nM - fm) < WGM ? (nM - fm) : WGM;
        u.pm = fm + ((wgid % nig) % gsz); u.pn = (wgid % nig) / gsz; return true;
    }
};

template <class Epi, class Sched, bool ALIGN_EPI = false, bool SP2 = false>
__device__ __forceinline__ void gemm_phase(LAS unsigned char* lds, const Gemm g, const Sched& S, const Epi& E) {
    int tid_ = threadIdx.x; asm volatile("" : "+v"(tid_));
    const int tid = tid_, wid = __builtin_amdgcn_readfirstlane(tid >> 6), lane = tid & 63, wr = wid >> 2, wc = wid & 3, fr = lane & 15, fq = lane >> 4;
    const int K = g.K, nt = K / BK;
    unsigned voffA[2], voffB[2];
#pragma unroll
    for (int i = 0; i < 2; ++i) { int R, C; stage_rc(tid * 16 + i * 8192, R, C); const int Rb = Epi::PERM ? ((R & ~31) + perm32(R & 31)) : R;
        const int Ra = Epi::APERM ? ((R & 64) + 4 * (R & 15) + ((R >> 4) & 3)) : R;
        voffA[i] = (unsigned)(Ra * K + C) * 2u; voffB[i] = (unsigned)(Rb * K + C) * 2u; }
    const size_t kstep = (size_t)(BK * 2);
    const size_t hstep = (size_t)HALF * K * 2;
    const size_t tstep = 2 * hstep;
    const unsigned ldsw = (unsigned)wid * 1024u;
    const int aoff = lds_byte(wr * 64 + fr, fq * 8), boff = lds_byte(wc * 32 + fr, fq * 8);
#define PG8_SA(b, h) (((b) * 2 + (h)) * HTB)
#define PG8_SB(b, h) ((4 + (b) * 2 + (h)) * HTB)
#define PG8_STAGE(bufoff, gbase, voff) do { _Pragma("unroll") for (int _i = 0; _i < 2; ++_i) \
        __builtin_amdgcn_global_load_lds((const unsigned*)((const char*)(gbase) + (voff)[_i]), (LAS unsigned*)(lds + (bufoff) + ldsw + _i * 8192), 16, 0, 0); } while (0)
#define PG8_LDA(dst, b, h) do { _Pragma("unroll") for (int m = 0; m < 4; ++m) _Pragma("unroll") for (int k = 0; k < 2; ++k) dst[m][k] = *(const LAS bf16x8*)(lds + PG8_SA(b, h) + aoff + m * 2048 + k * 1024); } while (0)
#define PG8_LDB(dst, b, h) do { _Pragma("unroll") for (int n = 0; n < 2; ++n) _Pragma("unroll") for (int k = 0; k < 2; ++k) dst[n][k] = *(const LAS bf16x8*)(lds + PG8_SB(b, h) + boff + n * 2048 + k * 1024); } while (0)
#define PG8_MMA(ai, bj, At, Bt) do { __builtin_amdgcn_s_setprio(1); _Pragma("unroll") for (int m = 0; m < 4; ++m) _Pragma("unroll") for (int n = 0; n < 2; ++n) _Pragma("unroll") for (int k = 0; k < 2; ++k) \
        acc[ai][bj][m][n] = __builtin_amdgcn_mfma_f32_16x16x32_bf16(Bt[n][k], At[m][k], acc[ai][bj][m][n], 0, 0, 0); __builtin_amdgcn_s_setprio(0); } while (0)
#define PG8_WAIT_V(n) asm volatile("s_waitcnt vmcnt(" #n ")" ::: "memory")
#define PG8_WAIT_L(n) asm volatile("s_waitcnt lgkmcnt(" #n ")" ::: "memory")
#define PG8_BAR __builtin_amdgcn_s_barrier()
#define PG8_SCHED __builtin_amdgcn_sched_barrier(0)
    Unit cur, nxt; int ui = 0;
    if (!S.next(0, cur)) return;
    f32x4 acc[2][2][4][2];
#pragma unroll
    for (int a = 0; a < 2; ++a)
#pragma unroll
        for (int b = 0; b < 2; ++b)
#pragma unroll
            for (int m = 0; m < 4; ++m)
#pragma unroll
                for (int n = 0; n < 2; ++n) acc[a][b][m][n] = (f32x4){0.f, 0.f, 0.f, 0.f};
    bf16x8 At[4][2], B0[2][2], B1[2][2];
    const char* cA = (const char*)g.A + (size_t)cur.pm * tstep; const char* cB = (const char*)g.Bt + (size_t)cur.pn * tstep;
    if constexpr (SP2) {
        PG8_STAGE(PG8_SB(0, 0), cB, voffB); PG8_STAGE(PG8_SB(0, 1), cB + hstep, voffB); PG8_STAGE(PG8_SA(0, 0), cA, voffA); PG8_STAGE(PG8_SA(0, 1), cA + hstep, voffA);
        if (wr == 1) PG8_BAR;
        PG8_WAIT_V(2); PG8_BAR;
        PG8_STAGE(PG8_SB(1, 0), cB + kstep, voffB); PG8_STAGE(PG8_SA(1, 0), cA + kstep, voffA); PG8_STAGE(PG8_SB(1, 1), cB + hstep + kstep, voffB);
        PG8_WAIT_V(6); PG8_BAR;
    } else {
        PG8_STAGE(PG8_SB(0, 0), cB, voffB); PG8_STAGE(PG8_SA(0, 0), cA, voffA); PG8_STAGE(PG8_SB(0, 1), cB + hstep, voffB); PG8_STAGE(PG8_SA(0, 1), cA + hstep, voffA);
        if (wr == 1) PG8_BAR;
        PG8_WAIT_V(4); PG8_BAR;
        PG8_STAGE(PG8_SB(1, 0), cB + kstep, voffB); PG8_STAGE(PG8_SA(1, 0), cA + kstep, voffA); PG8_STAGE(PG8_SB(1, 1), cB + hstep + kstep, voffB);
        PG8_WAIT_V(6); PG8_BAR;
    }
    for (;;) {
        const bool has_next = S.next(ui + 1, nxt);
        const char* nA = has_next ? (const char*)g.A + (size_t)nxt.pm * tstep : cA; const char* nB = has_next ? (const char*)g.Bt + (size_t)nxt.pn * tstep : cB;
        for (int t = 0; t < nt; t += 2) {
            const bool last = (t == nt - 2);
            const char* a1 = cA + (size_t)(t + 1) * kstep;
            const char* a2 = last ? nA : cA + (size_t)(t + 2) * kstep; const char* b2 = last ? nB : cB + (size_t)(t + 2) * kstep;
            const char* a3 = a2 + kstep; const char* b3 = b2 + kstep;
            if constexpr (Epi::HAS_MID) { if (t == (nt >> 1)) E.mid(acc, cur, ui, wr, fr); }
            if constexpr (SP2) {
            PG8_LDB(B0, 0, 0); PG8_LDB(B1, 0, 1); PG8_SCHED; PG8_LDA(At, 0, 0); PG8_STAGE(PG8_SA(1, 1), a1 + hstep, voffA);
            PG8_WAIT_V(8); PG8_WAIT_L(0); PG8_BAR; PG8_MMA(0, 0, At, B0); PG8_MMA(0, 1, At, B1); PG8_BAR; PG8_SCHED;
            PG8_LDA(At, 0, 1); PG8_STAGE(PG8_SB(0, 0), b2, voffB); PG8_STAGE(PG8_SB(0, 1), b2 + hstep, voffB); PG8_STAGE(PG8_SA(0, 0), a2, voffA);
            PG8_WAIT_V(8); PG8_WAIT_L(0); PG8_BAR; PG8_MMA(1, 0, At, B0); PG8_MMA(1, 1, At, B1); PG8_BAR; PG8_SCHED;
            PG8_LDB(B0, 1, 0); PG8_LDB(B1, 1, 1); PG8_SCHED; PG8_LDA(At, 1, 0); PG8_STAGE(PG8_SA(0, 1), a2 + hstep, voffA);
            PG8_WAIT_V(8); PG8_WAIT_L(0); PG8_BAR; PG8_MMA(0, 0, At, B0); PG8_MMA(0, 1, At, B1); PG8_BAR; PG8_SCHED;
            PG8_LDA(At, 1, 1); PG8_STAGE(PG8_SB(1, 0), b3, voffB); PG8_STAGE(PG8_SB(1, 1), b3 + hstep, voffB); PG8_STAGE(PG8_SA(1, 0), a3, voffA);
            PG8_WAIT_V(8); PG8_WAIT_L(0); PG8_BAR; PG8_MMA(1, 0, At, B0); PG8_MMA(1, 1, At, B1); PG8_BAR; PG8_SCHED;
            } else {
            PG8_LDB(B0, 0, 0); PG8_SCHED; PG8_LDA(At, 0, 0); PG8_STAGE(PG8_SA(1, 1), a1 + hstep, voffA);
            PG8_WAIT_L(8); PG8_BAR; PG8_WAIT_L(0); PG8_MMA(0, 0, At, B0); PG8_BAR; PG8_SCHED;
            PG8_LDB(B1, 0, 1); PG8_STAGE(PG8_SB(0, 0), b2, voffB);
            PG8_BAR; PG8_WAIT_L(0); PG8_MMA(0, 1, At, B1); PG8_BAR;
            PG8_LDA(At, 0, 1); PG8_STAGE(PG8_SA(0, 0), a2, voffA);
            PG8_BAR; PG8_WAIT_L(0); PG8_MMA(1, 0, At, B0); PG8_BAR; PG8_SCHED;
            PG8_STAGE(PG8_SB(0, 1), b2 + hstep, voffB);
            PG8_WAIT_V(6); PG8_BAR; PG8_MMA(1, 1, At, B1); PG8_BAR;
            PG8_LDB(B0, 1, 0); PG8_SCHED; PG8_LDA(At, 1, 0); PG8_STAGE(PG8_SA(0, 1), a2 + hstep, voffA);
            PG8_WAIT_L(8); PG8_BAR; PG8_WAIT_L(0); PG8_MMA(0, 0, At, B0); PG8_BAR; PG8_SCHED;
            PG8_LDB(B1, 1, 1); PG8_STAGE(PG8_SB(1, 0), b3, voffB);
            PG8_BAR; PG8_WAIT_L(0); PG8_MMA(0, 1, At, B1); PG8_BAR;
            PG8_LDA(At, 1, 1); PG8_STAGE(PG8_SA(1, 0), a3, voffA);
            PG8_BAR; PG8_WAIT_L(0); PG8_MMA(1, 0, At, B0); PG8_BAR; PG8_SCHED;
            PG8_STAGE(PG8_SB(1, 1), b3 + hstep, voffB);
            PG8_WAIT_V(6); PG8_BAR; PG8_MMA(1, 1, At, B1); PG8_BAR;
            }
        }
        if constexpr (ALIGN_EPI) { if (wr == 0) PG8_BAR; }
        if constexpr (!Epi::AFTER_DRAIN) E(acc, cur, ui, wr, wc, fr, fq);
        if (!has_next) break;
#pragma unroll
        for (int a = 0; a < 2; ++a)
#pragma unroll
            for (int b = 0; b < 2; ++b)
#pragma unroll
                for (int m = 0; m < 4; ++m)
#pragma unroll
                    for (int n = 0; n < 2; ++n) acc[a][b][m][n] = (f32x4){0.f, 0.f, 0.f, 0.f};
        cur = nxt; cA = nA; cB = nB; ++ui;
        if constexpr (ALIGN_EPI) { if (wr == 1) PG8_BAR; }
    }
    PG8_WAIT_V(0);
    if constexpr (!ALIGN_EPI) { if (wr == 0) PG8_BAR; }
    PG8_BAR;
    if constexpr (Epi::AFTER_DRAIN) E.fused(acc, cur, ui, wr, wc, fr, fq, lds);
#undef PG8_SA
#undef PG8_SB
#undef PG8_STAGE
#undef PG8_LDA
#undef PG8_LDB
#undef PG8_MMA
#undef PG8_WAIT_V
#undef PG8_WAIT_L
#undef PG8_BAR
#undef PG8_SCHED
}
}
using pg8::Unit;
typedef f32x4 Acc[2][2][4][2];

__device__ __forceinline__ u32x4 pack8(f32x4 a, f32x4 b) { u32x4 w; w.x = cvt_pk_bf16(a[0], a[1]); w.y = cvt_pk_bf16(a[2], a[3]); w.z = cvt_pk_bf16(b[0], b[1]); w.w = cvt_pk_bf16(b[2], b[3]); return w; }
__device__ __forceinline__ void unpack8(u32x4 w, f32x4& a, f32x4& b) { a = (f32x4){bflo(w.x), bfhi(w.x), bflo(w.y), bfhi(w.y)}; b = (f32x4){bflo(w.z), bfhi(w.z), bflo(w.w), bfhi(w.w)}; }
__device__ __forceinline__ float red_fq(float v) { v += __shfl_xor(v, 16); v += __shfl_xor(v, 32); return v; }
__device__ __forceinline__ float red8(float v) { v += __shfl_xor(v, 1); v += __shfl_xor(v, 2); v += __shfl_xor(v, 4); return v; }
__device__ __forceinline__ float sq4(f32x4 a) { return a[0] * a[0] + a[1] * a[1] + a[2] * a[2] + a[3] * a[3]; }
__device__ __forceinline__ float sum4(f32x4 a) { return (a[0] + a[1]) + (a[2] + a[3]); }
__device__ __forceinline__ float sum16(const float* sp) { return (sum4(*(const f32x4*)sp) + sum4(*(const f32x4*)(sp + 4))) + (sum4(*(const f32x4*)(sp + 8)) + sum4(*(const f32x4*)(sp + 12))); }

__device__ __forceinline__ void seg_z(int kind, float rs, f32x4& v0, f32x4& v1, float& s1, float& s2) {
    v0 *= rs; v1 *= rs;
    if (kind != 0) { v0 = gelu4(v0); v1 = gelu4(v1); }
    if (kind == 3) { s1 += sum4(v0) + sum4(v1); s2 += sq4(v0) + sq4(v1); }
}
struct EpiZ {
    static constexpr bool PERM = true, HAS_MID = false, AFTER_DRAIN = false, APERM = false;
    bf16_t* Z; const float* rstd1; float* lnstat;
    __device__ __forceinline__ void operator()(const Acc& acc, const Unit& u, int ui, int wr, int wc, int fr, int fq) const {
        const int row0 = u.pm * 256 + wr * 64 + fr, col0 = u.pn * 256 + wc * 32 + 8 * fq, kind = u.pn >> 1;
#pragma unroll
        for (int ai = 0; ai < 2; ++ai)
#pragma unroll
            for (int m = 0; m < 4; ++m) {
                const int row = row0 + ai * 128 + m * 16; const float rs = rstd1[row];
                float s1 = 0.f, s2 = 0.f;
#pragma unroll
                for (int bj = 0; bj < 2; ++bj) {
                    f32x4 v0 = acc[ai][bj][m][0], v1 = acc[ai][bj][m][1];
                    seg_z(kind, rs, v0, v1, s1, s2);
                    *(u32x4*)(Z + (size_t)row * 2048 + col0 + bj * 128) = pack8(v0, v1);
                }
                if (kind == 3) { s1 = red_fq(s1); s2 = red_fq(s2);
                    if (fq == 0) *(f32x2*)(lnstat + (size_t)row * 16 + (((u.pn - 6) * 4 + wc) * 2)) = (f32x2){s1, s2}; }
            }
    }
};
struct EpiE {
    static constexpr bool PERM = true, HAS_MID = false, AFTER_DRAIN = false, APERM = false;
    bf16_t* O;
    __device__ __forceinline__ void operator()(const Acc& acc, const Unit& u, int ui, int wr, int wc, int fr, int fq) const {
        const int row0 = u.pm * 256 + wr * 64 + fr, col0 = u.pn * 256 + wc * 32 + 8 * fq;
#pragma unroll
        for (int ai = 0; ai < 2; ++ai)
#pragma unroll
            for (int m = 0; m < 4; ++m)
#pragma unroll
                for (int bj = 0; bj < 2; ++bj)
                    *(u32x4*)(O + (size_t)(row0 + ai * 128 + m * 16) * 1024 + col0 + bj * 128) = pack8(acc[ai][bj][m][0], acc[ai][bj][m][1]);
    }
};
struct EpiH1 {
    static constexpr bool PERM = true, HAS_MID = true, AFTER_DRAIN = false, APERM = false;
    const bf16_t* Xb; bf16_t* Hb; float* ssq; const LAS f32x2* tab;
    __device__ __forceinline__ void mid(Acc& acc, const Unit& u, int ui, int wr, int fr) const {
#pragma unroll
        for (int ai = 0; ai < 2; ++ai)
#pragma unroll
            for (int m = 0; m < 4; ++m) { const float r = tab[ui * 256 + ai * 128 + wr * 64 + m * 16 + fr].x;
#pragma unroll
                for (int bj = 0; bj < 2; ++bj)
#pragma unroll
                    for (int n = 0; n < 2; ++n) acc[ai][bj][m][n] *= r; }
    }
    __device__ __forceinline__ void operator()(const Acc& acc, const Unit& u, int ui, int wr, int wc, int fr, int fq) const {
        const int rt0 = wr * 64 + fr, col0 = u.pn * 256 + wc * 32 + 8 * fq;
#pragma unroll
        for (int ai = 0; ai < 2; ++ai)
#pragma unroll
            for (int m = 0; m < 4; ++m) {
                const int rt = rt0 + ai * 128 + m * 16, row = u.pm * 256 + rt; const float rs = tab[ui * 256 + rt].y;
                float ss = 0.f;
#pragma unroll
                for (int bj = 0; bj < 2; ++bj) { const size_t o = (size_t)row * 1024 + col0 + bj * 128;
                    f32x4 x0, x1; unpack8(*(const u32x4*)(Xb + o), x0, x1);
                    const f32x4 h0 = x0 + acc[ai][bj][m][0] * rs, h1 = x1 + acc[ai][bj][m][1] * rs;
                    ss += sq4(h0) + sq4(h1);
                    *(u32x4*)(Hb + o) = pack8(h0, h1); }
                ss = red_fq(ss);
                if (fq == 0) ssq[(size_t)row * 16 + u.pn * 4 + wc] = ss;
            }
    }
};
struct EpiH2 {
    static constexpr bool PERM = true, HAS_MID = false, AFTER_DRAIN = false, APERM = false;
    bf16_t* Hb; float* ssq;
    __device__ __forceinline__ void operator()(const Acc& acc, const Unit& u, int ui, int wr, int wc, int fr, int fq) const {
        const int row0 = u.pm * 256 + wr * 64 + fr, col0 = u.pn * 256 + wc * 32 + 8 * fq;
#pragma unroll
        for (int ai = 0; ai < 2; ++ai)
#pragma unroll
            for (int m = 0; m < 4; ++m) {
                const int row = row0 + ai * 128 + m * 16; float ss = 0.f;
#pragma unroll
                for (int bj = 0; bj < 2; ++bj) { bf16_t* hp = Hb + (size_t)row * 1024 + col0 + bj * 128;
                    f32x4 x0, x1; unpack8(*(const u32x4*)hp, x0, x1);
                    const f32x4 h0 = x0 + acc[ai][bj][m][0], h1 = x1 + acc[ai][bj][m][1];
                    ss += sq4(h0) + sq4(h1);
                    *(u32x4*)hp = pack8(h0, h1); }
                ss = red_fq(ss);
                if (fq == 0) ssq[(size_t)row * 16 + u.pn * 4 + wc] = ss;
            }
    }
};
struct EpiG {
    static constexpr bool PERM = true, HAS_MID = false, AFTER_DRAIN = false, APERM = false;
    const bf16_t* Hb; const bf16_t* E; bf16_t* H3; float* ssq; const LAS float* tab;
    __device__ __forceinline__ void operator()(const Acc& acc, const Unit& u, int ui, int wr, int wc, int fr, int fq) const {
        const int rt0 = wr * 64 + fr, col0 = u.pn * 256 + wc * 32 + 8 * fq;
#pragma unroll
        for (int ai = 0; ai < 2; ++ai)
#pragma unroll
            for (int m = 0; m < 4; ++m) {
                const int rt = rt0 + ai * 128 + m * 16, row = u.pm * 256 + rt; const float rs = tab[ui * 256 + rt]; float ss = 0.f;
#pragma unroll
                for (int bj = 0; bj < 2; ++bj) { const size_t o = (size_t)row * 1024 + col0 + bj * 128;
                    f32x4 e0, e1, x0, x1; unpack8(*(const u32x4*)(E + o), e0, e1); unpack8(*(const u32x4*)(Hb + o), x0, x1);
                    f32x4 g0 = acc[ai][bj][m][0] * rs, g1 = acc[ai][bj][m][1] * rs;
#pragma unroll
                    for (int e = 0; e < 4; ++e) { g0[e] = sigmoidf_(g0[e]); g1[e] = sigmoidf_(g1[e]); }
                    const f32x4 h0 = x0 + e0 * g0, h1 = x1 + e1 * g1;
                    ss += sq4(h0) + sq4(h1);
                    *(u32x4*)(H3 + o) = pack8(h0, h1); }
                ss = red_fq(ss);
                if (fq == 0) ssq[(size_t)row * 16 + u.pn * 4 + wc] = ss;
            }
    }
};
struct EpiGF {
    static constexpr bool PERM = true, HAS_MID = false, AFTER_DRAIN = true, APERM = false;
    const bf16_t* Hb; const bf16_t* E; float* Y; const float* gfin; float* X; unsigned* cnt; const LAS float* tab;
    __device__ __forceinline__ void operator()(const Acc& acc, const Unit& u, int ui, int wr, int wc, int fr, int fq) const {}
    __device__ __forceinline__ void fused(Acc& acc, const Unit& u, int ui, int wr, int wc, int fr, int fq, LAS unsigned char* lds) const {
        const int rt0 = wr * 64 + fr, col0 = u.pn * 256 + wc * 32 + 8 * fq, tid = threadIdx.x;
        LAS float* Pw = (LAS float*)lds;
        LAS float* Rs = (LAS float*)lds + 1024;
#pragma unroll
        for (int ai = 0; ai < 2; ++ai)
#pragma unroll
            for (int m = 0; m < 4; ++m) {
                const int rt = rt0 + ai * 128 + m * 16, row = u.pm * 256 + rt; const float rs = tab[ui * 256 + rt]; float ss = 0.f;
#pragma unroll
                for (int bj = 0; bj < 2; ++bj) { const size_t o = (size_t)row * 1024 + col0 + bj * 128;
                    f32x4 e0, e1, x0, x1; unpack8(*(const u32x4*)(E + o), e0, e1); unpack8(*(const u32x4*)(Hb + o), x0, x1);
                    f32x4 g0 = acc[ai][bj][m][0] * rs, g1 = acc[ai][bj][m][1] * rs;
#pragma unroll
                    for (int e = 0; e < 4; ++e) { g0[e] = sigmoidf_(g0[e]); g1[e] = sigmoidf_(g1[e]); }
                    const f32x4 h0 = x0 + e0 * g0, h1 = x1 + e1 * g1;
                    ss += sq4(h0) + sq4(h1);
                    acc[ai][bj][m][0] = h0; acc[ai][bj][m][1] = h1; }
                ss = red_fq(ss);
                if (fq == 0) Pw[rt * 4 + wc] = ss;
            }
        __syncthreads();
        if (tid < 256) { const f32x4 q = *(const LAS f32x4*)(Pw + tid * 4);
            __hip_atomic_store((unsigned*)(X + ((size_t)u.pm * 4 + u.pn) * 256 + tid), __float_as_uint(sum4(q)), __ATOMIC_RELAXED, __HIP_MEMORY_SCOPE_AGENT); }
        asm volatile("s_waitcnt vmcnt(0)" ::: "memory");
        __syncthreads();
        if (tid == 0) { __hip_atomic_fetch_add(cnt + u.pm * 16, 1u, __ATOMIC_RELAXED, __HIP_MEMORY_SCOPE_AGENT); unsigned sp = 0;
            while (__hip_atomic_load(cnt + u.pm * 16, __ATOMIC_RELAXED, __HIP_MEMORY_SCOPE_AGENT) < 4u) { __builtin_amdgcn_s_sleep(1); if (++sp > (1u << 22)) break; } }
        __syncthreads();
        if (tid < 256) { float s = 0.f;
#pragma unroll
            for (int k = 0; k < 4; ++k) s += __uint_as_float(__hip_atomic_load((const unsigned*)(X + ((size_t)u.pm * 4 + k) * 256 + tid), __ATOMIC_RELAXED, __HIP_MEMORY_SCOPE_AGENT));
            Rs[tid] = rsqrtf(s * (1.0f / 1024.0f) + EPS); }
        __syncthreads();
        f32x4 gv[2][2];
#pragma unroll
        for (int bj = 0; bj < 2; ++bj) { gv[bj][0] = *(const f32x4*)(gfin + col0 + bj * 128); gv[bj][1] = *(const f32x4*)(gfin + col0 + bj * 128 + 4); }
#pragma unroll
        for (int ai = 0; ai < 2; ++ai)
#pragma unroll
            for (int m = 0; m < 4; ++m) {
                const int rt = rt0 + ai * 128 + m * 16, row = u.pm * 256 + rt; const float rs = Rs[rt];
#pragma unroll
                for (int bj = 0; bj < 2; ++bj) { float* yp = Y + (size_t)row * 1024 + col0 + bj * 128;
                    *(f32x4*)yp = acc[ai][bj][m][0] * rs * gv[bj][0]; *(f32x4*)(yp + 4) = acc[ai][bj][m][1] * rs * gv[bj][1]; }
            }
        __syncthreads();
    }
};
template <int C> __device__ __forceinline__ f32x4 dpp4(f32x4 v) { return (f32x4){dppf<C>(v[0]), dppf<C>(v[1]), dppf<C>(v[2]), dppf<C>(v[3])}; }
__device__ __forceinline__ f32x4 sel4(bool c, f32x4 a, f32x4 b) { return c ? a : b; }
template <int C> __device__ __forceinline__ float dppo(float old, float v) { return __int_as_float(__builtin_amdgcn_update_dpp(__float_as_int(old), __float_as_int(v), C, 0xf, 0xf, false)); }
template <int C> __device__ __forceinline__ f32x4 dppo4(f32x4 o, f32x4 v) { return (f32x4){dppo<C>(o[0], v[0]), dppo<C>(o[1], v[1]), dppo<C>(o[2], v[2]), dppo<C>(o[3], v[3])}; }
template <int C> __device__ __forceinline__ float dppz(float v) { return __int_as_float(__builtin_amdgcn_update_dpp(0, __float_as_int(v), C, 0xf, 0xf, true)); }
template <int C> __device__ __forceinline__ f32x4 dppz4(f32x4 v) { return (f32x4){dppz<C>(v[0]), dppz<C>(v[1]), dppz<C>(v[2]), dppz<C>(v[3])}; }
struct EpiUp {
    static constexpr bool PERM = true, HAS_MID = false, AFTER_DRAIN = false, APERM = true;
    bf16_t* ACT; const LAS float* tab; const float* cw; const float* cb; bf16_t* halo; float* ofp; int mode;
    __device__ __forceinline__ void operator()(const Acc& acc, const Unit& u, int ui, int wr, int wc, int fr, int fq) const {
        const int jc0 = u.pn * 128 + wc * 32 + 8 * fq;
        u32x2 held[2][4];
#pragma unroll
        for (int n = 0; n < 2; ++n) {
            const int jc = jc0 + 4 * n;
            const f32x4 w0g = *(const f32x4*)(cw + jc), w1g = *(const f32x4*)(cw + 6144 + jc), w2g = *(const f32x4*)(cw + 12288 + jc), bg = *(const f32x4*)(cb + jc);
            const f32x4 w0v = *(const f32x4*)(cw + 3072 + jc), w1v = *(const f32x4*)(cw + 6144 + 3072 + jc), w2v = *(const f32x4*)(cw + 12288 + 3072 + jc), bv = *(const f32x4*)(cb + 3072 + jc);
#pragma unroll
            for (int ai = 0; ai < 2; ++ai) {
                const int rt0 = ai * 128 + wr * 64 + 4 * fr, row0 = u.pm * 256 + rt0, g = row0 >> 6;
                const f32x4 rs = *(const LAS f32x4*)(tab + ui * 256 + rt0);
                f32x4 cg[4], cv[4];
#pragma unroll
                for (int m = 0; m < 4; ++m) { cg[m] = acc[ai][0][m][n] * rs[m]; cv[m] = acc[ai][1][m][n] * rs[m]; }
                const f32x4 pg3 = dppz4<0x111>(cg[3]), pg2 = dppz4<0x111>(cg[2]), pv3 = dppz4<0x111>(cv[3]), pv2 = dppz4<0x111>(cv[2]);
#pragma unroll
                for (int m = 0; m < 4; ++m) {
                    const f32x4 xg1 = m == 0 ? pg3 : cg[m - 1], xg2 = m == 0 ? pg2 : (m == 1 ? pg3 : cg[m - 2]);
                    const f32x4 xv1 = m == 0 ? pv3 : cv[m - 1], xv2 = m == 0 ? pv2 : (m == 1 ? pv3 : cv[m - 2]);
                    const f32x4 og = bg + w0g * xg2 + w1g * xg1 + w2g * cg[m], ov = bv + w0v * xv2 + w1v * xv1 + w2v * cv[m];
                    const f32x4 av = gelu4(og) * ov;
                    const u32x2 pk = (u32x2){cvt_pk_bf16(av[0], av[1]), cvt_pk_bf16(av[2], av[3])};
                    if (n == 0) held[ai][m] = pk;
                    else if (!(m < 2 && fr == 0)) *(u32x4*)(ACT + (size_t)(row0 + m) * 3072 + jc0) = (u32x4){held[ai][m].x, held[ai][m].y, pk.x, pk.y};
                }
                if (fr == 0) {
#pragma unroll
                    for (int m = 0; m < 2; ++m) { bf16_t* hp = halo + (size_t)(g * 4 + m) * 6144 + jc;
                        *(u32x2*)hp = (u32x2){cvt_pk_bf16(cg[m][0], cg[m][1]), cvt_pk_bf16(cg[m][2], cg[m][3])}; *(u32x2*)(hp + 3072) = (u32x2){cvt_pk_bf16(cv[m][0], cv[m][1]), cvt_pk_bf16(cv[m][2], cv[m][3])}; } }
                if (fr == 15) {
#pragma unroll
                    for (int m = 2; m < 4; ++m) { bf16_t* hp = halo + (size_t)(g * 4 + m) * 6144 + jc;
                        *(u32x2*)hp = (u32x2){cvt_pk_bf16(cg[m][0], cg[m][1]), cvt_pk_bf16(cg[m][2], cg[m][3])}; *(u32x2*)(hp + 3072) = (u32x2){cvt_pk_bf16(cv[m][0], cv[m][1]), cvt_pk_bf16(cv[m][2], cv[m][3])};
                        const int row = row0 + m;
                        if ((row & 2047) >= 2046) { float* op = ofp + (size_t)((row >> 11) * 2 + (row & 2047) - 2046) * 6144 + jc; *(f32x4*)op = cg[m]; *(f32x4*)(op + 3072) = cv[m]; } } }
            }
        }
    }
};

template <int UN> struct Frags { bf16x8 a[UN][4], b[UN][4]; };
struct TileP { const bf16_t* ap; const bf16_t* bp[4]; int lda; };
__device__ __forceinline__ TileP st_tile(const bf16_t* A, int lda, int arow0, const bf16_t* Bt, int ldb, int b0, int b1, int b2, int b3, int K) {
    int tid_ = threadIdx.x; asm volatile("" : "+v"(tid_));
    const int wave = tid_ >> 6, lane = tid_ & 63, fr = lane & 15, fq = lane >> 4, kw = K >> 3;
    TileP t; t.lda = lda; t.ap = A + (size_t)(arow0 + fr) * lda + wave * kw + 8 * fq;
    const bf16_t* bb = Bt + (size_t)fr * ldb + wave * kw + 8 * fq;
    t.bp[0] = bb + (size_t)b0 * ldb; t.bp[1] = bb + (size_t)b1 * ldb; t.bp[2] = bb + (size_t)b2 * ldb; t.bp[3] = bb + (size_t)b3 * ldb;
    return t;
}
template <int UN> __device__ __forceinline__ void st_load(Frags<UN>& F, const TileP& t, int s0) {
#pragma unroll
    for (int s = 0; s < UN; ++s)
#pragma unroll
        for (int i = 0; i < 4; ++i) { F.a[s][i] = *(const bf16x8*)(t.ap + (size_t)(16 * i) * t.lda + (s0 + s) * 32); F.b[s][i] = *(const bf16x8*)(t.bp[i] + (s0 + s) * 32); }
}
template <int UN> __device__ __forceinline__ void st_mma(f32x4 (&acc)[4][4], const Frags<UN>& F) {
#pragma unroll
    for (int s = 0; s < UN; ++s)
#pragma unroll
        for (int i = 0; i < 4; ++i)
#pragma unroll
            for (int j = 0; j < 4; ++j) acc[i][j] = __builtin_amdgcn_mfma_f32_16x16x32_bf16(F.b[s][j], F.a[s][i], acc[i][j], 0, 0, 0);
}
__device__ __forceinline__ void st_zero(f32x4 (&acc)[4][4]) {
#pragma unroll
    for (int i = 0; i < 4; ++i)
#pragma unroll
        for (int j = 0; j < 4; ++j) acc[i][j] = (f32x4){0.f, 0.f, 0.f, 0.f};
}
__device__ __forceinline__ void st_reduce(LAS unsigned char* lds, const f32x4 (&acc)[4][4], f32x4& lo0, f32x4& lo1, f32x4& hi0, f32x4& hi1) {
    int tid_ = threadIdx.x; asm volatile("" : "+v"(tid_));
    const int tid = tid_, wave = tid >> 6, lane = tid & 63, fr = lane & 15, fq = lane >> 4;
    LAS float* P = (LAS float*)lds + wave * 4096;
#pragma unroll
    for (int i = 0; i < 4; ++i)
#pragma unroll
        for (int j = 0; j < 4; ++j) { const int r = 16 * i + fr, ch = (4 * j + fq) ^ fr; *(LAS f32x4*)(P + r * 64 + ch * 4) = acc[i][j]; }
    __syncthreads();
    {   const int r = tid >> 3, c = tid & 7; LAS const float* Q = (LAS const float*)lds + r * 64;
        const int c0 = ((2 * c) ^ (r & 15)) * 4, c1 = ((2 * c + 1) ^ (r & 15)) * 4;
        lo0 = (f32x4){0.f, 0.f, 0.f, 0.f}; lo1 = lo0; hi0 = lo0; hi1 = lo0;
#pragma unroll
        for (int w = 0; w < 4; ++w) { lo0 += *(LAS const f32x4*)(Q + w * 4096 + c0); lo1 += *(LAS const f32x4*)(Q + w * 4096 + c1);
            hi0 += *(LAS const f32x4*)(Q + (w + 4) * 4096 + c0); hi1 += *(LAS const f32x4*)(Q + (w + 4) * 4096 + c1); } }
    __syncthreads();
}
struct XpT { const float* src; const float* scale; bf16_t* dst; };
__device__ __forceinline__ XpT xp_desc(KP p, unsigned char* ws, int tt) {
    const int lane = threadIdx.x & 63, w = threadIdx.x >> 6;
    const float* src; int ldsrc, k0, scol0, lddst, drow0; const float* scale; bf16_t* dst;
    if (tt < 512) { const int kt = tt >> 5, nt = tt & 31; src = p->in[8]; ldsrc = 2048; k0 = kt * 64; scol0 = nt * 64; scale = p->in[7] + k0; dst = (bf16_t*)(ws + OFF_WIN); lddst = 1024; drow0 = nt * 64; }
    else if (tt < 768) { const int t2 = tt - 512, kt = t2 >> 4, nt = t2 & 15; src = p->in[22]; ldsrc = 1024; k0 = kt * 64; scol0 = nt * 64; scale = k0 < 512 ? p->in[16] + k0 : p->in[21] + (k0 - 512); dst = (bf16_t*)(ws + OFF_WOUT); lddst = 1024; drow0 = nt * 64; }
    else if (tt < 2304) { const int t2 = tt - 768, kt = t2 / 96, nt = t2 % 96, n0 = nt * 64; src = p->in[24]; ldsrc = 6144; k0 = kt * 64; scol0 = ((n0 & 255) >> 7) * 3072 + (n0 >> 8) * 128 + (n0 & 127); scale = p->in[23] + k0; dst = (bf16_t*)(ws + OFF_WUP); lddst = 1024; drow0 = n0; }
    else if (tt < 3072) { const int t2 = tt - 2304, kt = t2 >> 4, nt = t2 & 15; src = p->in[27]; ldsrc = 1024; k0 = kt * 64; scol0 = nt * 64; scale = nullptr; dst = (bf16_t*)(ws + OFF_WDN); lddst = 3072; drow0 = nt * 64; }
    else if (tt < 3328) { const int t2 = tt - 3072, kt = t2 >> 4, nt = t2 & 15; src = p->in[29]; ldsrc = 1024; k0 = kt * 64; scol0 = nt * 64; scale = p->in[28] + k0; dst = (bf16_t*)(ws + OFF_WPG); lddst = 1024; drow0 = nt * 64; }
    else { const int t2 = tt - 3328, kt = t2 >> 4, nt = t2 & 15; src = p->in[30]; ldsrc = 1024; k0 = kt * 64; scol0 = nt * 64; scale = nullptr; dst = (bf16_t*)(ws + OFF_WPLE); lddst = 256; drow0 = nt * 64; }
    XpT t; t.src = src + (size_t)(k0 + 8 * w) * ldsrc + scol0 + lane; t.scale = scale ? scale + 8 * w : nullptr; t.dst = dst + (size_t)(drow0 + lane) * lddst + k0 + 8 * w;
    return t;
}
__device__ __forceinline__ int xp_ld(int tt) { return tt < 512 ? 2048 : (tt >= 768 && tt < 2304) ? 6144 : 1024; }
__device__ __forceinline__ void xp_pair(KP p, unsigned char* ws, int tt, int t1, bool two) {
    const XpT A = xp_desc(p, ws, tt), B = xp_desc(p, ws, two ? t1 : tt);
    const int la = xp_ld(tt), lb = xp_ld(two ? t1 : tt);
    float va[8], vb[8];
#pragma unroll
    for (int e = 0; e < 8; ++e) { va[e] = __builtin_nontemporal_load(A.src + (size_t)e * la); vb[e] = __builtin_nontemporal_load(B.src + (size_t)e * lb); }
    if (A.scale) {
#pragma unroll
        for (int e = 0; e < 8; ++e) va[e] *= A.scale[e]; }
    if (B.scale) {
#pragma unroll
        for (int e = 0; e < 8; ++e) vb[e] *= B.scale[e]; }
    *(u32x4*)A.dst = (u32x4){cvt_pk_bf16(va[0], va[1]), cvt_pk_bf16(va[2], va[3]), cvt_pk_bf16(va[4], va[5]), cvt_pk_bf16(va[6], va[7])};
    if (two) *(u32x4*)B.dst = (u32x4){cvt_pk_bf16(vb[0], vb[1]), cvt_pk_bf16(vb[2], vb[3]), cvt_pk_bf16(vb[4], vb[5]), cvt_pk_bf16(vb[6], vb[7])};
}
__device__ __forceinline__ int xp_p0_tile(int ti) { return ti < 768 ? ti : ti + 2304; }
__device__ __forceinline__ void p0_phase(KP p, LAS unsigned char* lds) {
    const int tid = threadIdx.x, lane = tid & 63, wave = tid >> 6, G = gridDim.x, blk = blockIdx.x;
    unsigned char* ws = p->ws;
    {   bf16_t* Xb = (bf16_t*)(ws + OFF_XB); float* rstd1 = (float*)(ws + OFF_RSTD1);
        for (int r0 = (blk * 8 + wave) * 2; r0 < NT; r0 += G * 16) {
            f32x4 v[2][4]; float ss[2];
#pragma unroll
            for (int h = 0; h < 2; ++h) { const int r = r0 + h; const float* src = r < NP ? p->in[0] + (size_t)r * D : p->in[1] + (size_t)(r - NP) * D;
#pragma unroll
                for (int i = 0; i < 4; ++i) v[h][i] = __builtin_nontemporal_load((const f32x4*)(src + i * 256 + lane * 4)); }
#pragma unroll
            for (int h = 0; h < 2; ++h) { ss[h] = 0.f;
#pragma unroll
                for (int i = 0; i < 4; ++i) ss[h] += sq4(v[h][i]);
                ss[h] = wave_sum(ss[h]);
                if (lane == 0) rstd1[r0 + h] = rsqrtf(ss[h] * (1.0f / 1024.0f) + EPS);
#pragma unroll
                for (int i = 0; i < 4; ++i) *(u32x2*)(Xb + (size_t)(r0 + h) * D + i * 256 + lane * 4) = (u32x2){cvt_pk_bf16(v[h][i][0], v[h][i][1]), cvt_pk_bf16(v[h][i][2], v[h][i][3])}; }
        } }
    {   bf16_t* Pb = (bf16_t*)(ws + OFF_PB);
        for (size_t i0 = ((size_t)blk * 512 + tid) * 4; i0 < (size_t)NT * 256; i0 += (size_t)G * 512 * 16) {
            f32x4 v[4];
#pragma unroll
            for (int h = 0; h < 4; ++h) { const size_t idx = i0 + (size_t)h * G * 512 * 4;
                if (idx < (size_t)NT * 256) v[h] = __builtin_nontemporal_load((const f32x4*)(idx < (size_t)NP * 256 ? p->in[2] + idx : p->in[3] + (idx - (size_t)NP * 256))); }
#pragma unroll
            for (int h = 0; h < 4; ++h) { const size_t idx = i0 + (size_t)h * G * 512 * 4;
                if (idx < (size_t)NT * 256) *(u32x2*)(Pb + idx) = (u32x2){cvt_pk_bf16(v[h][0], v[h][1]), cvt_pk_bf16(v[h][2], v[h][3])}; }
        } }
    {   for (int ti = blk; ti < 1088; ti += 2 * G) { const int t1 = ti + G; const bool two = t1 < 1088; xp_pair(p, ws, xp_p0_tile(ti), xp_p0_tile(two ? t1 : ti), two); } }
    {   u32x4* ag = (u32x4*)(ws + OFF_AGG); for (int i = blk * 512 + tid; i < 32768; i += G * 512) ag[i] = (u32x4){0u, 0u, 0u, 0u}; }
    {   bf16_t* Wg = (bf16_t*)(ws + OFF_WG); bf16_t* Ws = (bf16_t*)(ws + OFF_WSGU);
        if (blk == 0) ((float*)(ws + OFF_SP))[tid] = log1pf(expf(-p->in[15][tid]));
        for (int idx = blk * 512 + tid; idx < 65536; idx += G * 512) {
            const int hd = idx >> 13, n = (idx >> 6) & 127, k = idx & 63;
            const float v = n < 64 ? p->in[11][(hd * 64 + k) * 64 + n] : p->in[13][(hd * 64 + k) * 64 + (n - 64)];
            Wg[idx] = (bf16_t)(cvt_pk_bf16(v, 0.f) & 0xffffu);
            const int t = (idx >> 7) & 127, s = idx & 127;
            const float w = s <= t ? p->in[19][idx] : 0.f;
            Ws[idx] = (bf16_t)(cvt_pk_bf16(w, 0.f) & 0xffffu);
        } }
}

__device__ __forceinline__ float ald_f(const float* p) { return __uint_as_float(__hip_atomic_load((const unsigned*)p, __ATOMIC_RELAXED, __HIP_MEMORY_SCOPE_AGENT)); }
__device__ __forceinline__ void ast_f(float* p, float v) { __hip_atomic_store((unsigned*)p, __float_as_uint(v), __ATOMIC_RELAXED, __HIP_MEMORY_SCOPE_AGENT); }

__device__ __forceinline__ void p2_taskA(KP p, LAS unsigned char* lds, int task, int skip = 0) {
    int tid_ = threadIdx.x; asm volatile("" : "+v"(tid_));
    const int tid = tid_, lane = tid & 63, wave = tid >> 6;
    unsigned char* ws = p->ws;
    const bool samp = task >= 1024;
    const int hd = task & 7;
    const int c = samp ? 0 : (task >> 6), b = samp ? 0 : ((task >> 3) & 7), sc = samp ? ((task - 1024) >> 3) : 0;
    const int R0 = samp ? NP + sc * 128 : b * 2048 + c * 128;
    const bf16_t* Z = (const bf16_t*)(ws + OFF_Z);
    LAS bf16_t* xcb = (LAS bf16_t*)lds;
    LAS float* aS = (LAS float*)(lds + 18432);
    LAS float* uS = (LAS float*)(lds + 18432 + 34816);
    LAS float* Pseg = (LAS float*)(lds + 88064);
    LAS float* Sseg = Pseg + 512;
    LAS float* hin = Sseg + 512;
    const bf16_t* gap_ = Z + (size_t)(R0 + (tid >> 2)) * 2048 + 512 + hd * 64 + (tid & 3) * 16;
    const u32x4 gaw0 = *(const u32x4*)gap_, gaw1 = *(const u32x4*)(gap_ + 8);
    if (!(skip & 1))
    {   const int t = tid >> 2, cgp = tid & 3, ch0 = hd * 64 + cgp * 16;
        f32x4 xc[4];
#pragma unroll
        for (int i = 0; i < 4; ++i) xc[i] = *(const f32x4*)(p->in[10] + ch0 + 4 * i);
#pragma unroll
        for (int j = 0; j < 4; ++j) {
            f32x4 xv[4] = {{0.f, 0.f, 0.f, 0.f}, {0.f, 0.f, 0.f, 0.f}, {0.f, 0.f, 0.f, 0.f}, {0.f, 0.f, 0.f, 0.f}};
            const bf16_t* src = nullptr; const float* srcf = nullptr;
            if (!samp) { const int pos = c * 128 + t - 3 + j; if (pos >= 0) src = Z + (size_t)(b * 2048 + pos) * 2048 + ch0; }
            else { const int q = sc * 32 + (t >> 2), idx = (t & 3) + j; if (idx < 3) srcf = p->in[5] + ((size_t)q * 3 + idx) * 512 + ch0; else src = Z + (size_t)(NP + 4 * q + idx - 3) * 2048 + ch0; }
            if (src) { const u32x4 w0 = *(const u32x4*)src, w1 = *(const u32x4*)(src + 8); unpack8(w0, xv[0], xv[1]); unpack8(w1, xv[2], xv[3]); }
            else if (srcf) {
#pragma unroll
                for (int i = 0; i < 4; ++i) xv[i] = *(const f32x4*)(srcf + 4 * i); }
#pragma unroll
            for (int i = 0; i < 4; ++i) xc[i] += *(const f32x4*)(p->in[9] + j * 512 + ch0 + 4 * i) * xv[i];
            if (j == 3) {
                float* op = nullptr;
                if (!samp) { if (c == 15 && t >= 125) op = p->out + O_CP + (size_t)(b * 3 + t - 125) * 512 + ch0; }
                else { const int q = sc * 32 + (t >> 2), pos = t & 3; if (pos >= 1) op = p->out + O_CS + (size_t)(q * 3 + pos - 1) * 512 + ch0; }
                if (op) {
#pragma unroll
                    for (int i = 0; i < 4; ++i) *(f32x4*)(op + 4 * i) = xv[i]; }
            }
        }
        *(LAS u32x4*)(xcb + t * 72 + cgp * 16) = pack8(xc[0], xc[1]);
        *(LAS u32x4*)(xcb + t * 72 + cgp * 16 + 8) = pack8(xc[2], xc[3]);
    }
    __syncthreads();
    if (!(skip & 2))
    {   const int fr = lane & 15, fq = lane >> 4;
        bf16x8 af[2];
#pragma unroll
        for (int ks = 0; ks < 2; ++ks) af[ks] = *(const LAS bf16x8*)(xcb + (16 * wave + fr) * 72 + 32 * ks + 8 * fq);
        LAS const bf16_t* WgL = (LAS const bf16_t*)(lds + 98304);
        f32x4 acc[8];
#pragma unroll
        for (int nb = 0; nb < 8; ++nb) { acc[nb] = (f32x4){0.f, 0.f, 0.f, 0.f};
#pragma unroll
            for (int ks = 0; ks < 2; ++ks) { const bf16x8 bb = *(const LAS bf16x8*)(WgL + (16 * nb + fr) * 72 + 32 * ks + 8 * fq);
                acc[nb] = __builtin_amdgcn_mfma_f32_16x16x32_bf16(af[ks], bb, acc[nb], 0, 0, 0); } }
#pragma unroll
        for (int nb = 0; nb < 4; ++nb) {
            const int ch = 16 * nb + fr, chg = hd * 64 + ch;
            const float ba = p->in[12][chg], bx = p->in[14][chg], sp = ((const float*)(ws + OFF_SP))[chg];
#pragma unroll
            for (int j = 0; j < 4; ++j) {
                const int tok = 16 * wave + 4 * fq + j;
                const float rg = sigmoidf_(acc[nb][j] + ba), ig = sigmoidf_(acc[nb + 4][j] + bx);
                const float la = -8.0f * rg * sp;
                const float a = __builtin_amdgcn_exp2f(1.4426950409f * la);
                float mult = __builtin_amdgcn_sqrtf((1.0f - a) * (1.0f + a));
                if (!samp && c == 0 && tok == 0) mult = 1.0f;
                const float xcv = bf2f(xcb[tok * 72 + ch]);
                aS[tok * 68 + ch] = a; uS[tok * 68 + ch] = xcv * ig * mult;
            }
        }
    }
    __syncthreads();
    if (samp) {
        const int ch = lane;
#pragma unroll
        for (int s4 = 0; s4 < 4; ++s4) {
            const int q = sc * 32 + wave * 4 + s4;
            float h = p->in[4][(size_t)q * 512 + hd * 64 + ch];
#pragma unroll
            for (int i = 0; i < 4; ++i) { const int tok = 16 * wave + 4 * s4 + i; h = aS[tok * 68 + ch] * h + uS[tok * 68 + ch]; uS[tok * 68 + ch] = h; }
            p->out[O_HS + (size_t)q * 512 + hd * 64 + ch] = h;
        }
        __syncthreads();
    } else {
        {   const int ch = lane; float P = 1.f, S = 0.f;
#pragma unroll
            for (int i = 0; i < 16; ++i) { const int o = (16 * wave + i) * 68 + ch; const float a = aS[o]; S = a * S + uS[o]; P *= a; uS[o] = S; aS[o] = P; }
            Pseg[wave * 64 + ch] = P; Sseg[wave * 64 + ch] = S; }
        __syncthreads();
        if (wave == 0) {
            const int ch = lane;
            float Pc = 1.f, Sc = 0.f;
#pragma unroll
            for (int s = 0; s < 8; ++s) { const float P = Pseg[s * 64 + ch]; Sc = P * Sc + Sseg[s * 64 + ch]; Pc *= P; }
            unsigned long long* AGG = (unsigned long long*)(ws + OFF_AGG);
            if (c < 15 && !(skip & 3)) __hip_atomic_store(AGG + (size_t)task * 64 + ch, ((unsigned long long)__float_as_uint(Sc) << 32) | (unsigned long long)(__float_as_uint(Pc) | 0x80000000u), __ATOMIC_RELAXED, __HIP_MEMORY_SCOPE_AGENT);
            float h = 0.f;
            if (c > 0 && !(skip & 4)) {
                unsigned long long gv[15];
#pragma unroll
                for (int j = 0; j < 15; ++j) gv[j] = 1ull;
                unsigned sp = 0;
                for (;;) {
                    bool miss = false;
#pragma unroll
                    for (int j = 0; j < 15; ++j) if (j < c) { gv[j] = __hip_atomic_load(AGG + (size_t)(j * 64 + b * 8 + hd) * 64 + ch, __ATOMIC_RELAXED, __HIP_MEMORY_SCOPE_AGENT); }
#pragma unroll
                    for (int j = 0; j < 15; ++j) miss |= (gv[j] == 0ull);
                    if (__builtin_amdgcn_ballot_w64(miss) == 0ull) break;
                    __builtin_amdgcn_s_sleep(2); if (++sp > (1u << 20)) break;
                }
#pragma unroll
                for (int j = 0; j < 15; ++j) if (j < c) h = __uint_as_float((unsigned)gv[j] & 0x7fffffffu) * h + __uint_as_float((unsigned)(gv[j] >> 32));
            }
#pragma unroll
            for (int s = 0; s < 8; ++s) { hin[s * 64 + ch] = h; h = Pseg[s * 64 + ch] * h + Sseg[s * 64 + ch]; }
            if (c == 15) p->out[O_HP + (size_t)b * 512 + hd * 64 + ch] = h;
        }
        __syncthreads();
    }
    if (!(skip & 8))
    {   const int t = tid >> 2, part = tid & 3, row = R0 + t;
        f32x4 g[4]; unpack8(gaw0, g[0], g[1]); unpack8(gaw1, g[2], g[3]);
        float ss = 0.f;
#pragma unroll
        for (int i = 0; i < 4; ++i) { f32x4 h = *(const LAS f32x4*)(uS + t * 68 + part * 16 + 4 * i);
            if (!samp) h += *(const LAS f32x4*)(aS + t * 68 + part * 16 + 4 * i) * *(const LAS f32x4*)(hin + (t >> 4) * 64 + part * 16 + 4 * i);
            g[i] *= h; ss += sq4(g[i]); }
        ss += __shfl_xor(ss, 1); ss += __shfl_xor(ss, 2);
        if (part == 0) ((float*)(ws + OFF_SSQY))[(size_t)row * 16 + hd] = ss;
        bf16_t* yp = (bf16_t*)(ws + OFF_Y) + (size_t)row * 1024 + hd * 64 + part * 16;
        *(u32x4*)yp = pack8(g[0], g[1]); *(u32x4*)(yp + 8) = pack8(g[2], g[3]);
    }
    __syncthreads();
}

__device__ __forceinline__ void p2_taskB(KP p, LAS unsigned char* lds, int idx) {
    int tid_ = threadIdx.x; asm volatile("" : "+v"(tid_));
    const int tid = tid_, lane = tid & 63, wave = tid >> 6;
    unsigned char* ws = p->ws;
    const int chunk = idx >> 2, hb = idx & 3, R0 = chunk * 128;
    const bf16_t* Z = (const bf16_t*)(ws + OFF_Z);
    LAS bf16_t* vnT = (LAS bf16_t*)lds;
    {   const int s = tid >> 2, dg = tid & 3;
        float m_, r_;
        {   const float* lp = (const float*)(ws + OFF_LNSTAT) + (size_t)(R0 + s) * 16;
            float s1 = 0.f, s2 = 0.f;
#pragma unroll
            for (int i = 0; i < 4; ++i) { const f32x4 v = *(const f32x4*)(lp + 4 * i); s1 += v[0] + v[2]; s2 += v[1] + v[3]; }
            m_ = s1 * (1.0f / 512.0f); r_ = rsqrtf(s2 * (1.0f / 512.0f) - m_ * m_ + EPS); }
        const bf16_t* gp = Z + (size_t)(R0 + s) * 2048 + 1536 + hb * 128 + dg * 32;
#pragma unroll
        for (int q8 = 0; q8 < 4; ++q8) {
            f32x4 g0, g1; unpack8(*(const u32x4*)(gp + 8 * q8), g0, g1);
            const int d0 = dg * 32 + 8 * q8;
            const f32x4 lg0 = *(const f32x4*)(p->in[17] + hb * 128 + d0), lg1 = *(const f32x4*)(p->in[17] + hb * 128 + d0 + 4);
            const f32x4 lb0 = *(const f32x4*)(p->in[18] + hb * 128 + d0), lb1 = *(const f32x4*)(p->in[18] + hb * 128 + d0 + 4);
            g0 = (g0 - m_) * r_ * lg0 + lb0; g1 = (g1 - m_) * r_ * lg1 + lb1;
#pragma unroll
            for (int e = 0; e < 4; ++e) { vnT[(d0 + e) * 136 + s] = (bf16_t)(cvt_pk_bf16(g0[e], 0.f) & 0xffffu); vnT[(d0 + 4 + e) * 136 + s] = (bf16_t)(cvt_pk_bf16(g1[e], 0.f) & 0xffffu); }
        } }
    __syncthreads();
    {   const int fr = lane & 15, fq = lane >> 4, t = 16 * wave + fr, row = R0 + t;
        const bf16_t* W = (const bf16_t*)(ws + OFF_WSGU) + hb * 16384;
        f32x4 acc[8]; u32x2 gwv[8];
        const float bs = p->in[20][hb * 128 + t];
#pragma unroll
        for (int nb = 0; nb < 8; ++nb) { acc[nb] = (f32x4){0.f, 0.f, 0.f, 0.f}; gwv[nb] = *(const u32x2*)(Z + (size_t)row * 2048 + 1024 + hb * 128 + 16 * nb + 4 * fq); }
        for (int ks = 0; ks <= (wave >> 1); ++ks) {
            const bf16x8 wf = *(const bf16x8*)(W + t * 128 + 32 * ks + 8 * fq);
#pragma unroll
            for (int nb = 0; nb < 8; ++nb) { const bf16x8 vf = *(const LAS bf16x8*)(vnT + (16 * nb + fr) * 136 + 32 * ks + 8 * fq);
                acc[nb] = __builtin_amdgcn_mfma_f32_16x16x32_bf16(vf, wf, acc[nb], 0, 0, 0); } }
        float ss = 0.f;
#pragma unroll
        for (int nb = 0; nb < 8; ++nb) { const int d0 = hb * 128 + 16 * nb + 4 * fq; const u32x2 gw = gwv[nb];
            f32x4 v = (f32x4){bflo(gw.x), bfhi(gw.x), bflo(gw.y), bfhi(gw.y)} * (acc[nb] + bs);
            ss += sq4(v);
            *(u32x2*)((bf16_t*)(ws + OFF_Y) + (size_t)row * 1024 + 512 + d0) = (u32x2){cvt_pk_bf16(v[0], v[1]), cvt_pk_bf16(v[2], v[3])}; }
        ss = red_fq(ss);
        if (fq == 0) ((float*)(ws + OFF_SSQY))[(size_t)row * 16 + 8 + hb] = ss;
    }
    __syncthreads();
}
__device__ __forceinline__ void p2_taskBs(KP p, int q) {
    const int lane = threadIdx.x & 63, hb = lane >> 4;
    unsigned char* ws = p->ws;
    const bf16_t* Z = (const bf16_t*)(ws + OFF_Z);
    const f32x4 lg0 = *(const f32x4*)(p->in[17] + 8 * lane), lg1 = *(const f32x4*)(p->in[17] + 8 * lane + 4), lb0 = *(const f32x4*)(p->in[18] + 8 * lane), lb1 = *(const f32x4*)(p->in[18] + 8 * lane + 4);
    f32x4 vn[4][2];
#pragma unroll
    for (int t = 0; t < 4; ++t) {
        const int row = NP + 4 * q + t;
        const float* lp = (const float*)(ws + OFF_LNSTAT) + (size_t)row * 16;
        float s1 = 0.f, s2 = 0.f;
#pragma unroll
        for (int i = 0; i < 4; ++i) { const f32x4 v = *(const f32x4*)(lp + 4 * i); s1 += v[0] + v[2]; s2 += v[1] + v[3]; }
        const float mean = s1 * (1.0f / 512.0f), var = s2 * (1.0f / 512.0f) - mean * mean, r_ = rsqrtf(var + EPS);
        f32x4 g0, g1; unpack8(*(const u32x4*)(Z + (size_t)row * 2048 + 1536 + 8 * lane), g0, g1);
        vn[t][0] = (g0 - mean) * r_ * lg0 + lb0; vn[t][1] = (g1 - mean) * r_ * lg1 + lb1;
        float* op = p->out + O_VS + (size_t)(q * 4 + t) * 512 + 8 * lane;
        *(f32x4*)op = vn[t][0]; *(f32x4*)(op + 4) = vn[t][1];
    }
#pragma unroll
    for (int t = 0; t < 4; ++t) {
        const int row = NP + 4 * q + t;
        const float bs = p->in[20][hb * 128 + t];
        f32x4 m0 = {bs, bs, bs, bs}, m1 = m0;
#pragma unroll
        for (int s = 0; s <= t; ++s) { const float w = p->in[19][(size_t)(hb * 128 + t) * 128 + s]; m0 += w * vn[s][0]; m1 += w * vn[s][1]; }
        f32x4 g0, g1; unpack8(*(const u32x4*)(Z + (size_t)row * 2048 + 1024 + 8 * lane), g0, g1);
        g0 *= m0; g1 *= m1;
        float ss = sq4(g0) + sq4(g1);
        ss += __shfl_xor(ss, 1); ss += __shfl_xor(ss, 2); ss += __shfl_xor(ss, 4); ss += __shfl_xor(ss, 8);
        if ((lane & 15) == 0) ((float*)(ws + OFF_SSQY))[(size_t)row * 16 + 8 + hb] = ss;
        *(u32x4*)((bf16_t*)(ws + OFF_Y) + (size_t)row * 1024 + 512 + 8 * lane) = pack8(g0, g1);
    }
}
__device__ __forceinline__ void p2_phase(KP p, LAS unsigned char* lds, int lo = 0, int hi = 1584, int skip = 0) {
    int cur_hd = -1;
    for (int task = blockIdx.x; task < 1584; task += gridDim.x) {
        if (task < lo || task >= hi) continue;
        if (task < 1056 && (task & 7) != cur_hd) {
            cur_hd = task & 7;
            const bf16_t* Wg = (const bf16_t*)(p->ws + OFF_WG) + cur_hd * 8192;
            __syncthreads();
            for (int i = threadIdx.x; i < 1024; i += 512) { const int n = i >> 3, k8 = i & 7; *(LAS u32x4*)((LAS bf16_t*)(lds + 98304) + n * 72 + k8 * 8) = *(const u32x4*)(Wg + n * 64 + k8 * 8); }
            __syncthreads();
        }
        if (task < 1056) p2_taskA(p, lds, task, skip);
        else if (task < 1568) p2_taskB(p, lds, task - 1056);
        else p2_taskBs(p, (task - 1568) * 8 + (threadIdx.x >> 6));
    }
    if (lo == 0 && hi == 1584) {
        const int nb = (int)gridDim.x > 64 ? (int)gridDim.x - 32 : (int)gridDim.x, b0 = (int)gridDim.x > 64 ? (int)blockIdx.x - 32 : (int)blockIdx.x;
        if (b0 >= 0) for (int ti = b0; ti < 2304; ti += 2 * nb) { const int t1 = ti + nb; const bool two = t1 < 2304; xp_pair(p, p->ws, 768 + ti, 768 + (two ? t1 : ti), two); }
    }
}

__device__ __forceinline__ f32x4 ld_bf4(const bf16_t* q) { const u32x2 w = *(const u32x2*)q; return (f32x4){bflo(w.x), bfhi(w.x), bflo(w.y), bfhi(w.y)}; }
__device__ __forceinline__ void p4b_tile(KP p, int pm) {
    unsigned char* ws = p->ws;
    const bf16_t* halo = (const bf16_t*)(ws + OFF_HALO); bf16_t* ACT = (bf16_t*)(ws + OFF_ACT);
    const float* cw = p->in[25]; const float* cb = p->in[26];
    for (int jj = threadIdx.x; jj < 768; jj += 512) {
        const int j = jj * 4;
        const f32x4 bg = *(const f32x4*)(cb + j), w0g = *(const f32x4*)(cw + j), w1g = *(const f32x4*)(cw + 6144 + j), w2g = *(const f32x4*)(cw + 12288 + j);
        const f32x4 bv = *(const f32x4*)(cb + 3072 + j), w0v = *(const f32x4*)(cw + 3072 + j), w1v = *(const f32x4*)(cw + 6144 + 3072 + j), w2v = *(const f32x4*)(cw + 12288 + 3072 + j);
#pragma unroll
        for (int gl = 0; gl < 4; ++gl) {
            const int g = pm * 4 + gl; const bool first = (g & 31) == 0;
            const f32x4 z4 = {0.f, 0.f, 0.f, 0.f};
            const bf16_t* hb = halo + (size_t)(g * 4) * 6144 + j; const bf16_t* tb = halo + (size_t)((g - 1) * 4 + 2) * 6144 + j;
            const f32x4 h0g = ld_bf4(hb), h1g = ld_bf4(hb + 6144), h0v = ld_bf4(hb + 3072), h1v = ld_bf4(hb + 6144 + 3072);
            const f32x4 t0g = first ? z4 : ld_bf4(tb), t1g = first ? z4 : ld_bf4(tb + 6144), t0v = first ? z4 : ld_bf4(tb + 3072), t1v = first ? z4 : ld_bf4(tb + 6144 + 3072);
            {   const f32x4 og = bg + w0g * t0g + w1g * t1g + w2g * h0g, ov = bv + w0v * t0v + w1v * t1v + w2v * h0v;
                *(u32x2*)(ACT + (size_t)(g * 64) * 3072 + j) = (u32x2){cvt_pk_bf16(gelu_t(og[0]) * ov[0], gelu_t(og[1]) * ov[1]), cvt_pk_bf16(gelu_t(og[2]) * ov[2], gelu_t(og[3]) * ov[3])}; }
            {   const f32x4 og = bg + w0g * t1g + w1g * h0g + w2g * h1g, ov = bv + w0v * t1v + w1v * h0v + w2v * h1v;
                *(u32x2*)(ACT + (size_t)(g * 64 + 1) * 3072 + j) = (u32x2){cvt_pk_bf16(gelu_t(og[0]) * ov[0], gelu_t(og[1]) * ov[1]), cvt_pk_bf16(gelu_t(og[2]) * ov[2], gelu_t(og[3]) * ov[3])}; }
        }
    }
}
__device__ __forceinline__ void p7_phase(KP p, int row_lo) {
    const int lane = threadIdx.x & 63, wave = threadIdx.x >> 6;
    const float* ssq = (const float*)(p->ws + OFF_SSQ3); const bf16_t* H3 = (const bf16_t*)(p->ws + OFF_H3);
    f32x4 gf[4];
#pragma unroll
    for (int i = 0; i < 2; ++i) { gf[2 * i] = *(const f32x4*)(p->in[31] + i * 512 + lane * 8); gf[2 * i + 1] = *(const f32x4*)(p->in[31] + i * 512 + lane * 8 + 4); }
    for (int r = row_lo + blockIdx.x * 8 + wave; r < NT; r += gridDim.x * 8) {
        const float rs = rsqrtf(sum16(ssq + (size_t)r * 16) * (1.0f / 1024.0f) + EPS);
        float* op = p->out + (size_t)r * 1024;
#pragma unroll
        for (int i = 0; i < 2; ++i) { f32x4 a, b; unpack8(*(const u32x4*)(H3 + (size_t)r * 1024 + i * 512 + lane * 8), a, b);
            *(f32x4*)(op + i * 512 + lane * 8) = a * rs * gf[2 * i]; *(f32x4*)(op + i * 512 + lane * 8 + 4) = b * rs * gf[2 * i + 1]; }
    }
}

__device__ __forceinline__ bool st_map(int i, int nct, int& rt, int& ct) {
    const int b = blockIdx.x;
    if (gridDim.x == 256) {
        const int xcd = b & 7, slot = b >> 3, cl = slot >> 3;
        rt = slot & 7;
        if (nct >= 32) { ct = i * 32 + xcd * 4 + cl; return ct < nct; }
        ct = xcd * 2 + cl; return i == 0 && cl < 2;
    }
    const int idx = i * gridDim.x + b; rt = idx & 7; ct = idx >> 3; return ct < nct;
}
#define ST_IDX(nct_) const int r = threadIdx.x >> 3, c = threadIdx.x & 7; (void)r; (void)c; int rt, ct; for (int it_ = 0; st_map(it_, (nct_), rt, ct); ++it_)
__device__ __forceinline__ void p1_small(KP p, LAS unsigned char* lds) {
    unsigned char* ws = p->ws;
    ST_IDX(32) {
        const int arow0 = NP + 64 * rt;
        const TileP T = st_tile((const bf16_t*)(ws + OFF_XB), 1024, arow0, (const bf16_t*)(ws + OFF_WIN), 1024, 64 * ct, 64 * ct + 16, 64 * ct + 32, 64 * ct + 48, 1024);
        Frags<4> F; st_load(F, T, 0);
        const int row = arow0 + r, col = 64 * ct + 8 * c, kind = ct >> 3;
        const float rs = ((const float*)(ws + OFF_RSTD1))[row];
        f32x4 acc[4][4]; st_zero(acc); st_mma(acc, F);
        f32x4 lo0, lo1, hi0, hi1; st_reduce(lds, acc, lo0, lo1, hi0, hi1);
        f32x4 v0 = lo0 + hi0, v1 = lo1 + hi1; float s1 = 0.f, s2 = 0.f;
        seg_z(kind, rs, v0, v1, s1, s2);
        *(u32x4*)((bf16_t*)(ws + OFF_Z) + (size_t)row * 2048 + col) = pack8(v0, v1);
        if (kind == 3) { s1 = red8(s1); s2 = red8(s2); if (c == 0) *(f32x2*)((float*)(ws + OFF_LNSTAT) + (size_t)row * 16 + (ct - 24) * 2) = (f32x2){s1, s2}; }
    }
}
__device__ __forceinline__ void p3_small(KP p, LAS unsigned char* lds) {
    unsigned char* ws = p->ws;
    ST_IDX(16) {
        const int arow0 = NP + 64 * rt;
        const TileP T = st_tile((const bf16_t*)(ws + OFF_Y), 1024, arow0, (const bf16_t*)(ws + OFF_WOUT), 1024, 64 * ct, 64 * ct + 16, 64 * ct + 32, 64 * ct + 48, 1024);
        Frags<4> F; st_load(F, T, 0);
        const int row = arow0 + r; const float* sp = (const float*)(ws + OFF_SSQY) + (size_t)row * 16;
        const f32x4 q0 = *(const f32x4*)sp, q1 = *(const f32x4*)(sp + 4), q2 = *(const f32x4*)(sp + 8);
        const size_t o = (size_t)row * 1024 + 64 * ct + 8 * c;
        const u32x4 xw = *(const u32x4*)((const bf16_t*)(ws + OFF_XB) + o);
        f32x4 acc[4][4]; st_zero(acc); st_mma(acc, F);
        f32x4 lo0, lo1, hi0, hi1; st_reduce(lds, acc, lo0, lo1, hi0, hi1);
        const float ra = rsqrtf((sum4(q0) + sum4(q1)) * (1.0f / 512.0f) + EPS), rb = rsqrtf(sum4(q2) * (1.0f / 512.0f) + EPS);
        f32x4 x0, x1; unpack8(xw, x0, x1);
        const f32x4 h0 = x0 + lo0 * ra + hi0 * rb, h1 = x1 + lo1 * ra + hi1 * rb;
        *(u32x4*)((bf16_t*)(ws + OFF_R3) + o) = pack8(h0, h1);
        const float ss = red8(sq4(h0) + sq4(h1));
        if (c == 0) ((float*)(ws + OFF_SSQ1))[(size_t)row * 16 + ct] = ss;
    }
}
__device__ __forceinline__ void p5_small(KP p, LAS unsigned char* lds, int mode = 0) {
    unsigned char* ws = p->ws;
    int tid_ = threadIdx.x; asm volatile("" : "+v"(tid_));
    const int tid = tid_, wave = tid >> 6, lane = tid & 63, fr = lane & 15, fq = lane >> 4;
    for (int idx = blockIdx.x; idx < 256; idx += gridDim.x) {
        int rt, ct;
        if (gridDim.x == 256) { const int xcd = idx & 7, slot = idx >> 3; rt = slot & 15; ct = xcd * 2 + (slot >> 4); } else { rt = idx & 15; ct = idx >> 4; }
        const int arow0 = NP + 32 * rt;
        const bf16_t* ap = (const bf16_t*)(ws + OFF_ACT) + (size_t)(arow0 + fr) * 3072 + wave * 384 + 8 * fq;
        const bf16_t* bp = (const bf16_t*)(ws + OFF_WDN) + (size_t)(64 * ct + fr) * 3072 + wave * 384 + 8 * fq;
        bf16x8 a0[2][2], b0[2][4], a1[2][2], b1[2][4];
#define P5S_LOAD(A_, B_, s0) do { _Pragma("unroll") for (int s = 0; s < 2; ++s) { _Pragma("unroll") for (int i = 0; i < 2; ++i) A_[s][i] = *(const bf16x8*)(ap + (size_t)(16 * i) * 3072 + ((s0) + s) * 32); \
            _Pragma("unroll") for (int j = 0; j < 4; ++j) B_[s][j] = *(const bf16x8*)(bp + (size_t)(16 * j) * 3072 + ((s0) + s) * 32); } } while (0)
#define P5S_MMA(A_, B_) do { _Pragma("unroll") for (int s = 0; s < 2; ++s) _Pragma("unroll") for (int i = 0; i < 2; ++i) _Pragma("unroll") for (int j = 0; j < 4; ++j) \
            acc[i][j] = __builtin_amdgcn_mfma_f32_16x16x32_bf16(B_[s][j], A_[s][i], acc[i][j], 0, 0, 0); } while (0)
        P5S_LOAD(a0, b0, 0); P5S_LOAD(a1, b1, 2);
        const int r = tid >> 4, c4 = tid & 15, row = arow0 + r;
        bf16_t* hp = (bf16_t*)(ws + OFF_R3) + (size_t)row * 1024 + 64 * ct + 4 * c4;
        const u32x2 xw = *(const u32x2*)hp;
        f32x4 acc[2][4];
#pragma unroll
        for (int i = 0; i < 2; ++i)
#pragma unroll
            for (int j = 0; j < 4; ++j) acc[i][j] = (f32x4){0.f, 0.f, 0.f, 0.f};
#pragma unroll
        for (int s0 = 0; s0 < 12; s0 += 4) { P5S_MMA(a0, b0); if (s0 + 4 < 12) P5S_LOAD(a0, b0, s0 + 4); P5S_MMA(a1, b1); if (s0 + 6 < 12) P5S_LOAD(a1, b1, s0 + 6); }
#undef P5S_LOAD
#undef P5S_MMA
        LAS float* P = (LAS float*)lds + wave * 2048;
#pragma unroll
        for (int i = 0; i < 2; ++i)
#pragma unroll
            for (int j = 0; j < 4; ++j) { const int rr = 16 * i + fr, ch = (4 * j + fq) ^ fr; *(LAS f32x4*)(P + rr * 64 + ch * 4) = acc[i][j]; }
        __syncthreads();
        f32x4 sum = {0.f, 0.f, 0.f, 0.f};
        {   LAS const float* Q = (LAS const float*)lds + r * 64 + ((c4 ^ (r & 15)) * 4);
#pragma unroll
            for (int w = 0; w < 8; ++w) sum += *(LAS const f32x4*)(Q + w * 2048); }
        __syncthreads();
        const f32x4 h = (f32x4){bflo(xw.x), bfhi(xw.x), bflo(xw.y), bfhi(xw.y)} + sum;
        float ss = sq4(h); ss += __shfl_xor(ss, 1); ss += __shfl_xor(ss, 2); ss += __shfl_xor(ss, 4); ss += __shfl_xor(ss, 8);
        if (mode) { asm volatile("" :: "v"(ss), "v"(h[0])); continue; }
        *(u32x2*)hp = (u32x2){cvt_pk_bf16(h[0], h[1]), cvt_pk_bf16(h[2], h[3])};
        if (c4 == 0) ((float*)(ws + OFF_SSQ2))[(size_t)row * 16 + ct] = ss;
    }
}
__device__ __forceinline__ void p6_small(KP p, LAS unsigned char* lds, bool fuse) {
    unsigned char* ws = p->ws;
    ST_IDX(16) {
        const int arow0 = NP + 64 * rt;
        const TileP T = st_tile((const bf16_t*)(ws + OFF_R3), 1024, arow0, (const bf16_t*)(ws + OFF_WPG), 1024, 64 * ct, 64 * ct + 16, 64 * ct + 32, 64 * ct + 48, 1024);
        Frags<4> F; st_load(F, T, 0);
        const int row = arow0 + r; const float* sp = (const float*)(ws + OFF_SSQ2) + (size_t)row * 16;
        const f32x4 q0 = *(const f32x4*)sp, q1 = *(const f32x4*)(sp + 4), q2 = *(const f32x4*)(sp + 8), q3 = *(const f32x4*)(sp + 12);
        const size_t o = (size_t)row * 1024 + 64 * ct + 8 * c;
        const u32x4 ew = *(const u32x4*)((const bf16_t*)(ws + OFF_E) + o), xw = *(const u32x4*)((const bf16_t*)(ws + OFF_R3) + o);
        f32x4 acc[4][4]; st_zero(acc); st_mma(acc, F);
        f32x4 lo0, lo1, hi0, hi1; st_reduce(lds, acc, lo0, lo1, hi0, hi1);
        const float rs = rsqrtf(((sum4(q0) + sum4(q1)) + (sum4(q2) + sum4(q3))) * (1.0f / 1024.0f) + EPS);
        f32x4 e0, e1, x0, x1; unpack8(ew, e0, e1); unpack8(xw, x0, x1);
        f32x4 g0 = (lo0 + hi0) * rs, g1 = (lo1 + hi1) * rs;
#pragma unroll
        for (int e = 0; e < 4; ++e) { g0[e] = sigmoidf_(g0[e]); g1[e] = sigmoidf_(g1[e]); }
        const f32x4 h0 = x0 + e0 * g0, h1 = x1 + e1 * g1;
        const float ss = red8(sq4(h0) + sq4(h1));
        if (!fuse) {
            *(u32x4*)((bf16_t*)(ws + OFF_H3) + o) = pack8(h0, h1);
            if (c == 0) ((float*)(ws + OFF_SSQ3))[(size_t)row * 16 + ct] = ss;
        } else {
            float* X2 = (float*)(ws + OFF_SSQ3) + 65536 + (size_t)rt * 1024;
            unsigned* cnt2 = (unsigned*)(ws + OFF_FLAG) + 1016 + rt;
            if (c == 0) __hip_atomic_store((unsigned*)(X2 + ct * 64 + r), __float_as_uint(ss), __ATOMIC_RELAXED, __HIP_MEMORY_SCOPE_AGENT);
            asm volatile("s_waitcnt vmcnt(0)" ::: "memory");
            __syncthreads();
            if (threadIdx.x == 0) { __hip_atomic_fetch_add(cnt2, 1u, __ATOMIC_RELAXED, __HIP_MEMORY_SCOPE_AGENT); unsigned sp = 0;
                while (__hip_atomic_load(cnt2, __ATOMIC_RELAXED, __HIP_MEMORY_SCOPE_AGENT) < 16u) { __builtin_amdgcn_s_sleep(1); if (++sp > (1u << 22)) break; } }
            __syncthreads();
            float tot = __uint_as_float(__hip_atomic_load((const unsigned*)(X2 + (2 * c) * 64 + r), __ATOMIC_RELAXED, __HIP_MEMORY_SCOPE_AGENT))
                      + __uint_as_float(__hip_atomic_load((const unsigned*)(X2 + (2 * c + 1) * 64 + r), __ATOMIC_RELAXED, __HIP_MEMORY_SCOPE_AGENT));
            tot = red8(tot);
            const float r4 = rsqrtf(tot * (1.0f / 1024.0f) + EPS);
            const int col = 64 * ct + 8 * c;
            float* yp = p->out + O_Y + (size_t)row * 1024 + col;
            *(f32x4*)yp = h0 * r4 * *(const f32x4*)(p->in[31] + col); *(f32x4*)(yp + 4) = h1 * r4 * *(const f32x4*)(p->in[31] + col + 4);
        }
    }
}
__device__ __forceinline__ void p4s_issue(unsigned char* ws, int rt, int s96, Frags<4>& F, int& arow0, int& jc0) {
    const int pn = s96 >> 2, s = s96 & 3, nb = 256 * pn + 32 * s;
    arow0 = NP + 64 * rt; jc0 = 128 * pn + 32 * s;
    const TileP T = st_tile((const bf16_t*)(ws + OFF_R3), 1024, arow0, (const bf16_t*)(ws + OFF_WUP), 1024, nb, nb + 16, nb + 128, nb + 144, 1024);
    st_load(F, T, 0);
}
__device__ __forceinline__ void pe_small(KP p, LAS unsigned char* lds) {
    unsigned char* ws = p->ws;
    ST_IDX(16) {
        const int arow0 = NP + 64 * rt;
        const TileP T = st_tile((const bf16_t*)(ws + OFF_PB), 256, arow0, (const bf16_t*)(ws + OFF_WPLE), 256, 64 * ct, 64 * ct + 16, 64 * ct + 32, 64 * ct + 48, 256);
        Frags<1> F; st_load(F, T, 0);
        f32x4 acc[4][4]; st_zero(acc); st_mma(acc, F);
        f32x4 lo0, lo1, hi0, hi1; st_reduce(lds, acc, lo0, lo1, hi0, hi1);
        *(u32x4*)((bf16_t*)(ws + OFF_E) + (size_t)(arow0 + r) * 1024 + 64 * ct + 8 * c) = pack8(lo0 + hi0, lo1 + hi1);
    }
}
__device__ __forceinline__ void p4_small(KP p, LAS unsigned char* lds, int mode = 0) {
    unsigned char* ws = p->ws; const int r = threadIdx.x >> 3, c = threadIdx.x & 7;
    const float* cw = p->in[25]; const float* cb = p->in[26]; const float* st = p->in[6];
    int it = 0, rt, ct; if (!st_map(0, 96, rt, ct)) return;
    Frags<4> F; int arow0, jc0; p4s_issue(ws, rt, ct, F, arow0, jc0);
    for (;;) {
        const int row = arow0 + r;
        const float rs = rsqrtf(sum16((const float*)(ws + OFF_SSQ1) + (size_t)row * 16) * (1.0f / 1024.0f) + EPS);
        f32x4 acc[4][4]; st_zero(acc); st_mma(acc, F);
        const bool more = st_map(it + 1, 96, rt, ct);
        int narow0 = 0, njc0 = 0; if (more) p4s_issue(ws, rt, ct, F, narow0, njc0);
        f32x4 lo0, lo1, hi0, hi1;
        if (mode == 2) { lo0 = acc[0][0]; lo1 = acc[0][1]; hi0 = acc[1][0]; hi1 = acc[1][1]; } else st_reduce(lds, acc, lo0, lo1, hi0, hi1);
        if (mode == 1) { asm volatile("" :: "v"(lo0[0] + lo1[0] + hi0[0] + hi1[0])); } else {
            LAS float* U = (LAS float*)lds;
            *(LAS f32x4*)(U + r * 68 + 8 * c) = (lo0 + hi0) * rs; *(LAS f32x4*)(U + r * 68 + 8 * c + 4) = (lo1 + hi1) * rs;
            __syncthreads();
            {   const int jc = jc0 + 4 * c, t = r & 3, q = (row - NP) >> 2;
                const f32x4 cg = *(LAS const f32x4*)(U + r * 68 + 4 * c), cv = *(LAS const f32x4*)(U + r * 68 + 32 + 4 * c);
                f32x4 x1g, x1v, x2g, x2v;
                if (t >= 1) { x1g = *(LAS const f32x4*)(U + (r - 1) * 68 + 4 * c); x1v = *(LAS const f32x4*)(U + (r - 1) * 68 + 32 + 4 * c); }
                else { x1g = *(const f32x4*)(st + (size_t)(q * 2 + 1) * 6144 + jc); x1v = *(const f32x4*)(st + (size_t)(q * 2 + 1) * 6144 + 3072 + jc); }
                if (t >= 2) { x2g = *(LAS const f32x4*)(U + (r - 2) * 68 + 4 * c); x2v = *(LAS const f32x4*)(U + (r - 2) * 68 + 32 + 4 * c); }
                else { x2g = *(const f32x4*)(st + (size_t)(q * 2 + t) * 6144 + jc); x2v = *(const f32x4*)(st + (size_t)(q * 2 + t) * 6144 + 3072 + jc); }
                const f32x4 og = *(const f32x4*)(cb + jc) + *(const f32x4*)(cw + jc) * x2g + *(const f32x4*)(cw + 6144 + jc) * x1g + *(const f32x4*)(cw + 12288 + jc) * cg;
                const f32x4 ov = *(const f32x4*)(cb + 3072 + jc) + *(const f32x4*)(cw + 3072 + jc) * x2v + *(const f32x4*)(cw + 6144 + 3072 + jc) * x1v + *(const f32x4*)(cw + 12288 + 3072 + jc) * cv;
                const float a0 = gelu_t(og[0]) * ov[0], a1 = gelu_t(og[1]) * ov[1], a2 = gelu_t(og[2]) * ov[2], a3 = gelu_t(og[3]) * ov[3];
                *(u32x2*)((bf16_t*)(ws + OFF_ACT) + (size_t)row * 3072 + jc) = (u32x2){cvt_pk_bf16(a0, a1), cvt_pk_bf16(a2, a3)};
                if (t >= 2) { float* op = p->out + O_FS + (size_t)(q * 2 + t - 2) * 6144 + jc; *(f32x4*)op = cg; *(f32x4*)(op + 3072) = cv; }
            }
            __syncthreads();
        }
        if (!more) break;
        arow0 = narow0; jc0 = njc0; ++it;
    }
}
#ifndef GP1_ALIGN
#define GP1_ALIGN true
#endif
#ifndef GP1_SP2
#define GP1_SP2 true
#endif
#ifndef GP3_ALIGN
#define GP3_ALIGN false
#endif
#ifndef GP3_SP2
#define GP3_SP2 true
#endif
#ifndef GP4_ALIGN
#define GP4_ALIGN true
#endif
#ifndef GP4_SP2
#define GP4_SP2 true
#endif
#ifndef GP5_ALIGN
#define GP5_ALIGN false
#endif
#ifndef GP5_SP2
#define GP5_SP2 true
#endif
#ifndef GPE_ALIGN
#define GPE_ALIGN false
#endif
#ifndef GPE_SP2
#define GPE_SP2 true
#endif
#ifndef GP6_ALIGN
#define GP6_ALIGN false
#endif
#ifndef GP6_SP2
#define GP6_SP2 true
#endif
#ifndef REP
#define REP 0
#endif
#if REP
__device__ __forceinline__ int rep_count(int bit) { int n = ((REP >> bit) & 1) ? 2 : 1; asm volatile("" : "+s"(n)); return n; }
#define REPEAT(bit) for (int nrep_ = rep_count(bit), rep_ = 0; rep_ < nrep_; ++rep_)
#else
#define REPEAT(bit)
#endif
template <class S> __device__ __forceinline__ void fill_tab_rstd(LAS float* tab, const S& sched, const float* ssq, float invn) {
    Unit u; const int r = threadIdx.x & 255;
    for (int i = threadIdx.x >> 8; sched.next(i, u); i += 2) {
        const float* sp = ssq + (size_t)(u.pm * 256 + r) * 16;
        tab[i * 256 + r] = rsqrtf(sum16(sp) * invn + EPS); }
    __syncthreads();
}

__global__ void __launch_bounds__(512) mega(Params p_) {
    KP p = (KP)__builtin_amdgcn_kernarg_segment_ptr();
#define FRESH_P() asm volatile("" : "+s"(p))
    extern __shared__ __attribute__((aligned(16))) unsigned char lds_raw[];
    LAS unsigned char* lds = (LAS unsigned char*)lds_raw;
    const int tid = threadIdx.x, G = gridDim.x, blk = blockIdx.x;
    volatile LAS unsigned* st = (volatile LAS unsigned*)(lds + LDS_X);
    if (tid < 4) st[tid] = 0u;
    __syncthreads();
    unsigned char* ws = p->ws;
    XcdBarrier bar = xcd_barrier_post((unsigned*)(ws + OFF_BAR), st);
    LAS float* tab = (LAS float*)(lds + LDS_X + 256);
#define GRID_BAR() do { if (p_.use_cg) cg::this_grid().sync(); else xcd_barrier(bar); } while (0)

    REPEAT(0) { p0_phase(p, lds); __syncthreads(); }
    GRID_BAR();
    FRESH_P(); ws = p->ws;
    {   pg8::Gemm g{(const bf16_t*)(ws + OFF_XB), (const bf16_t*)(ws + OFF_WIN), NP, 2048, 1024};
        pg8::StaticOrder S; S.init(NP, 2048, G, blk);
        EpiZ E{(bf16_t*)(ws + OFF_Z), (const float*)(ws + OFF_RSTD1), (float*)(ws + OFF_LNSTAT)};
        pg8::gemm_phase<EpiZ, pg8::StaticOrder, GP1_ALIGN, GP1_SP2>(lds, g, S, E);
        p1_small(p, lds);
    }
    GRID_BAR();
    FRESH_P(); ws = p->ws;
#if REP & 4
    { int lo = (PMODE == 1) ? 0 : 1056, hi = (PMODE == 1) ? 1024 : 1568; int sk = PSKIP; asm volatile("" : "+s"(lo), "+s"(hi), "+s"(sk)); p2_phase(p, lds, lo, hi, sk); __syncthreads(); }
#endif
    p2_phase(p, lds);
    GRID_BAR();
    FRESH_P(); ws = p->ws;
    {   pg8::StaticOrder S; S.init(NP, 1024, G, blk);
        LAS f32x2* tab2 = (LAS f32x2*)tab;
        {   Unit u; const float* sq = (const float*)(ws + OFF_SSQY);
            for (int i = 0; S.next(i, u); ++i)
                if (tid < 256) { const float* sp = sq + (size_t)(u.pm * 256 + tid) * 16;
                    const float sa = sum4(*(const f32x4*)sp) + sum4(*(const f32x4*)(sp + 4)), sb = sum4(*(const f32x4*)(sp + 8));
                    const float ra = rsqrtf(sa * (1.0f / 512.0f) + EPS), rb = rsqrtf(sb * (1.0f / 512.0f) + EPS);
                    tab2[i * 256 + tid] = (f32x2){ra / rb, rb}; }
            __syncthreads(); }
        pg8::Gemm g{(const bf16_t*)(ws + OFF_Y), (const bf16_t*)(ws + OFF_WOUT), NP, 1024, 1024};
        EpiH1 E{(const bf16_t*)(ws + OFF_XB), (bf16_t*)(ws + OFF_R3), (float*)(ws + OFF_SSQ1), tab2};
        REPEAT(3) { pg8::gemm_phase<EpiH1, pg8::StaticOrder, GP3_ALIGN, GP3_SP2>(lds, g, S, E); }
        REPEAT(10) { p3_small(p, lds); }
    }
    GRID_BAR();
    FRESH_P(); ws = p->ws;
    {   pg8::StaticOrder S; S.init(NP, 6144, G, blk);
        fill_tab_rstd(tab, S, (const float*)(ws + OFF_SSQ1), 1.0f / 1024.0f);
        pg8::Gemm g{(const bf16_t*)(ws + OFF_R3), (const bf16_t*)(ws + OFF_WUP), NP, 6144, 1024};
        EpiUp E{(bf16_t*)(ws + OFF_ACT), tab, p->in[25], p->in[26], (bf16_t*)(ws + OFF_HALO), p->out + O_FP, 0};
        pg8::gemm_phase<EpiUp, pg8::StaticOrder, GP4_ALIGN, GP4_SP2>(lds, g, S, E);
#if REP & 4096
        { int md = PMODE; asm volatile("" : "+s"(md)); p4_small(p, lds, md); }
#endif
        p4_small(p, lds);
    }
    GRID_BAR();
    FRESH_P(); ws = p->ws;
    {   pg8::StaticOrder S; S.init(NP, 1024, G, blk);
        {   Unit u; int last = -1;
            for (int i = 0; S.next(i, u); ++i) if (u.pm != last) { p4b_tile(p, u.pm); last = u.pm; }
            asm volatile("s_waitcnt vmcnt(0)" ::: "memory"); __syncthreads(); }
        pg8::Gemm g{(const bf16_t*)(ws + OFF_ACT), (const bf16_t*)(ws + OFF_WDN), NP, 1024, 3072};
        EpiH2 E{(bf16_t*)(ws + OFF_R3), (float*)(ws + OFF_SSQ2)};
        pg8::gemm_phase<EpiH2, pg8::StaticOrder, GP5_ALIGN, GP5_SP2>(lds, g, S, E);
#if REP & 8192
        { int md = 1; asm volatile("" : "+s"(md)); p5_small(p, lds, md); }
#endif
        p5_small(p, lds);
        pg8::Gemm g2{(const bf16_t*)(ws + OFF_PB), (const bf16_t*)(ws + OFF_WPLE), NP, 1024, 256};
        pg8::StaticOrder S2; S2.init(NP, 1024, G, blk);
        EpiE E2{(bf16_t*)(ws + OFF_E)};
        REPEAT(11) { pg8::gemm_phase<EpiE, pg8::StaticOrder, GPE_ALIGN, GPE_SP2>(lds, g2, S2, E2); }
        pe_small(p, lds);
    }
    GRID_BAR();
    FRESH_P(); ws = p->ws;
    {   pg8::StaticOrder S; S.init(NP, 1024, G, blk);
        fill_tab_rstd(tab, S, (const float*)(ws + OFF_SSQ2), 1.0f / 1024.0f);
        pg8::Gemm g{(const bf16_t*)(ws + OFF_R3), (const bf16_t*)(ws + OFF_WPG), NP, 1024, 1024};
        if (G == 256) {
            EpiGF E{(const bf16_t*)(ws + OFF_R3), (const bf16_t*)(ws + OFF_E), p->out + O_Y, p->in[31], (float*)(ws + OFF_SSQ3), (unsigned*)(ws + OFF_FLAG), tab};
            pg8::gemm_phase<EpiGF, pg8::StaticOrder, false, GP6_SP2>(lds, g, S, E);
        } else {
            EpiG E{(const bf16_t*)(ws + OFF_R3), (const bf16_t*)(ws + OFF_E), (bf16_t*)(ws + OFF_H3), (float*)(ws + OFF_SSQ3), tab};
            pg8::gemm_phase<EpiG, pg8::StaticOrder, GP6_ALIGN, GP6_SP2>(lds, g, S, E);
        }
        p6_small(p, lds, G == 256);
    }
    if (G != 256) {
        GRID_BAR();
        FRESH_P(); ws = p->ws;
        p7_phase(p, 0);
    }
}

extern "C" void kernel_launch(void* const* d_in, const int* in_sizes, int n_in, void* d_out, int out_size, void* d_ws, size_t ws_size, hipStream_t stream) {
    static int grid = 0;
    if (grid == 0) {
        if (n_in != 32 || out_size != (int)O_END || ws_size < WS_END) { fprintf(stderr, "kernel_launch: unexpected shapes (n_in %d out %d ws %zu, need ws %zu)\n", n_in, out_size, ws_size, (size_t)WS_END); grid = -1; return; }
        int dev = 0, cus = 0, per_cu = 0;
        if (hipGetDevice(&dev) != hipSuccess || hipDeviceGetAttribute(&cus, hipDeviceAttributeMultiprocessorCount, dev) != hipSuccess) { grid = -1; return; }
        if (hipFuncSetAttribute((const void*)mega, hipFuncAttributeMaxDynamicSharedMemorySize, LDS_BYTES) != hipSuccess) { fprintf(stderr, "kernel_launch: hipFuncSetAttribute failed\n"); grid = -1; return; }
        if (hipOccupancyMaxActiveBlocksPerMultiprocessor(&per_cu, (const void*)mega, 512, LDS_BYTES) != hipSuccess || per_cu < 1) { fprintf(stderr, "kernel_launch: occupancy query says %d\n", per_cu); (void)hipGetLastError(); grid = -1; return; }
        grid = cus;
    }
    if (grid < 0) return;
    (void)hipMemsetAsync(d_ws, 0, CTL_BYTES, stream);
    Params hp{};
    for (int i = 0; i < 32; ++i) hp.in[i] = (const float*)d_in[i];
    hp.out = (float*)d_out; hp.ws = (unsigned char*)d_ws; hp.use_cg = 0; hp.pad = 0;
    void* args[] = {&hp};
    hipError_t e = hipLaunchCooperativeKernel((const void*)mega, dim3(grid), dim3(512), args, LDS_BYTES, stream);
    if (e != hipSuccess) fprintf(stderr, "kernel_launch: cooperative launch failed: %s (grid %d)\n", hipGetErrorString(e), grid);
}
```

```cpp
#ifndef REP
#define REP 0
#endif
#ifndef PSKIP
#define PSKIP 0
#endif
#ifndef PMODE
#define PMODE 0
#endif
#include <hip/hip_runtime.h>
#include <hip/hip_cooperative_groups.h>
#include <cstdio>
namespace cg = cooperative_groups;
#define LAS __attribute__((address_space(3)))
typedef unsigned short bf16_t;
typedef short bf16x8 __attribute__((ext_vector_type(8)));
typedef float f32x4 __attribute__((ext_vector_type(4)));
typedef float f32x2 __attribute__((ext_vector_type(2)));
typedef unsigned u32x4 __attribute__((ext_vector_type(4)));
typedef unsigned u32x2 __attribute__((ext_vector_type(2)));

constexpr int D = 1024, NP = 16384, NS = 512, NT = 16896, SEQ = 2048, NBP = 8, NBS = 128;
constexpr int WA = 512, DFF = 3072, PLE = 256;
constexpr float EPS = 1e-6f;
constexpr size_t O_Y = 0;
constexpr size_t O_HP = 17301504, O_HS = 17305600, O_CP = 17371136, O_CS = 17383424, O_VS = 17580032, O_FP = 17842176, O_FS = 17940480, O_END = 19513344;
constexpr size_t OFF_BAR = 0, OFF_FLAG = 16384, CTL_BYTES = 32768;
constexpr size_t OFF_WIN = 32768;
constexpr size_t OFF_WOUT = OFF_WIN + (size_t)2048 * 1024 * 2;
constexpr size_t OFF_WUP = OFF_WOUT + (size_t)1024 * 1024 * 2;
constexpr size_t OFF_WDN = OFF_WUP + (size_t)6144 * 1024 * 2;
constexpr size_t OFF_WPG = OFF_WDN + (size_t)1024 * 3072 * 2;
constexpr size_t OFF_WPLE = OFF_WPG + (size_t)1024 * 1024 * 2;
constexpr size_t OFF_WG = OFF_WPLE + (size_t)1024 * 256 * 2;
constexpr size_t OFF_WSGU = OFF_WG + (size_t)8 * 128 * 64 * 2;
constexpr size_t OFF_RSTD1 = OFF_WSGU + (size_t)4 * 128 * 128 * 2;
constexpr size_t OFF_SP = OFF_RSTD1 + 98304;
constexpr size_t OFF_LNSTAT = OFF_RSTD1 + 131072;
constexpr size_t STAT_BYTES = (size_t)NT * 16 * 4;
constexpr size_t OFF_SSQY = OFF_LNSTAT + STAT_BYTES;
constexpr size_t OFF_SSQ1 = OFF_SSQY + STAT_BYTES;
constexpr size_t OFF_SSQ2 = OFF_SSQ1 + STAT_BYTES;
constexpr size_t OFF_SSQ3 = OFF_SSQ2 + STAT_BYTES;
constexpr size_t OFF_AGG = OFF_SSQ3 + STAT_BYTES;
constexpr size_t OFF_HALO = OFF_AGG + (size_t)1024 * 128 * 4;
constexpr size_t OFF_PB = OFF_HALO + (size_t)264 * 4 * 6144 * 4;
constexpr size_t OFF_R1 = OFF_PB + (size_t)NT * 256 * 2;
constexpr size_t OFF_XB = OFF_R1, OFF_Z = OFF_R1 + (size_t)NT * 1024 * 2, OFF_ACT = OFF_R1, OFF_H3 = OFF_R1;
constexpr size_t OFF_R3 = OFF_R1 + (size_t)NT * 3072 * 2;
constexpr size_t OFF_E = OFF_R3 + (size_t)NT * 1024 * 2, OFF_Y = OFF_E;
constexpr size_t WS_END = OFF_E + (size_t)NT * 1024 * 2;

constexpr int LDS_BYTES = 155648, LDS_X = 131072;

struct Params {
    const float* in[32];
    float* out;
    unsigned char* ws;
    int use_cg;
    int pad;
};

typedef const __attribute__((address_space(4))) Params* KP;

__device__ __forceinline__ unsigned cvt_pk_bf16(float lo, float hi) { unsigned r; asm volatile("v_cvt_pk_bf16_f32 %0, %1, %2" : "=v"(r) : "v"(lo), "v"(hi)); return r; }
__device__ __forceinline__ float bflo(unsigned w) { return __uint_as_float(w << 16); }
__device__ __forceinline__ float bfhi(unsigned w) { return __uint_as_float(w & 0xffff0000u); }
__device__ __forceinline__ float bf2f(bf16_t v) { return __uint_as_float((unsigned)v << 16); }
__device__ __forceinline__ float sigmoidf_(float x) { return __builtin_amdgcn_rcpf(1.0f + __builtin_amdgcn_exp2f(-1.4426950409f * x)); }
__device__ __forceinline__ float gelu_t(float x) {
    const float u = x * (-2.3022082f - 0.1029432f * x * x);
    return x * __builtin_amdgcn_rcpf(1.0f + __builtin_amdgcn_exp2f(u));
}
__device__ __forceinline__ f32x2 gelu2(f32x2 x) {
    const f32x2 u = x * ((x * x) * (-0.1029432f) + (-2.3022082f));
    f32x2 e; e.x = __builtin_amdgcn_exp2f(u.x); e.y = __builtin_amdgcn_exp2f(u.y);
    const f32x2 d = e + 1.0f;
    f32x2 r; r.x = __builtin_amdgcn_rcpf(d.x); r.y = __builtin_amdgcn_rcpf(d.y);
    return x * r;
}
__device__ __forceinline__ f32x4 gelu4(f32x4 v) { const f32x2 a = gelu2((f32x2){v[0], v[1]}), b = gelu2((f32x2){v[2], v[3]}); return (f32x4){a.x, a.y, b.x, b.y}; }
__device__ __forceinline__ float wave_sum(float v) {
#pragma unroll
    for (int o = 32; o >= 1; o >>= 1) v += __shfl_xor(v, o);
    return v;
}
template <int CTRL> __device__ __forceinline__ float dppf(float v) { return __int_as_float(__builtin_amdgcn_update_dpp(0, __float_as_int(v), CTRL, 0xf, 0xf, false)); }

#define XB_TMO      128
#define XB_XCNT(j)  (256  + 64 * (j))
#define XB_XSUB(j)  (1280 + 64 * (j))
#define XB_XGEN(j)  (2304 + 64 * (j))
#define XB_TOP      3328
#define XB_TOPGEN   3392
#define XCD_BAR_WORDS 3456
#define XB_SPIN_CAP (1u << 20)
__device__ __forceinline__ unsigned xb_ld(unsigned* p)              { return __hip_atomic_load(p, __ATOMIC_RELAXED, __HIP_MEMORY_SCOPE_AGENT); }
__device__ __forceinline__ unsigned xb_add(unsigned* p, unsigned v) { return __hip_atomic_fetch_add(p, v, __ATOMIC_RELAXED, __HIP_MEMORY_SCOPE_AGENT); }
__device__ __forceinline__ unsigned xb_xcc_id() { return (unsigned)__builtin_amdgcn_s_getreg((3 << 11) | 20) & 0xFu; }
#define XB_SPIN(cond, bar) do { unsigned _sp = 0; while (cond) { __builtin_amdgcn_s_sleep(1); \
    if ((++_sp & 255u) == 0u) { if (xb_ld(&(bar)[XB_TMO])) break; if (_sp > XB_SPIN_CAP) { atomicAdd(&(bar)[XB_TMO], 1u); break; } } } } while (0)
struct XcdBarrier { unsigned* bar; unsigned x; volatile LAS unsigned* st; };
__device__ __forceinline__ XcdBarrier xcd_barrier_post(unsigned* bar, volatile LAS unsigned* st) {
    XcdBarrier b; b.bar = bar; b.x = xb_xcc_id(); b.st = st;
    if (threadIdx.x == 0) (void)xb_add(&bar[XB_XCNT(b.x)], 1u);
    return b;
}
__device__ __forceinline__ void xcd_barrier_complete(unsigned* bar, unsigned x, unsigned& nloc, unsigned& nx) {
    const unsigned G = gridDim.x * gridDim.y * gridDim.z;
    unsigned sum, cnt, mine, sp = 0u;
    for (;;) {
        sum = 0u; cnt = 0u; mine = 0u;
#pragma unroll
        for (unsigned j = 0; j < 16; ++j) { const unsigned c = xb_ld(&bar[XB_XCNT(j)]); sum += c; cnt += (c > 0u) ? 1u : 0u; mine = (j == x) ? c : mine; }
        if (sum == G) break;
        __builtin_amdgcn_s_sleep(1);
        if ((++sp & 255u) == 0u) { if (xb_ld(&bar[XB_TMO])) break; if (sp > XB_SPIN_CAP) { atomicAdd(&bar[XB_TMO], 1u); break; } }
    }
    nloc = mine > 0u ? mine : 1u; nx = cnt > 0u ? cnt : 1u;
}
__device__ __forceinline__ void xcd_barrier(const XcdBarrier& b) {
    asm volatile("s_waitcnt vmcnt(0)" ::: "memory");
    __syncthreads();
    if (threadIdx.x == 0) {
        unsigned* bar = b.bar;
        __builtin_amdgcn_s_waitcnt(0);
        unsigned nloc = b.st[0], nx = b.st[1];
        if (nloc == 0u) { xcd_barrier_complete(bar, b.x, nloc, nx); b.st[0] = nloc; b.st[1] = nx; }
        const unsigned old = xb_add(&bar[XB_XSUB(b.x)], 1u);
        const unsigned gen = old / nloc;
        if (old + 1u == (gen + 1u) * nloc) {
            __builtin_amdgcn_fence(__ATOMIC_RELEASE, "agent");
            asm volatile("s_waitcnt vmcnt(0)" ::: "memory");
            const unsigned og = xb_add(&bar[XB_TOP], 1u);
            const unsigned tg = og / nx;
            if (og + 1u == (tg + 1u) * nx) xb_add(&bar[XB_TOPGEN], 1u);
            else XB_SPIN(xb_ld(&bar[XB_TOPGEN]) == tg, bar);
            __builtin_amdgcn_fence(__ATOMIC_ACQUIRE, "agent");
            xb_add(&bar[XB_XGEN(b.x)], 1u);
            asm volatile("s_waitcnt vmcnt(0)" ::: "memory");
        } else {
            XB_SPIN(xb_ld(&bar[XB_XGEN(b.x)]) == gen, bar);
            __builtin_amdgcn_fence(__ATOMIC_ACQUIRE, "agent");
            asm volatile("s_waitcnt vmcnt(0)" ::: "memory");
        }
    }
    __syncthreads();
}
namespace pg8 {
constexpr int BM = 256, BK = 64, HALF = 128, HTB = HALF * BK * 2, STAGE_BYTES = 8 * HTB, NXCD = 8, WGM = 8;
__device__ __forceinline__ int lds_byte(int r, int c) { const int st = (r >> 4) * 2 + (c >> 5), rr = r & 15, cc = c & 31, ob = rr * 64 + cc * 2; return st * 1024 + (ob ^ (((ob >> 9) & 1) << 5)); }
__device__ __forceinline__ void stage_rc(int b, int& R, int& C) { const int st = b / 1024, sb = b % 1024, swz = sb ^ (((sb >> 9) & 1) << 5); R = (st >> 1) * 16 + swz / 64; C = (st & 1) * 32 + (swz % 64) / 2; }
__device__ __forceinline__ int perm32(int rho) { const int n = rho >> 4, i = rho & 15; return 8 * (i >> 2) + 4 * n + (i & 3); }
struct Unit { int pm, pn; };
struct Gemm { const bf16_t* A; const bf16_t* Bt; int M, N, K; };
struct StaticOrder {
    int nM, nN, nwg, G, c;
    __device__ void init(int M, int N, int G_, int c_) { nM = M / BM; nN = N / BM; nwg = nM * nN; G = G_; c = c_; }
    __device__ bool next(int i, Unit& u) const {
        const long L = (long)i * G + c; if (L >= nwg) return false;
        int wgid = (int)L; { const int q = nwg / NXCD, r = nwg % NXCD, xcd = wgid % NXCD, off = wgid / NXCD; wgid = (xcd < r ? xcd * (q + 1) : r * (q + 1) + (xcd - r) * q) + off; }
        const int nig = WGM * nN, gid = wgid / nig, fm = gid * WGM, gsz = (nM - fm) < WGM ? (nM - fm) : WGM;
        u.pm = fm + ((wgid % nig) % gsz); u.pn = (wgid % nig) / gsz; return true;
    }
};

template <class Epi, class Sched, bool ALIGN_EPI = false, bool SP2 = false>
__device__ __forceinline__ void gemm_phase(LAS unsigned char* lds, const Gemm g, const Sched& S, const Epi& E) {
    int tid_ = threadIdx.x; asm volatile("" : "+v"(tid_));
    const int tid = tid_, wid = __builtin_amdgcn_readfirstlane(tid >> 6), lane = tid & 63, wr = wid >> 2, wc = wid & 3, fr = lane & 15, fq = lane >> 4;
    const int K = g.K, nt = K / BK;
    unsigned voffA[2], voffB[2];
#pragma unroll
    for (int i = 0; i < 2; ++i) { int R, C; stage_rc(tid * 16 + i * 8192, R, C); const int Rb = Epi::PERM ? ((R & ~31) + perm32(R & 31)) : R;
        const int Ra = Epi::APERM ? ((R & 64) + 4 * (R & 15) + ((R >> 4) & 3)) : R;
        voffA[i] = (unsigned)(Ra * K + C) * 2u; voffB[i] = (unsigned)(Rb * K + C) * 2u; }
    const size_t kstep = (size_t)(BK * 2);
    const size_t hstep = (size_t)HALF * K * 2;
    const size_t tstep = 2 * hstep;
    const unsigned ldsw = (unsigned)wid * 1024u;
    const int aoff = lds_byte(wr * 64 + fr, fq * 8), boff = lds_byte(wc * 32 + fr, fq * 8);
#define PG8_SA(b, h) (((b) * 2 + (h)) * HTB)
#define PG8_SB(b, h) ((4 + (b) * 2 + (h)) * HTB)
#define PG8_STAGE(bufoff, gbase, voff) do { _Pragma("unroll") for (int _i = 0; _i < 2; ++_i) \
        __builtin_amdgcn_global_load_lds((const unsigned*)((const char*)(gbase) + (voff)[_i]), (LAS unsigned*)(lds + (bufoff) + ldsw + _i * 8192), 16, 0, 0); } while (0)
#define PG8_LDA(dst, b, h) do { _Pragma("unroll") for (int m = 0; m < 4; ++m) _Pragma("unroll") for (int k = 0; k < 2; ++k) dst[m][k] = *(const LAS bf16x8*)(lds + PG8_SA(b, h) + aoff + m * 2048 + k * 1024); } while (0)
#define PG8_LDB(dst, b, h) do { _Pragma("unroll") for (int n = 0; n < 2; ++n) _Pragma("unroll") for (int k = 0; k < 2; ++k) dst[n][k] = *(const LAS bf16x8*)(lds + PG8_SB(b, h) + boff + n * 2048 + k * 1024); } while (0)
#define PG8_MMA(ai, bj, At, Bt) do { __builtin_amdgcn_s_setprio(1); _Pragma("unroll") for (int m = 0; m < 4; ++m) _Pragma("unroll") for (int n = 0; n < 2; ++n) _Pragma("unroll") for (int k = 0; k < 2; ++k) \
        acc[ai][bj][m][n] = __builtin_amdgcn_mfma_f32_16x16x32_bf16(Bt[n][k], At[m][k], acc[ai][bj][m][n], 0, 0, 0); __builtin_amdgcn_s_setprio(0); } while (0)
#define PG8_WAIT_V(n) asm volatile("s_waitcnt vmcnt(" #n ")" ::: "memory")
#define PG8_WAIT_L(n) asm volatile("s_waitcnt lgkmcnt(" #n ")" ::: "memory")
#define PG8_BAR __builtin_amdgcn_s_barrier()
#define PG8_SCHED __builtin_amdgcn_sched_barrier(0)
    Unit cur, nxt; int ui = 0;
    if (!S.next(0, cur)) return;
    f32x4 acc[2][2][4][2];
#pragma unroll
    for (int a = 0; a < 2; ++a)
#pragma unroll
        for (int b = 0; b < 2; ++b)
#pragma unroll
            for (int m = 0; m < 4; ++m)
#pragma unroll
                for (int n = 0; n < 2; ++n) acc[a][b][m][n] = (f32x4){0.f, 0.f, 0.f, 0.f};
    bf16x8 At[4][2], B0[2][2], B1[2][2];
    const char* cA = (const char*)g.A + (size_t)cur.pm * tstep; const char* cB = (const char*)g.Bt + (size_t)cur.pn * tstep;
    if constexpr (SP2) {
        PG8_STAGE(PG8_SB(0, 0), cB, voffB); PG8_STAGE(PG8_SB(0, 1), cB + hstep, voffB); PG8_STAGE(PG8_SA(0, 0), cA, voffA); PG8_STAGE(PG8_SA(0, 1), cA + hstep, voffA);
        if (wr == 1) PG8_BAR;
        PG8_WAIT_V(2); PG8_BAR;
        PG8_STAGE(PG8_SB(1, 0), cB + kstep, voffB); PG8_STAGE(PG8_SA(1, 0), cA + kstep, voffA); PG8_STAGE(PG8_SB(1, 1), cB + hstep + kstep, voffB);
        PG8_WAIT_V(6); PG8_BAR;
    } else {
        PG8_STAGE(PG8_SB(0, 0), cB, voffB); PG8_STAGE(PG8_SA(0, 0), cA, voffA); PG8_STAGE(PG8_SB(0, 1), cB + hstep, voffB); PG8_STAGE(PG8_SA(0, 1), cA + hstep, voffA);
        if (wr == 1) PG8_BAR;
        PG8_WAIT_V(4); PG8_BAR;
        PG8_STAGE(PG8_SB(1, 0), cB + kstep, voffB); PG8_STAGE(PG8_SA(1, 0), cA + kstep, voffA); PG8_STAGE(PG8_SB(1, 1), cB + hstep + kstep, voffB);
        PG8_WAIT_V(6); PG8_BAR;
    }
    for (;;) {
        const bool has_next = S.next(ui + 1, nxt);
        const char* nA = has_next ? (const char*)g.A + (size_t)nxt.pm * tstep : cA; const char* nB = has_next ? (const char*)g.Bt + (size_t)nxt.pn * tstep : cB;
        for (int t = 0; t < nt; t += 2) {
            const bool last = (t == nt - 2);
            const char* a1 = cA + (size_t)(t + 1) * kstep;
            const char* a2 = last ? nA : cA + (size_t)(t + 2) * kstep; const char* b2 = last ? nB : cB + (size_t)(t + 2) * kstep;
            const char* a3 = a2 + kstep; const char* b3 = b2 + kstep;
            if constexpr (Epi::HAS_MID) { if (t == (nt >> 1)) E.mid(acc, cur, ui, wr, fr); }
            if constexpr (SP2) {
            PG8_LDB(B0, 0, 0); PG8_LDB(B1, 0, 1); PG8_SCHED; PG8_LDA(At, 0, 0); PG8_STAGE(PG8_SA(1, 1), a1 + hstep, voffA);
            PG8_WAIT_V(8); PG8_WAIT_L(0); PG8_BAR; PG8_MMA(0, 0, At, B0); PG8_MMA(0, 1, At, B1); PG8_BAR; PG8_SCHED;
            PG8_LDA(At, 0, 1); PG8_STAGE(PG8_SB(0, 0), b2, voffB); PG8_STAGE(PG8_SB(0, 1), b2 + hstep, voffB); PG8_STAGE(PG8_SA(0, 0), a2, voffA);
            PG8_WAIT_V(8); PG8_WAIT_L(0); PG8_BAR; PG8_MMA(1, 0, At, B0); PG8_MMA(1, 1, At, B1); PG8_BAR; PG8_SCHED;
            PG8_LDB(B0, 1, 0); PG8_LDB(B1, 1, 1); PG8_SCHED; PG8_LDA(At, 1, 0); PG8_STAGE(PG8_SA(0, 1), a2 + hstep, voffA);
            PG8_WAIT_V(8); PG8_WAIT_L(0); PG8_BAR; PG8_MMA(0, 0, At, B0); PG8_MMA(0, 1, At, B1); PG8_BAR; PG8_SCHED;
            PG8_LDA(At, 1, 1); PG8_STAGE(PG8_SB(1, 0), b3, voffB); PG8_STAGE(PG8_SB(1, 1), b3 + hstep, voffB); PG8_STAGE(PG8_SA(1, 0), a3, voffA);
            PG8_WAIT_V(8); PG8_WAIT_L(0); PG8_BAR; PG8_MMA(1, 0, At, B0); PG8_MMA(1, 1, At, B1); PG8_BAR; PG8_SCHED;
            } else {
            PG8_LDB(B0, 0, 0); PG8_SCHED; PG8_LDA(At, 0, 0); PG8_STAGE(PG8_SA(1, 1), a1 + hstep, voffA);
            PG8_WAIT_L(8); PG8_BAR; PG8_WAIT_L(0); PG8_MMA(0, 0, At, B0); PG8_BAR; PG8_SCHED;
            PG8_LDB(B1, 0, 1); PG8_STAGE(PG8_SB(0, 0), b2, voffB);
            PG8_BAR; PG8_WAIT_L(0); PG8_MMA(0, 1, At, B1); PG8_BAR;
            PG8_LDA(At, 0, 1); PG8_STAGE(PG8_SA(0, 0), a2, voffA);
            PG8_BAR; PG8_WAIT_L(0); PG8_MMA(1, 0, At, B0); PG8_BAR; PG8_SCHED;
            PG8_STAGE(PG8_SB(0, 1), b2 + hstep, voffB);
            PG8_WAIT_V(6); PG8_BAR; PG8_MMA(1, 1, At, B1); PG8_BAR;
            PG8_LDB(B0, 1, 0); PG8_SCHED; PG8_LDA(At, 1, 0); PG8_STAGE(PG8_SA(0, 1), a2 + hstep, voffA);
            PG8_WAIT_L(8); PG8_BAR; PG8_WAIT_L(0); PG8_MMA(0, 0, At, B0); PG8_BAR; PG8_SCHED;
            PG8_LDB(B1, 1, 1); PG8_STAGE(PG8_SB(1, 0), b3, voffB);
            PG8_BAR; PG8_WAIT_L(0); PG8_MMA(0, 1, At, B1); PG8_BAR;
            PG8_LDA(At, 1, 1); PG8_STAGE(PG8_SA(1, 0), a3, voffA);
            PG8_BAR; PG8_WAIT_L(0); PG8_MMA(1, 0, At, B0); PG8_BAR; PG8_SCHED;
            PG8_STAGE(PG8_SB(1, 1), b3 + hstep, voffB);
            PG8_WAIT_V(6); PG8_BAR; PG8_MMA(1, 1, At, B1); PG8_BAR;
            }
        }
        if constexpr (ALIGN_EPI) { if (wr == 0) PG8_BAR; }
        if constexpr (!Epi::AFTER_DRAIN) E(acc, cur, ui, wr, wc, fr, fq);
        if (!has_next) break;
#pragma unroll
        for (int a = 0; a < 2; ++a)
#pragma unroll
            for (int b = 0; b < 2; ++b)
#pragma unroll
                for (int m = 0; m < 4; ++m)
#pragma unroll
                    for (int n = 0; n < 2; ++n) acc[a][b][m][n] = (f32x4){0.f, 0.f, 0.f, 0.f};
        cur = nxt; cA = nA; cB = nB; ++ui;
        if constexpr (ALIGN_EPI) { if (wr == 1) PG8_BAR; }
    }
    PG8_WAIT_V(0);
    if constexpr (!ALIGN_EPI) { if (wr == 0) PG8_BAR; }
    PG8_BAR;
    if constexpr (Epi::AFTER_DRAIN) E.fused(acc, cur, ui, wr, wc, fr, fq, lds);
#undef PG8_SA
#undef PG8_SB
#undef PG8_STAGE
#undef PG8_LDA
#undef PG8_LDB
#undef PG8_MMA
#undef PG8_WAIT_V
#undef PG8_WAIT_L
#undef PG8_BAR
#undef PG8_SCHED
}
}
using pg8::Unit;
typedef f32x4 Acc[2][2][4][2];

__device__ __forceinline__ u32x4 pack8(f32x4 a, f32x4 b) { u32x4 w; w.x = cvt_pk_bf16(a[0], a[1]); w.y = cvt_pk_bf16(a[2], a[3]); w.z = cvt_pk_bf16(b[0], b[1]); w.w = cvt_pk_bf16(b[2], b[3]); return w; }
__device__ __forceinline__ void unpack8(u32x4 w, f32x4& a, f32x4& b) { a = (f32x4){bflo(w.x), bfhi(w.x), bflo(w.y), bfhi(w.y)}; b = (f32x4){bflo(w.z), bfhi(w.z), bflo(w.w), bfhi(w.w)}; }
__device__ __forceinline__ float red_fq(float v) { v += __shfl_xor(v, 16); v += __shfl_xor(v, 32); return v; }
__device__ __forceinline__ float red8(float v) { v += __shfl_xor(v, 1); v += __shfl_xor(v, 2); v += __shfl_xor(v, 4); return v; }
__device__ __forceinline__ float sq4(f32x4 a) { return a[0] * a[0] + a[1] * a[1] + a[2] * a[2] + a[3] * a[3]; }
__device__ __forceinline__ float sum4(f32x4 a) { return (a[0] + a[1]) + (a[2] + a[3]); }
__device__ __forceinline__ float sum16(const float* sp) { return (sum4(*(const f32x4*)sp) + sum4(*(const f32x4*)(sp + 4))) + (sum4(*(const f32x4*)(sp + 8)) + sum4(*(const f32x4*)(sp + 12))); }

__device__ __forceinline__ void seg_z(int kind, float rs, f32x4& v0, f32x4& v1, float& s1, float& s2) {
    v0 *= rs; v1 *= rs;
    if (kind != 0) { v0 = gelu4(v0); v1 = gelu4(v1); }
    if (kind == 3) { s1 += sum4(v0) + sum4(v1); s2 += sq4(v0) + sq4(v1); }
}
struct EpiZ {
    static constexpr bool PERM = true, HAS_MID = false, AFTER_DRAIN = false, APERM = false;
    bf16_t* Z; const float* rstd1; float* lnstat;
    __device__ __forceinline__ void operator()(const Acc& acc, const Unit& u, int ui, int wr, int wc, int fr, int fq) const {
        const int row0 = u.pm * 256 + wr * 64 + fr, col0 = u.pn * 256 + wc * 32 + 8 * fq, kind = u.pn >> 1;
#pragma unroll
        for (int ai = 0; ai < 2; ++ai)
#pragma unroll
            for (int m = 0; m < 4; ++m) {
                const int row = row0 + ai * 128 + m * 16; const float rs = rstd1[row];
                float s1 = 0.f, s2 = 0.f;
#pragma unroll
                for (int bj = 0; bj < 2; ++bj) {
                    f32x4 v0 = acc[ai][bj][m][0], v1 = acc[ai][bj][m][1];
                    seg_z(kind, rs, v0, v1, s1, s2);
                    *(u32x4*)(Z + (size_t)row * 2048 + col0 + bj * 128) = pack8(v0, v1);
                }
                if (kind == 3) { s1 = red_fq(s1); s2 = red_fq(s2);
                    if (fq == 0) *(f32x2*)(lnstat + (size_t)row * 16 + (((u.pn - 6) * 4 + wc) * 2)) = (f32x2){s1, s2}; }
            }
    }
};
struct EpiE {
    static constexpr bool PERM = true, HAS_MID = false, AFTER_DRAIN = false, APERM = false;
    bf16_t* O;
    __device__ __forceinline__ void operator()(const Acc& acc, const Unit& u, int ui, int wr, int wc, int fr, int fq) const {
        const int row0 = u.pm * 256 + wr * 64 + fr, col0 = u.pn * 256 + wc * 32 + 8 * fq;
#pragma unroll
        for (int ai = 0; ai < 2; ++ai)
#pragma unroll
            for (int m = 0; m < 4; ++m)
#pragma unroll
                for (int bj = 0; bj < 2; ++bj)
                    *(u32x4*)(O + (size_t)(row0 + ai * 128 + m * 16) * 1024 + col0 + bj * 128) = pack8(acc[ai][bj][m][0], acc[ai][bj][m][1]);
    }
};
struct EpiH1 {
    static constexpr bool PERM = true, HAS_MID = true, AFTER_DRAIN = false, APERM = false;
    const bf16_t* Xb; bf16_t* Hb; float* ssq; const LAS f32x2* tab;
    __device__ __forceinline__ void mid(Acc& acc, const Unit& u, int ui, int wr, int fr) const {
#pragma unroll
        for (int ai = 0; ai < 2; ++ai)
#pragma unroll
            for (int m = 0; m < 4; ++m) { const float r = tab[ui * 256 + ai * 128 + wr * 64 + m * 16 + fr].x;
#pragma unroll
                for (int bj = 0; bj < 2; ++bj)
#pragma unroll
                    for (int n = 0; n < 2; ++n) acc[ai][bj][m][n] *= r; }
    }
    __device__ __forceinline__ void operator()(const Acc& acc, const Unit& u, int ui, int wr, int wc, int fr, int fq) const {
        const int rt0 = wr * 64 + fr, col0 = u.pn * 256 + wc * 32 + 8 * fq;
#pragma unroll
        for (int ai = 0; ai < 2; ++ai)
#pragma unroll
            for (int m = 0; m < 4; ++m) {
                const int rt = rt0 + ai * 128 + m * 16, row = u.pm * 256 + rt; const float rs = tab[ui * 256 + rt].y;
                float ss = 0.f;
#pragma unroll
                for (int bj = 0; bj < 2; ++bj) { const size_t o = (size_t)row * 1024 + col0 + bj * 128;
                    f32x4 x0, x1; unpack8(*(const u32x4*)(Xb + o), x0, x1);
                    const f32x4 h0 = x0 + acc[ai][bj][m][0] * rs, h1 = x1 + acc[ai][bj][m][1] * rs;
                    ss += sq4(h0) + sq4(h1);
                    *(u32x4*)(Hb + o) = pack8(h0, h1); }
                ss = red_fq(ss);
                if (fq == 0) ssq[(size_t)row * 16 + u.pn * 4 + wc] = ss;
            }
    }
};
struct EpiH2 {
    static constexpr bool PERM = true, HAS_MID = false, AFTER_DRAIN = false, APERM = false;
    bf16_t* Hb; float* ssq;
    __device__ __forceinline__ void operator()(const Acc& acc, const Unit& u, int ui, int wr, int wc, int fr, int fq) const {
        const int row0 = u.pm * 256 + wr * 64 + fr, col0 = u.pn * 256 + wc * 32 + 8 * fq;
#pragma unroll
        for (int ai = 0; ai < 2; ++ai)
#pragma unroll
            for (int m = 0; m < 4; ++m) {
                const int row = row0 + ai * 128 + m * 16; float ss = 0.f;
#pragma unroll
                for (int bj = 0; bj < 2; ++bj) { bf16_t* hp = Hb + (size_t)row * 1024 + col0 + bj * 128;
                    f32x4 x0, x1; unpack8(*(const u32x4*)hp, x0, x1);
                    const f32x4 h0 = x0 + acc[ai][bj][m][0], h1 = x1 + acc[ai][bj][m][1];
                    ss += sq4(h0) + sq4(h1);
                    *(u32x4*)hp = pack8(h0, h1); }
                ss = red_fq(ss);
                if (fq == 0) ssq[(size_t)row * 16 + u.pn * 4 + wc] = ss;
            }
    }
};
struct EpiG {
    static constexpr bool PERM = true, HAS_MID = false, AFTER_DRAIN = false, APERM = false;
    const bf16_t* Hb; const bf16_t* E; bf16_t* H3; float* ssq; const LAS float* tab;
    __device__ __forceinline__ void operator()(const Acc& acc, const Unit& u, int ui, int wr, int wc, int fr, int fq) const {
        const int rt0 = wr * 64 + fr, col0 = u.pn * 256 + wc * 32 + 8 * fq;
#pragma unroll
        for (int ai = 0; ai < 2; ++ai)
#pragma unroll
            for (int m = 0; m < 4; ++m) {
                const int rt = rt0 + ai * 128 + m * 16, row = u.pm * 256 + rt; const float rs = tab[ui * 256 + rt]; float ss = 0.f;
#pragma unroll
                for (int bj = 0; bj < 2; ++bj) { const size_t o = (size_t)row * 1024 + col0 + bj * 128;
                    f32x4 e0, e1, x0, x1; unpack8(*(const u32x4*)(E + o), e0, e1); unpack8(*(const u32x4*)(Hb + o), x0, x1);
                    f32x4 g0 = acc[ai][bj][m][0] * rs, g1 = acc[ai][bj][m][1] * rs;
#pragma unroll
                    for (int e = 0; e < 4; ++e) { g0[e] = sigmoidf_(g0[e]); g1[e] = sigmoidf_(g1[e]); }
                    const f32x4 h0 = x0 + e0 * g0, h1 = x1 + e1 * g1;
                    ss += sq4(h0) + sq4(h1);
                    *(u32x4*)(H3 + o) = pack8(h0, h1); }
                ss = red_fq(ss);
                if (fq == 0) ssq[(size_t)row * 16 + u.pn * 4 + wc] = ss;
            }
    }
};
struct EpiGF {
    static constexpr bool PERM = true, HAS_MID = false, AFTER_DRAIN = true, APERM = false;
    const bf16_t* Hb; const bf16_t* E; float* Y; const float* gfin; float* X; unsigned* cnt; const LAS float* tab;
    __device__ __forceinline__ void operator()(const Acc& acc, const Unit& u, int ui, int wr, int wc, int fr, int fq) const {}
    __device__ __forceinline__ void fused(Acc& acc, const Unit& u, int ui, int wr, int wc, int fr, int fq, LAS unsigned char* lds) const {
        const int rt0 = wr * 64 + fr, col0 = u.pn * 256 + wc * 32 + 8 * fq, tid = threadIdx.x;
        LAS float* Pw = (LAS float*)lds;
        LAS float* Rs = (LAS float*)lds + 1024;
#pragma unroll
        for (int ai = 0; ai < 2; ++ai)
#pragma unroll
            for (int m = 0; m < 4; ++m) {
                const int rt = rt0 + ai * 128 + m * 16, row = u.pm * 256 + rt; const float rs = tab[ui * 256 + rt]; float ss = 0.f;
#pragma unroll
                for (int bj = 0; bj < 2; ++bj) { const size_t o = (size_t)row * 1024 + col0 + bj * 128;
                    f32x4 e0, e1, x0, x1; unpack8(*(const u32x4*)(E + o), e0, e1); unpack8(*(const u32x4*)(Hb + o), x0, x1);
                    f32x4 g0 = acc[ai][bj][m][0] * rs, g1 = acc[ai][bj][m][1] * rs;
#pragma unroll
                    for (int e = 0; e < 4; ++e) { g0[e] = sigmoidf_(g0[e]); g1[e] = sigmoidf_(g1[e]); }
                    const f32x4 h0 = x0 + e0 * g0, h1 = x1 + e1 * g1;
                    ss += sq4(h0) + sq4(h1);
                    acc[ai][bj][m][0] = h0; acc[ai][bj][m][1] = h1; }
                ss = red_fq(ss);
                if (fq == 0) Pw[rt * 4 + wc] = ss;
            }
        __syncthreads();
        if (tid < 256) { const f32x4 q = *(const LAS f32x4*)(Pw + tid * 4);
            __hip_atomic_store((unsigned*)(X + ((size_t)u.pm * 4 + u.pn) * 256 + tid), __float_as_uint(sum4(q)), __ATOMIC_RELAXED, __HIP_MEMORY_SCOPE_AGENT); }
        asm volatile("s_waitcnt vmcnt(0)" ::: "memory");
        __syncthreads();
        if (tid == 0) { __hip_atomic_fetch_add(cnt + u.pm * 16, 1u, __ATOMIC_RELAXED, __HIP_MEMORY_SCOPE_AGENT); unsigned sp = 0;
            while (__hip_atomic_load(cnt + u.pm * 16, __ATOMIC_RELAXED, __HIP_MEMORY_SCOPE_AGENT) < 4u) { __builtin_amdgcn_s_sleep(1); if (++sp > (1u << 22)) break; } }
        __syncthreads();
        if (tid < 256) { float s = 0.f;
#pragma unroll
            for (int k = 0; k < 4; ++k) s += __uint_as_float(__hip_atomic_load((const unsigned*)(X + ((size_t)u.pm * 4 + k) * 256 + tid), __ATOMIC_RELAXED, __HIP_MEMORY_SCOPE_AGENT));
            Rs[tid] = rsqrtf(s * (1.0f / 1024.0f) + EPS); }
        __syncthreads();
        f32x4 gv[2][2];
#pragma unroll
        for (int bj = 0; bj < 2; ++bj) { gv[bj][0] = *(const f32x4*)(gfin + col0 + bj * 128); gv[bj][1] = *(const f32x4*)(gfin + col0 + bj * 128 + 4); }
#pragma unroll
        for (int ai = 0; ai < 2; ++ai)
#pragma unroll
            for (int m = 0; m < 4; ++m) {
                const int rt = rt0 + ai * 128 + m * 16, row = u.pm * 256 + rt; const float rs = Rs[rt];
#pragma unroll
                for (int bj = 0; bj < 2; ++bj) { float* yp = Y + (size_t)row * 1024 + col0 + bj * 128;
                    *(f32x4*)yp = acc[ai][bj][m][0] * rs * gv[bj][0]; *(f32x4*)(yp + 4) = acc[ai][bj][m][1] * rs * gv[bj][1]; }
            }
        __syncthreads();
    }
};
template <int C> __device__ __forceinline__ f32x4 dpp4(f32x4 v) { return (f32x4){dppf<C>(v[0]), dppf<C>(v[1]), dppf<C>(v[2]), dppf<C>(v[3])}; }
__device__ __forceinline__ f32x4 sel4(bool c, f32x4 a, f32x4 b) { return c ? a : b; }
template <int C> __device__ __forceinline__ float dppo(float old, float v) { return __int_as_float(__builtin_amdgcn_update_dpp(__float_as_int(old), __float_as_int(v), C, 0xf, 0xf, false)); }
template <int C> __device__ __forceinline__ f32x4 dppo4(f32x4 o, f32x4 v) { return (f32x4){dppo<C>(o[0], v[0]), dppo<C>(o[1], v[1]), dppo<C>(o[2], v[2]), dppo<C>(o[3], v[3])}; }
template <int C> __device__ __forceinline__ float dppz(float v) { return __int_as_float(__builtin_amdgcn_update_dpp(0, __float_as_int(v), C, 0xf, 0xf, true)); }
template <int C> __device__ __forceinline__ f32x4 dppz4(f32x4 v) { return (f32x4){dppz<C>(v[0]), dppz<C>(v[1]), dppz<C>(v[2]), dppz<C>(v[3])}; }
struct EpiUp {
    static constexpr bool PERM = true, HAS_MID = false, AFTER_DRAIN = false, APERM = true;
    bf16_t* ACT; const LAS float* tab; const float* cw; const float* cb; bf16_t* halo; float* ofp; int mode;
    __device__ __forceinline__ void operator()(const Acc& acc, const Unit& u, int ui, int wr, int wc, int fr, int fq) const {
        const int jc0 = u.pn * 128 + wc * 32 + 8 * fq;
        u32x2 held[2][4];
#pragma unroll
        for (int n = 0; n < 2; ++n) {
            const int jc = jc0 + 4 * n;
            const f32x4 w0g = *(const f32x4*)(cw + jc), w1g = *(const f32x4*)(cw + 6144 + jc), w2g = *(const f32x4*)(cw + 12288 + jc), bg = *(const f32x4*)(cb + jc);
            const f32x4 w0v = *(const f32x4*)(cw + 3072 + jc), w1v = *(const f32x4*)(cw + 6144 + 3072 + jc), w2v = *(const f32x4*)(cw + 12288 + 3072 + jc), bv = *(const f32x4*)(cb + 3072 + jc);
#pragma unroll
            for (int ai = 0; ai < 2; ++ai) {
                const int rt0 = ai * 128 + wr * 64 + 4 * fr, row0 = u.pm * 256 + rt0, g = row0 >> 6;
                const f32x4 rs = *(const LAS f32x4*)(tab + ui * 256 + rt0);
                f32x4 cg[4], cv[4];
#pragma unroll
                for (int m = 0; m < 4; ++m) { cg[m] = acc[ai][0][m][n] * rs[m]; cv[m] = acc[ai][1][m][n] * rs[m]; }
                const f32x4 pg3 = dppz4<0x111>(cg[3]), pg2 = dppz4<0x111>(cg[2]), pv3 = dppz4<0x111>(cv[3]), pv2 = dppz4<0x111>(cv[2]);
#pragma unroll
                for (int m = 0; m < 4; ++m) {
                    const f32x4 xg1 = m == 0 ? pg3 : cg[m - 1], xg2 = m == 0 ? pg2 : (m == 1 ? pg3 : cg[m - 2]);
                    const f32x4 xv1 = m == 0 ? pv3 : cv[m - 1], xv2 = m == 0 ? pv2 : (m == 1 ? pv3 : cv[m - 2]);
                    const f32x4 og = bg + w0g * xg2 + w1g * xg1 + w2g * cg[m], ov = bv + w0v * xv2 + w1v * xv1 + w2v * cv[m];
                    const f32x4 av = gelu4(og) * ov;
                    const u32x2 pk = (u32x2){cvt_pk_bf16(av[0], av[1]), cvt_pk_bf16(av[2], av[3])};
                    if (n == 0) held[ai][m] = pk;
                    else if (!(m < 2 && fr == 0)) *(u32x4*)(ACT + (size_t)(row0 + m) * 3072 + jc0) = (u32x4){held[ai][m].x, held[ai][m].y, pk.x, pk.y};
                }
                if (fr == 0) {
#pragma unroll
                    for (int m = 0; m < 2; ++m) { bf16_t* hp = halo + (size_t)(g * 4 + m) * 6144 + jc;
                        *(u32x2*)hp = (u32x2){cvt_pk_bf16(cg[m][0], cg[m][1]), cvt_pk_bf16(cg[m][2], cg[m][3])}; *(u32x2*)(hp + 3072) = (u32x2){cvt_pk_bf16(cv[m][0], cv[m][1]), cvt_pk_bf16(cv[m][2], cv[m][3])}; } }
                if (fr == 15) {
#pragma unroll
                    for (int m = 2; m < 4; ++m) { bf16_t* hp = halo + (size_t)(g * 4 + m) * 6144 + jc;
                        *(u32x2*)hp = (u32x2){cvt_pk_bf16(cg[m][0], cg[m][1]), cvt_pk_bf16(cg[m][2], cg[m][3])}; *(u32x2*)(hp + 3072) = (u32x2){cvt_pk_bf16(cv[m][0], cv[m][1]), cvt_pk_bf16(cv[m][2], cv[m][3])};
                        const int row = row0 + m;
                        if ((row & 2047) >= 2046) { float* op = ofp + (size_t)((row >> 11) * 2 + (row & 2047) - 2046) * 6144 + jc; *(f32x4*)op = cg[m]; *(f32x4*)(op + 3072) = cv[m]; } } }
            }
        }
    }
};

template <int UN> struct Frags { bf16x8 a[UN][4], b[UN][4]; };
struct TileP { const bf16_t* ap; const bf16_t* bp[4]; int lda; };
__device__ __forceinline__ TileP st_tile(const bf16_t* A, int lda, int arow0, const bf16_t* Bt, int ldb, int b0, int b1, int b2, int b3, int K) {
    int tid_ = threadIdx.x; asm volatile("" : "+v"(tid_));
    const int wave = tid_ >> 6, lane = tid_ & 63, fr = lane & 15, fq = lane >> 4, kw = K >> 3;
    TileP t; t.lda = lda; t.ap = A + (size_t)(arow0 + fr) * lda + wave * kw + 8 * fq;
    const bf16_t* bb = Bt + (size_t)fr * ldb + wave * kw + 8 * fq;
    t.bp[0] = bb + (size_t)b0 * ldb; t.bp[1] = bb + (size_t)b1 * ldb; t.bp[2] = bb + (size_t)b2 * ldb; t.bp[3] = bb + (size_t)b3 * ldb;
    return t;
}
template <int UN> __device__ __forceinline__ void st_load(Frags<UN>& F, const TileP& t, int s0) {
#pragma unroll
    for (int s = 0; s < UN; ++s)
#pragma unroll
        for (int i = 0; i < 4; ++i) { F.a[s][i] = *(const bf16x8*)(t.ap + (size_t)(16 * i) * t.lda + (s0 + s) * 32); F.b[s][i] = *(const bf16x8*)(t.bp[i] + (s0 + s) * 32); }
}
template <int UN> __device__ __forceinline__ void st_mma(f32x4 (&acc)[4][4], const Frags<UN>& F) {
#pragma unroll
    for (int s = 0; s < UN; ++s)
#pragma unroll
        for (int i = 0; i < 4; ++i)
#pragma unroll
            for (int j = 0; j < 4; ++j) acc[i][j] = __builtin_amdgcn_mfma_f32_16x16x32_bf16(F.b[s][j], F.a[s][i], acc[i][j], 0, 0, 0);
}
__device__ __forceinline__ void st_zero(f32x4 (&acc)[4][4]) {
#pragma unroll
    for (int i = 0; i < 4; ++i)
#pragma unroll
        for (int j = 0; j < 4; ++j) acc[i][j] = (f32x4){0.f, 0.f, 0.f, 0.f};
}
__device__ __forceinline__ void st_reduce(LAS unsigned char* lds, const f32x4 (&acc)[4][4], f32x4& lo0, f32x4& lo1, f32x4& hi0, f32x4& hi1) {
    int tid_ = threadIdx.x; asm volatile("" : "+v"(tid_));
    const int tid = tid_, wave = tid >> 6, lane = tid & 63, fr = lane & 15, fq = lane >> 4;
    LAS float* P = (LAS float*)lds + wave * 4096;
#pragma unroll
    for (int i = 0; i < 4; ++i)
#pragma unroll
        for (int j = 0; j < 4; ++j) { const int r = 16 * i + fr, ch = (4 * j + fq) ^ fr; *(LAS f32x4*)(P + r * 64 + ch * 4) = acc[i][j]; }
    __syncthreads();
    {   const int r = tid >> 3, c = tid & 7; LAS const float* Q = (LAS const float*)lds + r * 64;
        const int c0 = ((2 * c) ^ (r & 15)) * 4, c1 = ((2 * c + 1) ^ (r & 15)) * 4;
        lo0 = (f32x4){0.f, 0.f, 0.f, 0.f}; lo1 = lo0; hi0 = lo0; hi1 = lo0;
#pragma unroll
        for (int w = 0; w < 4; ++w) { lo0 += *(LAS const f32x4*)(Q + w * 4096 + c0); lo1 += *(LAS const f32x4*)(Q + w * 4096 + c1);
            hi0 += *(LAS const f32x4*)(Q + (w + 4) * 4096 + c0); hi1 += *(LAS const f32x4*)(Q + (w + 4) * 4096 + c1); } }
    __syncthreads();
}
struct XpT { const float* src; const float* scale; bf16_t* dst; };
__device__ __forceinline__ XpT xp_desc(KP p, unsigned char* ws, int tt) {
    const int lane = threadIdx.x & 63, w = threadIdx.x >> 6;
    const float* src; int ldsrc, k0, scol0, lddst, drow0; const float* scale; bf16_t* dst;
    if (tt < 512) { const int kt = tt >> 5, nt = tt & 31; src = p->in[8]; ldsrc = 2048; k0 = kt * 64; scol0 = nt * 64; scale = p->in[7] + k0; dst = (bf16_t*)(ws + OFF_WIN); lddst = 1024; drow0 = nt * 64; }
    else if (tt < 768) { const int t2 = tt - 512, kt = t2 >> 4, nt = t2 & 15; src = p->in[22]; ldsrc = 1024; k0 = kt * 64; scol0 = nt * 64; scale = k0 < 512 ? p->in[16] + k0 : p->in[21] + (k0 - 512); dst = (bf16_t*)(ws + OFF_WOUT); lddst = 1024; drow0 = nt * 64; }
    else if (tt < 2304) { const int t2 = tt - 768, kt = t2 / 96, nt = t2 % 96, n0 = nt * 64; src = p->in[24]; ldsrc = 6144; k0 = kt * 64; scol0 = ((n0 & 255) >> 7) * 3072 + (n0 >> 8) * 128 + (n0 & 127); scale = p->in[23] + k0; dst = (bf16_t*)(ws + OFF_WUP); lddst = 1024; drow0 = n0; }
    else if (tt < 3072) { const int t2 = tt - 2304, kt = t2 >> 4, nt = t2 & 15; src = p->in[27]; ldsrc = 1024; k0 = kt * 64; scol0 = nt * 64; scale = nullptr; dst = (bf16_t*)(ws + OFF_WDN); lddst = 3072; drow0 = nt * 64; }
    else if (tt < 3328) { const int t2 = tt - 3072, kt = t2 >> 4, nt = t2 & 15; src = p->in[29]; ldsrc = 1024; k0 = kt * 64; scol0 = nt * 64; scale = p->in[28] + k0; dst = (bf16_t*)(ws + OFF_WPG); lddst = 1024; drow0 = nt * 64; }
    else { const int t2 = tt - 3328, kt = t2 >> 4, nt = t2 & 15; src = p->in[30]; ldsrc = 1024; k0 = kt * 64; scol0 = nt * 64; scale = nullptr; dst = (bf16_t*)(ws + OFF_WPLE); lddst = 256; drow0 = nt * 64; }
    XpT t; t.src = src + (size_t)(k0 + 8 * w) * ldsrc + scol0 + lane; t.scale = scale ? scale + 8 * w : nullptr; t.dst = dst + (size_t)(drow0 + lane) * lddst + k0 + 8 * w;
    return t;
}
__device__ __forceinline__ int xp_ld(int tt) { return tt < 512 ? 2048 : (tt >= 768 && tt < 2304) ? 6144 : 1024; }
__device__ __forceinline__ void xp_pair(KP p, unsigned char* ws, int tt, int t1, bool two) {
    const XpT A = xp_desc(p, ws, tt), B = xp_desc(p, ws, two ? t1 : tt);
    const int la = xp_ld(tt), lb = xp_ld(two ? t1 : tt);
    float va[8], vb[8];
#pragma unroll
    for (int e = 0; e < 8; ++e) { va[e] = __builtin_nontemporal_load(A.src + (size_t)e * la); vb[e] = __builtin_nontemporal_load(B.src + (size_t)e * lb); }
    if (A.scale) {
#pragma unroll
        for (int e = 0; e < 8; ++e) va[e] *= A.scale[e]; }
    if (B.scale) {
#pragma unroll
        for (int e = 0; e < 8; ++e) vb[e] *= B.scale[e]; }
    *(u32x4*)A.dst = (u32x4){cvt_pk_bf16(va[0], va[1]), cvt_pk_bf16(va[2], va[3]), cvt_pk_bf16(va[4], va[5]), cvt_pk_bf16(va[6], va[7])};
    if (two) *(u32x4*)B.dst = (u32x4){cvt_pk_bf16(vb[0], vb[1]), cvt_pk_bf16(vb[2], vb[3]), cvt_pk_bf16(vb[4], vb[5]), cvt_pk_bf16(vb[6], vb[7])};
}
__device__ __forceinline__ void p0_phase(KP p, LAS unsigned char* lds) {
    const int tid = threadIdx.x, lane = tid & 63, wave = tid >> 6, G = gridDim.x, blk = blockIdx.x;
    unsigned char* ws = p->ws;
    {   bf16_t* Xb = (bf16_t*)(ws + OFF_XB); float* rstd1 = (float*)(ws + OFF_RSTD1);
        for (int r0 = (blk * 8 + wave) * 2; r0 < NT; r0 += G * 16) {
            f32x4 v[2][4]; float ss[2];
#pragma unroll
            for (int h = 0; h < 2; ++h) { const int r = r0 + h; const float* src = r < NP ? p->in[0] + (size_t)r * D : p->in[1] + (size_t)(r - NP) * D;
#pragma unroll
                for (int i = 0; i < 4; ++i) v[h][i] = __builtin_nontemporal_load((const f32x4*)(src + i * 256 + lane * 4)); }
#pragma unroll
            for (int h = 0; h < 2; ++h) { ss[h] = 0.f;
#pragma unroll
                for (int i = 0; i < 4; ++i) ss[h] += sq4(v[h][i]);
                ss[h] = wave_sum(ss[h]);
                if (lane == 0) rstd1[r0 + h] = rsqrtf(ss[h] * (1.0f / 1024.0f) + EPS);
#pragma unroll
                for (int i = 0; i < 4; ++i) *(u32x2*)(Xb + (size_t)(r0 + h) * D + i * 256 + lane * 4) = (u32x2){cvt_pk_bf16(v[h][i][0], v[h][i][1]), cvt_pk_bf16(v[h][i][2], v[h][i][3])}; }
        } }
    {   for (int ti = blk; ti < 768; ti += 2 * G) { const int t1 = ti + G; const bool two = t1 < 768; xp_pair(p, ws, ti, two ? t1 : ti, two); } }
    {   u32x4* ag = (u32x4*)(ws + OFF_AGG); for (int i = blk * 512 + tid; i < 32768; i += G * 512) ag[i] = (u32x4){0u, 0u, 0u, 0u}; }
    {   bf16_t* Wg = (bf16_t*)(ws + OFF_WG); bf16_t* Ws = (bf16_t*)(ws + OFF_WSGU);
        if (blk == 0) ((float*)(ws + OFF_SP))[tid] = log1pf(expf(-p->in[15][tid]));
        for (int idx = blk * 512 + tid; idx < 65536; idx += G * 512) {
            const int hd = idx >> 13, n = (idx >> 6) & 127, k = idx & 63;
            const float v = n < 64 ? p->in[11][(hd * 64 + k) * 64 + n] : p->in[13][(hd * 64 + k) * 64 + (n - 64)];
            Wg[idx] = (bf16_t)(cvt_pk_bf16(v, 0.f) & 0xffffu);
            const int t = (idx >> 7) & 127, s = idx & 127;
            const float w = s <= t ? p->in[19][idx] : 0.f;
            Ws[idx] = (bf16_t)(cvt_pk_bf16(w, 0.f) & 0xffffu);
        } }
}

__device__ __forceinline__ float ald_f(const float* p) { return __uint_as_float(__hip_atomic_load((const unsigned*)p, __ATOMIC_RELAXED, __HIP_MEMORY_SCOPE_AGENT)); }
__device__ __forceinline__ void ast_f(float* p, float v) { __hip_atomic_store((unsigned*)p, __float_as_uint(v), __ATOMIC_RELAXED, __HIP_MEMORY_SCOPE_AGENT); }

__device__ __forceinline__ void p2_taskA(KP p, LAS unsigned char* lds, int task, int skip = 0) {
    int tid_ = threadIdx.x; asm volatile("" : "+v"(tid_));
    const int tid = tid_, lane = tid & 63, wave = tid >> 6;
    unsigned char* ws = p->ws;
    const bool samp = task >= 1024;
    const int hd = task & 7;
    const int c = samp ? 0 : (task >> 6), b = samp ? 0 : ((task >> 3) & 7), sc = samp ? ((task - 1024) >> 3) : 0;
    const int R0 = samp ? NP + sc * 128 : b * 2048 + c * 128;
    const bf16_t* Z = (const bf16_t*)(ws + OFF_Z);
    LAS bf16_t* xcb = (LAS bf16_t*)lds;
    LAS float* aS = (LAS float*)(lds + 18432);
    LAS float* uS = (LAS float*)(lds + 18432 + 34816);
    LAS float* Pseg = (LAS float*)(lds + 88064);
    LAS float* Sseg = Pseg + 512;
    LAS float* hin = Sseg + 512;
    const bf16_t* gap_ = Z + (size_t)(R0 + (tid >> 2)) * 2048 + 512 + hd * 64 + (tid & 3) * 16;
    const u32x4 gaw0 = *(const u32x4*)gap_, gaw1 = *(const u32x4*)(gap_ + 8);
    if (!(skip & 1))
    {   const int t = tid >> 2, cgp = tid & 3, ch0 = hd * 64 + cgp * 16;
        f32x4 xc[4];
#pragma unroll
        for (int i = 0; i < 4; ++i) xc[i] = *(const f32x4*)(p->in[10] + ch0 + 4 * i);
#pragma unroll
        for (int j = 0; j < 4; ++j) {
            f32x4 xv[4] = {{0.f, 0.f, 0.f, 0.f}, {0.f, 0.f, 0.f, 0.f}, {0.f, 0.f, 0.f, 0.f}, {0.f, 0.f, 0.f, 0.f}};
            const bf16_t* src = nullptr; const float* srcf = nullptr;
            if (!samp) { const int pos = c * 128 + t - 3 + j; if (pos >= 0) src = Z + (size_t)(b * 2048 + pos) * 2048 + ch0; }
            else { const int q = sc * 32 + (t >> 2), idx = (t & 3) + j; if (idx < 3) srcf = p->in[5] + ((size_t)q * 3 + idx) * 512 + ch0; else src = Z + (size_t)(NP + 4 * q + idx - 3) * 2048 + ch0; }
            if (src) { const u32x4 w0 = *(const u32x4*)src, w1 = *(const u32x4*)(src + 8); unpack8(w0, xv[0], xv[1]); unpack8(w1, xv[2], xv[3]); }
            else if (srcf) {
#pragma unroll
                for (int i = 0; i < 4; ++i) xv[i] = *(const f32x4*)(srcf + 4 * i); }
#pragma unroll
            for (int i = 0; i < 4; ++i) xc[i] += *(const f32x4*)(p->in[9] + j * 512 + ch0 + 4 * i) * xv[i];
            if (j == 3) {
                float* op = nullptr;
                if (!samp) { if (c == 15 && t >= 125) op = p->out + O_CP + (size_t)(b * 3 + t - 125) * 512 + ch0; }
                else { const int q = sc * 32 + (t >> 2), pos = t & 3; if (pos >= 1) op = p->out + O_CS + (size_t)(q * 3 + pos - 1) * 512 + ch0; }
                if (op) {
#pragma unroll
                    for (int i = 0; i < 4; ++i) *(f32x4*)(op + 4 * i) = xv[i]; }
            }
        }
        *(LAS u32x4*)(xcb + t * 72 + cgp * 16) = pack8(xc[0], xc[1]);
        *(LAS u32x4*)(xcb + t * 72 + cgp * 16 + 8) = pack8(xc[2], xc[3]);
    }
    __syncthreads();
    if (!(skip & 2))
    {   const int fr = lane & 15, fq = lane >> 4;
        bf16x8 af[2];
#pragma unroll
        for (int ks = 0; ks < 2; ++ks) af[ks] = *(const LAS bf16x8*)(xcb + (16 * wave + fr) * 72 + 32 * ks + 8 * fq);
        LAS const bf16_t* WgL = (LAS const bf16_t*)(lds + 98304);
        f32x4 acc[8];
#pragma unroll
        for (int nb = 0; nb < 8; ++nb) { acc[nb] = (f32x4){0.f, 0.f, 0.f, 0.f};
#pragma unroll
            for (int ks = 0; ks < 2; ++ks) { const bf16x8 bb = *(const LAS bf16x8*)(WgL + (16 * nb + fr) * 72 + 32 * ks + 8 * fq);
                acc[nb] = __builtin_amdgcn_mfma_f32_16x16x32_bf16(af[ks], bb, acc[nb], 0, 0, 0); } }
#pragma unroll
        for (int nb = 0; nb < 4; ++nb) {
            const int ch = 16 * nb + fr, chg = hd * 64 + ch;
            const float ba = p->in[12][chg], bx = p->in[14][chg], sp = ((const float*)(ws + OFF_SP))[chg];
#pragma unroll
            for (int j = 0; j < 4; ++j) {
                const int tok = 16 * wave + 4 * fq + j;
                const float rg = sigmoidf_(acc[nb][j] + ba), ig = sigmoidf_(acc[nb + 4][j] + bx);
                const float la = -8.0f * rg * sp;
                const float a = __builtin_amdgcn_exp2f(1.4426950409f * la);
                float mult = __builtin_amdgcn_sqrtf((1.0f - a) * (1.0f + a));
                if (!samp && c == 0 && tok == 0) mult = 1.0f;
                const float xcv = bf2f(xcb[tok * 72 + ch]);
                aS[tok * 68 + ch] = a; uS[tok * 68 + ch] = xcv * ig * mult;
            }
        }
    }
    __syncthreads();
    if (samp) {
        const int ch = lane;
#pragma unroll
        for (int s4 = 0; s4 < 4; ++s4) {
            const int q = sc * 32 + wave * 4 + s4;
            float h = p->in[4][(size_t)q * 512 + hd * 64 + ch];
#pragma unroll
            for (int i = 0; i < 4; ++i) { const int tok = 16 * wave + 4 * s4 + i; h = aS[tok * 68 + ch] * h + uS[tok * 68 + ch]; uS[tok * 68 + ch] = h; }
            p->out[O_HS + (size_t)q * 512 + hd * 64 + ch] = h;
        }
        __syncthreads();
    } else {
        {   const int ch = lane; float P = 1.f, S = 0.f;
#pragma unroll
            for (int i = 0; i < 16; ++i) { const int o = (16 * wave + i) * 68 + ch; const float a = aS[o]; S = a * S + uS[o]; P *= a; uS[o] = S; aS[o] = P; }
            Pseg[wave * 64 + ch] = P; Sseg[wave * 64 + ch] = S; }
        __syncthreads();
        if (wave == 0) {
            const int ch = lane;
            float Pc = 1.f, Sc = 0.f;
#pragma unroll
            for (int s = 0; s < 8; ++s) { const float P = Pseg[s * 64 + ch]; Sc = P * Sc + Sseg[s * 64 + ch]; Pc *= P; }
            unsigned long long* AGG = (unsigned long long*)(ws + OFF_AGG);
            if (c < 15 && !(skip & 3)) __hip_atomic_store(AGG + (size_t)task * 64 + ch, ((unsigned long long)__float_as_uint(Sc) << 32) | (unsigned long long)(__float_as_uint(Pc) | 0x80000000u), __ATOMIC_RELAXED, __HIP_MEMORY_SCOPE_AGENT);
            float h = 0.f;
            if (c > 0 && !(skip & 4)) {
                unsigned long long gv[15];
#pragma unroll
                for (int j = 0; j < 15; ++j) gv[j] = 1ull;
                unsigned sp = 0;
                for (;;) {
                    bool miss = false;
#pragma unroll
                    for (int j = 0; j < 15; ++j) if (j < c) { gv[j] = __hip_atomic_load(AGG + (size_t)(j * 64 + b * 8 + hd) * 64 + ch, __ATOMIC_RELAXED, __HIP_MEMORY_SCOPE_AGENT); }
#pragma unroll
                    for (int j = 0; j < 15; ++j) miss |= (gv[j] == 0ull);
                    if (__builtin_amdgcn_ballot_w64(miss) == 0ull) break;
                    __builtin_amdgcn_s_sleep(2); if (++sp > (1u << 20)) break;
                }
#pragma unroll
                for (int j = 0; j < 15; ++j) if (j < c) h = __uint_as_float((unsigned)gv[j] & 0x7fffffffu) * h + __uint_as_float((unsigned)(gv[j] >> 32));
            }
#pragma unroll
            for (int s = 0; s < 8; ++s) { hin[s * 64 + ch] = h; h = Pseg[s * 64 + ch] * h + Sseg[s * 64 + ch]; }
            if (c == 15) p->out[O_HP + (size_t)b * 512 + hd * 64 + ch] = h;
        }
        __syncthreads();
    }
    if (!(skip & 8))
    {   const int t = tid >> 2, part = tid & 3, row = R0 + t;
        f32x4 g[4]; unpack8(gaw0, g[0], g[1]); unpack8(gaw1, g[2], g[3]);
        float ss = 0.f;
#pragma unroll
        for (int i = 0; i < 4; ++i) { f32x4 h = *(const LAS f32x4*)(uS + t * 68 + part * 16 + 4 * i);
            if (!samp) h += *(const LAS f32x4*)(aS + t * 68 + part * 16 + 4 * i) * *(const LAS f32x4*)(hin + (t >> 4) * 64 + part * 16 + 4 * i);
            g[i] *= h; ss += sq4(g[i]); }
        ss += __shfl_xor(ss, 1); ss += __shfl_xor(ss, 2);
        if (part == 0) ((float*)(ws + OFF_SSQY))[(size_t)row * 16 + hd] = ss;
        bf16_t* yp = (bf16_t*)(ws + OFF_Y) + (size_t)row * 1024 + hd * 64 + part * 16;
        *(u32x4*)yp = pack8(g[0], g[1]); *(u32x4*)(yp + 8) = pack8(g[2], g[3]);
    }
    __syncthreads();
}

__device__ __forceinline__ void p2_taskB(KP p, LAS unsigned char* lds, int idx) {
    int tid_ = threadIdx.x; asm volatile("" : "+v"(tid_));
    const int tid = tid_, lane = tid & 63, wave = tid >> 6;
    unsigned char* ws = p->ws;
    const int chunk = idx >> 2, hb = idx & 3, R0 = chunk * 128;
    const bf16_t* Z = (const bf16_t*)(ws + OFF_Z);
    LAS bf16_t* vnT = (LAS bf16_t*)lds;
    {   const int s = tid >> 2, dg = tid & 3;
        float m_, r_;
        {   const float* lp = (const float*)(ws + OFF_LNSTAT) + (size_t)(R0 + s) * 16;
            float s1 = 0.f, s2 = 0.f;
#pragma unroll
            for (int i = 0; i < 4; ++i) { const f32x4 v = *(const f32x4*)(lp + 4 * i); s1 += v[0] + v[2]; s2 += v[1] + v[3]; }
            m_ = s1 * (1.0f / 512.0f); r_ = rsqrtf(s2 * (1.0f / 512.0f) - m_ * m_ + EPS); }
        const bf16_t* gp = Z + (size_t)(R0 + s) * 2048 + 1536 + hb * 128 + dg * 32;
#pragma unroll
        for (int q8 = 0; q8 < 4; ++q8) {
            f32x4 g0, g1; unpack8(*(const u32x4*)(gp + 8 * q8), g0, g1);
            const int d0 = dg * 32 + 8 * q8;
            const f32x4 lg0 = *(const f32x4*)(p->in[17] + hb * 128 + d0), lg1 = *(const f32x4*)(p->in[17] + hb * 128 + d0 + 4);
            const f32x4 lb0 = *(const f32x4*)(p->in[18] + hb * 128 + d0), lb1 = *(const f32x4*)(p->in[18] + hb * 128 + d0 + 4);
            g0 = (g0 - m_) * r_ * lg0 + lb0; g1 = (g1 - m_) * r_ * lg1 + lb1;
#pragma unroll
            for (int e = 0; e < 4; ++e) { vnT[(d0 + e) * 136 + s] = (bf16_t)(cvt_pk_bf16(g0[e], 0.f) & 0xffffu); vnT[(d0 + 4 + e) * 136 + s] = (bf16_t)(cvt_pk_bf16(g1[e], 0.f) & 0xffffu); }
        } }
    __syncthreads();
    {   const int fr = lane & 15, fq = lane >> 4, t = 16 * wave + fr, row = R0 + t;
        const bf16_t* W = (const bf16_t*)(ws + OFF_WSGU) + hb * 16384;
        f32x4 acc[8]; u32x2 gwv[8];
        const float bs = p->in[20][hb * 128 + t];
#pragma unroll
        for (int nb = 0; nb < 8; ++nb) { acc[nb] = (f32x4){0.f, 0.f, 0.f, 0.f}; gwv[nb] = *(const u32x2*)(Z + (size_t)row * 2048 + 1024 + hb * 128 + 16 * nb + 4 * fq); }
        for (int ks = 0; ks <= (wave >> 1); ++ks) {
            const bf16x8 wf = *(const bf16x8*)(W + t * 128 + 32 * ks + 8 * fq);
#pragma unroll
            for (int nb = 0; nb < 8; ++nb) { const bf16x8 vf = *(const LAS bf16x8*)(vnT + (16 * nb + fr) * 136 + 32 * ks + 8 * fq);
                acc[nb] = __builtin_amdgcn_mfma_f32_16x16x32_bf16(vf, wf, acc[nb], 0, 0, 0); } }
        float ss = 0.f;
#pragma unroll
        for (int nb = 0; nb < 8; ++nb) { const int d0 = hb * 128 + 16 * nb + 4 * fq; const u32x2 gw = gwv[nb];
            f32x4 v = (f32x4){bflo(gw.x), bfhi(gw.x), bflo(gw.y), bfhi(gw.y)} * (acc[nb] + bs);
            ss += sq4(v);
            *(u32x2*)((bf16_t*)(ws + OFF_Y) + (size_t)row * 1024 + 512 + d0) = (u32x2){cvt_pk_bf16(v[0], v[1]), cvt_pk_bf16(v[2], v[3])}; }
        ss = red_fq(ss);
        if (fq == 0) ((float*)(ws + OFF_SSQY))[(size_t)row * 16 + 8 + hb] = ss;
    }
    __syncthreads();
}
__device__ __forceinline__ void p2_taskBs(KP p, int q) {
    const int lane = threadIdx.x & 63, hb = lane >> 4;
    unsigned char* ws = p->ws;
    const bf16_t* Z = (const bf16_t*)(ws + OFF_Z);
    const f32x4 lg0 = *(const f32x4*)(p->in[17] + 8 * lane), lg1 = *(const f32x4*)(p->in[17] + 8 * lane + 4), lb0 = *(const f32x4*)(p->in[18] + 8 * lane), lb1 = *(const f32x4*)(p->in[18] + 8 * lane + 4);
    f32x4 vn[4][2];
#pragma unroll
    for (int t = 0; t < 4; ++t) {
        const int row = NP + 4 * q + t;
        const float* lp = (const float*)(ws + OFF_LNSTAT) + (size_t)row * 16;
        float s1 = 0.f, s2 = 0.f;
#pragma unroll
        for (int i = 0; i < 4; ++i) { const f32x4 v = *(const f32x4*)(lp + 4 * i); s1 += v[0] + v[2]; s2 += v[1] + v[3]; }
        const float mean = s1 * (1.0f / 512.0f), var = s2 * (1.0f / 512.0f) - mean * mean, r_ = rsqrtf(var + EPS);
        f32x4 g0, g1; unpack8(*(const u32x4*)(Z + (size_t)row * 2048 + 1536 + 8 * lane), g0, g1);
        vn[t][0] = (g0 - mean) * r_ * lg0 + lb0; vn[t][1] = (g1 - mean) * r_ * lg1 + lb1;
        float* op = p->out + O_VS + (size_t)(q * 4 + t) * 512 + 8 * lane;
        *(f32x4*)op = vn[t][0]; *(f32x4*)(op + 4) = vn[t][1];
    }
#pragma unroll
    for (int t = 0; t < 4; ++t) {
        const int row = NP + 4 * q + t;
        const float bs = p->in[20][hb * 128 + t];
        f32x4 m0 = {bs, bs, bs, bs}, m1 = m0;
#pragma unroll
        for (int s = 0; s <= t; ++s) { const float w = p->in[19][(size_t)(hb * 128 + t) * 128 + s]; m0 += w * vn[s][0]; m1 += w * vn[s][1]; }
        f32x4 g0, g1; unpack8(*(const u32x4*)(Z + (size_t)row * 2048 + 1024 + 8 * lane), g0, g1);
        g0 *= m0; g1 *= m1;
        float ss = sq4(g0) + sq4(g1);
        ss += __shfl_xor(ss, 1); ss += __shfl_xor(ss, 2); ss += __shfl_xor(ss, 4); ss += __shfl_xor(ss, 8);
        if ((lane & 15) == 0) ((float*)(ws + OFF_SSQY))[(size_t)row * 16 + 8 + hb] = ss;
        *(u32x4*)((bf16_t*)(ws + OFF_Y) + (size_t)row * 1024 + 512 + 8 * lane) = pack8(g0, g1);
    }
}
__device__ __forceinline__ void p2_phase(KP p, LAS unsigned char* lds, int lo = 0, int hi = 1584, int skip = 0) {
    int cur_hd = -1;
    for (int task = blockIdx.x; task < 1584; task += gridDim.x) {
        if (task < lo || task >= hi) continue;
        if (task < 1056 && (task & 7) != cur_hd) {
            cur_hd = task & 7;
            const bf16_t* Wg = (const bf16_t*)(p->ws + OFF_WG) + cur_hd * 8192;
            __syncthreads();
            for (int i = threadIdx.x; i < 1024; i += 512) { const int n = i >> 3, k8 = i & 7; *(LAS u32x4*)((LAS bf16_t*)(lds + 98304) + n * 72 + k8 * 8) = *(const u32x4*)(Wg + n * 64 + k8 * 8); }
            __syncthreads();
        }
        if (task < 1056) p2_taskA(p, lds, task, skip);
        else if (task < 1568) p2_taskB(p, lds, task - 1056);
        else p2_taskBs(p, (task - 1568) * 8 + (threadIdx.x >> 6));
    }
    if (lo == 0 && hi == 1584) {
        const int nb = (int)gridDim.x > 64 ? (int)gridDim.x - 32 : (int)gridDim.x, b0 = (int)gridDim.x > 64 ? (int)blockIdx.x - 32 : (int)blockIdx.x;
        if (b0 >= 0) for (int ti = b0; ti < 2304; ti += 2 * nb) { const int t1 = ti + nb; const bool two = t1 < 2304; xp_pair(p, p->ws, 768 + ti, 768 + (two ? t1 : ti), two); }
    }
}


__device__ __forceinline__ void p3_extra(KP p) {
    unsigned char* ws = p->ws; const int tid = threadIdx.x;
    const bool half = gridDim.x == 256; const int e = half ? (int)blockIdx.x - 128 : (int)blockIdx.x, ne = half ? 128 : (int)gridDim.x;
    if (e < 0) return;
    {   bf16_t* Pb = (bf16_t*)(ws + OFF_PB);
        for (size_t i0 = ((size_t)e * 512 + tid) * 4; i0 < (size_t)NT * 256; i0 += (size_t)ne * 512 * 16) {
            f32x4 v[4];
#pragma unroll
            for (int h = 0; h < 4; ++h) { const size_t idx = i0 + (size_t)h * ne * 512 * 4;
                if (idx < (size_t)NT * 256) v[h] = __builtin_nontemporal_load((const f32x4*)(idx < (size_t)NP * 256 ? p->in[2] + idx : p->in[3] + (idx - (size_t)NP * 256))); }
#pragma unroll
            for (int h = 0; h < 4; ++h) { const size_t idx = i0 + (size_t)h * ne * 512 * 4;
                if (idx < (size_t)NT * 256) *(u32x2*)(Pb + idx) = (u32x2){cvt_pk_bf16(v[h][0], v[h][1]), cvt_pk_bf16(v[h][2], v[h][3])}; }
        } }
    for (int ti = e; ti < 320; ti += 2 * ne) { const int t1 = ti + ne; const bool two = t1 < 320; xp_pair(p, ws, 3072 + ti, 3072 + (two ? t1 : ti), two); }
}
__device__ __forceinline__ f32x4 ld_bf4(const bf16_t* q) { const u32x2 w = *(const u32x2*)q; return (f32x4){bflo(w.x), bfhi(w.x), bflo(w.y), bfhi(w.y)}; }
__device__ __forceinline__ void p4b_tile(KP p, int pm) {
    unsigned char* ws = p->ws;
    const bf16_t* halo = (const bf16_t*)(ws + OFF_HALO); bf16_t* ACT = (bf16_t*)(ws + OFF_ACT);
    const float* cw = p->in[25]; const float* cb = p->in[26];
    for (int jj = threadIdx.x; jj < 768; jj += 512) {
        const int j = jj * 4;
        const f32x4 bg = *(const f32x4*)(cb + j), w0g = *(const f32x4*)(cw + j), w1g = *(const f32x4*)(cw + 6144 + j), w2g = *(const f32x4*)(cw + 12288 + j);
        const f32x4 bv = *(const f32x4*)(cb + 3072 + j), w0v = *(const f32x4*)(cw + 3072 + j), w1v = *(const f32x4*)(cw + 6144 + 3072 + j), w2v = *(const f32x4*)(cw + 12288 + 3072 + j);
#pragma unroll
        for (int gl = 0; gl < 4; ++gl) {
            const int g = pm * 4 + gl; const bool first = (g & 31) == 0;
            const f32x4 z4 = {0.f, 0.f, 0.f, 0.f};
            const bf16_t* hb = halo + (size_t)(g * 4) * 6144 + j; const bf16_t* tb = halo + (size_t)((g - 1) * 4 + 2) * 6144 + j;
            const f32x4 h0g = ld_bf4(hb), h1g = ld_bf4(hb + 6144), h0v = ld_bf4(hb + 3072), h1v = ld_bf4(hb + 6144 + 3072);
            const f32x4 t0g = first ? z4 : ld_bf4(tb), t1g = first ? z4 : ld_bf4(tb + 6144), t0v = first ? z4 : ld_bf4(tb + 3072), t1v = first ? z4 : ld_bf4(tb + 6144 + 3072);
            {   const f32x4 og = bg + w0g * t0g + w1g * t1g + w2g * h0g, ov = bv + w0v * t0v + w1v * t1v + w2v * h0v;
                *(u32x2*)(ACT + (size_t)(g * 64) * 3072 + j) = (u32x2){cvt_pk_bf16(gelu_t(og[0]) * ov[0], gelu_t(og[1]) * ov[1]), cvt_pk_bf16(gelu_t(og[2]) * ov[2], gelu_t(og[3]) * ov[3])}; }
            {   const f32x4 og = bg + w0g * t1g + w1g * h0g + w2g * h1g, ov = bv + w0v * t1v + w1v * h0v + w2v * h1v;
                *(u32x2*)(ACT + (size_t)(g * 64 + 1) * 3072 + j) = (u32x2){cvt_pk_bf16(gelu_t(og[0]) * ov[0], gelu_t(og[1]) * ov[1]), cvt_pk_bf16(gelu_t(og[2]) * ov[2], gelu_t(og[3]) * ov[3])}; }
        }
    }
}
__device__ __forceinline__ void p7_phase(KP p, int row_lo) {
    const int lane = threadIdx.x & 63, wave = threadIdx.x >> 6;
    const float* ssq = (const float*)(p->ws + OFF_SSQ3); const bf16_t* H3 = (const bf16_t*)(p->ws + OFF_H3);
    f32x4 gf[4];
#pragma unroll
    for (int i = 0; i < 2; ++i) { gf[2 * i] = *(const f32x4*)(p->in[31] + i * 512 + lane * 8); gf[2 * i + 1] = *(const f32x4*)(p->in[31] + i * 512 + lane * 8 + 4); }
    for (int r = row_lo + blockIdx.x * 8 + wave; r < NT; r += gridDim.x * 8) {
        const float rs = rsqrtf(sum16(ssq + (size_t)r * 16) * (1.0f / 1024.0f) + EPS);
        float* op = p->out + (size_t)r * 1024;
#pragma unroll
        for (int i = 0; i < 2; ++i) { f32x4 a, b; unpack8(*(const u32x4*)(H3 + (size_t)r * 1024 + i * 512 + lane * 8), a, b);
            *(f32x4*)(op + i * 512 + lane * 8) = a * rs * gf[2 * i]; *(f32x4*)(op + i * 512 + lane * 8 + 4) = b * rs * gf[2 * i + 1]; }
    }
}

__device__ __forceinline__ bool st_map(int i, int nct, int& rt, int& ct) {
    const int b = blockIdx.x;
    if (gridDim.x == 256) {
        const int xcd = b & 7, slot = b >> 3, cl = slot >> 3;
        rt = slot & 7;
        if (nct >= 32) { ct = i * 32 + xcd * 4 + cl; return ct < nct; }
        ct = xcd * 2 + cl; return i == 0 && cl < 2;
    }
    const int idx = i * gridDim.x + b; rt = idx & 7; ct = idx >> 3; return ct < nct;
}
#define ST_IDX(nct_) const int r = threadIdx.x >> 3, c = threadIdx.x & 7; (void)r; (void)c; int rt, ct; for (int it_ = 0; st_map(it_, (nct_), rt, ct); ++it_)
__device__ __forceinline__ void p1_small(KP p, LAS unsigned char* lds) {
    unsigned char* ws = p->ws;
    ST_IDX(32) {
        const int arow0 = NP + 64 * rt;
        const TileP T = st_tile((const bf16_t*)(ws + OFF_XB), 1024, arow0, (const bf16_t*)(ws + OFF_WIN), 1024, 64 * ct, 64 * ct + 16, 64 * ct + 32, 64 * ct + 48, 1024);
        Frags<4> F; st_load(F, T, 0);
        const int row = arow0 + r, col = 64 * ct + 8 * c, kind = ct >> 3;
        const float rs = ((const float*)(ws + OFF_RSTD1))[row];
        f32x4 acc[4][4]; st_zero(acc); st_mma(acc, F);
        f32x4 lo0, lo1, hi0, hi1; st_reduce(lds, acc, lo0, lo1, hi0, hi1);
        f32x4 v0 = lo0 + hi0, v1 = lo1 + hi1; float s1 = 0.f, s2 = 0.f;
        seg_z(kind, rs, v0, v1, s1, s2);
        *(u32x4*)((bf16_t*)(ws + OFF_Z) + (size_t)row * 2048 + col) = pack8(v0, v1);
        if (kind == 3) { s1 = red8(s1); s2 = red8(s2); if (c == 0) *(f32x2*)((float*)(ws + OFF_LNSTAT) + (size_t)row * 16 + (ct - 24) * 2) = (f32x2){s1, s2}; }
    }
}
__device__ __forceinline__ void p3_small(KP p, LAS unsigned char* lds) {
    unsigned char* ws = p->ws;
    ST_IDX(16) {
        const int arow0 = NP + 64 * rt;
        const TileP T = st_tile((const bf16_t*)(ws + OFF_Y), 1024, arow0, (const bf16_t*)(ws + OFF_WOUT), 1024, 64 * ct, 64 * ct + 16, 64 * ct + 32, 64 * ct + 48, 1024);
        Frags<4> F; st_load(F, T, 0);
        const int row = arow0 + r; const float* sp = (const float*)(ws + OFF_SSQY) + (size_t)row * 16;
        const f32x4 q0 = *(const f32x4*)sp, q1 = *(const f32x4*)(sp + 4), q2 = *(const f32x4*)(sp + 8);
        const size_t o = (size_t)row * 1024 + 64 * ct + 8 * c;
        const u32x4 xw = *(const u32x4*)((const bf16_t*)(ws + OFF_XB) + o);
        f32x4 acc[4][4]; st_zero(acc); st_mma(acc, F);
        f32x4 lo0, lo1, hi0, hi1; st_reduce(lds, acc, lo0, lo1, hi0, hi1);
        const float ra = rsqrtf((sum4(q0) + sum4(q1)) * (1.0f / 512.0f) + EPS), rb = rsqrtf(sum4(q2) * (1.0f / 512.0f) + EPS);
        f32x4 x0, x1; unpack8(xw, x0, x1);
        const f32x4 h0 = x0 + lo0 * ra + hi0 * rb, h1 = x1 + lo1 * ra + hi1 * rb;
        *(u32x4*)((bf16_t*)(ws + OFF_R3) + o) = pack8(h0, h1);
        const float ss = red8(sq4(h0) + sq4(h1));
        if (c == 0) ((float*)(ws + OFF_SSQ1))[(size_t)row * 16 + ct] = ss;
    }
}
__device__ __forceinline__ void p5_small(KP p, LAS unsigned char* lds, int mode = 0) {
    unsigned char* ws = p->ws;
    int tid_ = threadIdx.x; asm volatile("" : "+v"(tid_));
    const int tid = tid_, wave = tid >> 6, lane = tid & 63, fr = lane & 15, fq = lane >> 4;
    for (int idx = blockIdx.x; idx < 256; idx += gridDim.x) {
        int rt, ct;
        if (gridDim.x == 256) { const int xcd = idx & 7, slot = idx >> 3; rt = slot & 15; ct = xcd * 2 + (slot >> 4); } else { rt = idx & 15; ct = idx >> 4; }
        const int arow0 = NP + 32 * rt;
        const bf16_t* ap = (const bf16_t*)(ws + OFF_ACT) + (size_t)(arow0 + fr) * 3072 + wave * 384 + 8 * fq;
        const bf16_t* bp = (const bf16_t*)(ws + OFF_WDN) + (size_t)(64 * ct + fr) * 3072 + wave * 384 + 8 * fq;
        bf16x8 a0[2][2], b0[2][4], a1[2][2], b1[2][4];
#define P5S_LOAD(A_, B_, s0) do { _Pragma("unroll") for (int s = 0; s < 2; ++s) { _Pragma("unroll") for (int i = 0; i < 2; ++i) A_[s][i] = *(const bf16x8*)(ap + (size_t)(16 * i) * 3072 + ((s0) + s) * 32); \
            _Pragma("unroll") for (int j = 0; j < 4; ++j) B_[s][j] = *(const bf16x8*)(bp + (size_t)(16 * j) * 3072 + ((s0) + s) * 32); } } while (0)
#define P5S_MMA(A_, B_) do { _Pragma("unroll") for (int s = 0; s < 2; ++s) _Pragma("unroll") for (int i = 0; i < 2; ++i) _Pragma("unroll") for (int j = 0; j < 4; ++j) \
            acc[i][j] = __builtin_amdgcn_mfma_f32_16x16x32_bf16(B_[s][j], A_[s][i], acc[i][j], 0, 0, 0); } while (0)
        P5S_LOAD(a0, b0, 0); P5S_LOAD(a1, b1, 2);
        const int r = tid >> 4, c4 = tid & 15, row = arow0 + r;
        bf16_t* hp = (bf16_t*)(ws + OFF_R3) + (size_t)row * 1024 + 64 * ct + 4 * c4;
        const u32x2 xw = *(const u32x2*)hp;
        f32x4 acc[2][4];
#pragma unroll
        for (int i = 0; i < 2; ++i)
#pragma unroll
            for (int j = 0; j < 4; ++j) acc[i][j] = (f32x4){0.f, 0.f, 0.f, 0.f};
#pragma unroll
        for (int s0 = 0; s0 < 12; s0 += 4) { P5S_MMA(a0, b0); if (s0 + 4 < 12) P5S_LOAD(a0, b0, s0 + 4); P5S_MMA(a1, b1); if (s0 + 6 < 12) P5S_LOAD(a1, b1, s0 + 6); }
#undef P5S_LOAD
#undef P5S_MMA
        LAS float* P = (LAS float*)lds + wave * 2048;
#pragma unroll
        for (int i = 0; i < 2; ++i)
#pragma unroll
            for (int j = 0; j < 4; ++j) { const int rr = 16 * i + fr, ch = (4 * j + fq) ^ fr; *(LAS f32x4*)(P + rr * 64 + ch * 4) = acc[i][j]; }
        __syncthreads();
        f32x4 sum = {0.f, 0.f, 0.f, 0.f};
        {   LAS const float* Q = (LAS const float*)lds + r * 64 + ((c4 ^ (r & 15)) * 4);
#pragma unroll
            for (int w = 0; w < 8; ++w) sum += *(LAS const f32x4*)(Q + w * 2048); }
        __syncthreads();
        const f32x4 h = (f32x4){bflo(xw.x), bfhi(xw.x), bflo(xw.y), bfhi(xw.y)} + sum;
        float ss = sq4(h); ss += __shfl_xor(ss, 1); ss += __shfl_xor(ss, 2); ss += __shfl_xor(ss, 4); ss += __shfl_xor(ss, 8);
        if (mode) { asm volatile("" :: "v"(ss), "v"(h[0])); continue; }
        *(u32x2*)hp = (u32x2){cvt_pk_bf16(h[0], h[1]), cvt_pk_bf16(h[2], h[3])};
        if (c4 == 0) ((float*)(ws + OFF_SSQ2))[(size_t)row * 16 + ct] = ss;
    }
}
__device__ __forceinline__ void p6_small(KP p, LAS unsigned char* lds, bool fuse) {
    unsigned char* ws = p->ws;
    ST_IDX(16) {
        const int arow0 = NP + 64 * rt;
        const TileP T = st_tile((const bf16_t*)(ws + OFF_R3), 1024, arow0, (const bf16_t*)(ws + OFF_WPG), 1024, 64 * ct, 64 * ct + 16, 64 * ct + 32, 64 * ct + 48, 1024);
        Frags<4> F; st_load(F, T, 0);
        const int row = arow0 + r; const float* sp = (const float*)(ws + OFF_SSQ2) + (size_t)row * 16;
        const f32x4 q0 = *(const f32x4*)sp, q1 = *(const f32x4*)(sp + 4), q2 = *(const f32x4*)(sp + 8), q3 = *(const f32x4*)(sp + 12);
        const size_t o = (size_t)row * 1024 + 64 * ct + 8 * c;
        const u32x4 ew = *(const u32x4*)((const bf16_t*)(ws + OFF_E) + o), xw = *(const u32x4*)((const bf16_t*)(ws + OFF_R3) + o);
        f32x4 acc[4][4]; st_zero(acc); st_mma(acc, F);
        f32x4 lo0, lo1, hi0, hi1; st_reduce(lds, acc, lo0, lo1, hi0, hi1);
        const float rs = rsqrtf(((sum4(q0) + sum4(q1)) + (sum4(q2) + sum4(q3))) * (1.0f / 1024.0f) + EPS);
        f32x4 e0, e1, x0, x1; unpack8(ew, e0, e1); unpack8(xw, x0, x1);
        f32x4 g0 = (lo0 + hi0) * rs, g1 = (lo1 + hi1) * rs;
#pragma unroll
        for (int e = 0; e < 4; ++e) { g0[e] = sigmoidf_(g0[e]); g1[e] = sigmoidf_(g1[e]); }
        const f32x4 h0 = x0 + e0 * g0, h1 = x1 + e1 * g1;
        const float ss = red8(sq4(h0) + sq4(h1));
        if (!fuse) {
            *(u32x4*)((bf16_t*)(ws + OFF_H3) + o) = pack8(h0, h1);
            if (c == 0) ((float*)(ws + OFF_SSQ3))[(size_t)row * 16 + ct] = ss;
        } else {
            float* X2 = (float*)(ws + OFF_SSQ3) + 65536 + (size_t)rt * 1024;
            unsigned* cnt2 = (unsigned*)(ws + OFF_FLAG) + 1016 + rt;
            if (c == 0) __hip_atomic_store((unsigned*)(X2 + ct * 64 + r), __float_as_uint(ss), __ATOMIC_RELAXED, __HIP_MEMORY_SCOPE_AGENT);
            asm volatile("s_waitcnt vmcnt(0)" ::: "memory");
            __syncthreads();
            if (threadIdx.x == 0) { __hip_atomic_fetch_add(cnt2, 1u, __ATOMIC_RELAXED, __HIP_MEMORY_SCOPE_AGENT); unsigned sp = 0;
                while (__hip_atomic_load(cnt2, __ATOMIC_RELAXED, __HIP_MEMORY_SCOPE_AGENT) < 16u) { __builtin_amdgcn_s_sleep(1); if (++sp > (1u << 22)) break; } }
            __syncthreads();
            float tot = __uint_as_float(__hip_atomic_load((const unsigned*)(X2 + (2 * c) * 64 + r), __ATOMIC_RELAXED, __HIP_MEMORY_SCOPE_AGENT))
                      + __uint_as_float(__hip_atomic_load((const unsigned*)(X2 + (2 * c + 1) * 64 + r), __ATOMIC_RELAXED, __HIP_MEMORY_SCOPE_AGENT));
            tot = red8(tot);
            const float r4 = rsqrtf(tot * (1.0f / 1024.0f) + EPS);
            const int col = 64 * ct + 8 * c;
            float* yp = p->out + O_Y + (size_t)row * 1024 + col;
            *(f32x4*)yp = h0 * r4 * *(const f32x4*)(p->in[31] + col); *(f32x4*)(yp + 4) = h1 * r4 * *(const f32x4*)(p->in[31] + col + 4);
        }
    }
}
__device__ __forceinline__ void p4s_issue(unsigned char* ws, int rt, int s96, Frags<4>& F, int& arow0, int& jc0) {
    const int pn = s96 >> 2, s = s96 & 3, nb = 256 * pn + 32 * s;
    arow0 = NP + 64 * rt; jc0 = 128 * pn + 32 * s;
    const TileP T = st_tile((const bf16_t*)(ws + OFF_R3), 1024, arow0, (const bf16_t*)(ws + OFF_WUP), 1024, nb, nb + 16, nb + 128, nb + 144, 1024);
    st_load(F, T, 0);
}
__device__ __forceinline__ void pe_small(KP p, LAS unsigned char* lds) {
    unsigned char* ws = p->ws;
    ST_IDX(16) {
        const int arow0 = NP + 64 * rt;
        const TileP T = st_tile((const bf16_t*)(ws + OFF_PB), 256, arow0, (const bf16_t*)(ws + OFF_WPLE), 256, 64 * ct, 64 * ct + 16, 64 * ct + 32, 64 * ct + 48, 256);
        Frags<1> F; st_load(F, T, 0);
        f32x4 acc[4][4]; st_zero(acc); st_mma(acc, F);
        f32x4 lo0, lo1, hi0, hi1; st_reduce(lds, acc, lo0, lo1, hi0, hi1);
        *(u32x4*)((bf16_t*)(ws + OFF_E) + (size_t)(arow0 + r) * 1024 + 64 * ct + 8 * c) = pack8(lo0 + hi0, lo1 + hi1);
    }
}
__device__ __forceinline__ void p4_small(KP p, LAS unsigned char* lds, int mode = 0) {
    unsigned char* ws = p->ws; const int r = threadIdx.x >> 3, c = threadIdx.x & 7;
    const float* cw = p->in[25]; const float* cb = p->in[26]; const float* st = p->in[6];
    int it = 0, rt, ct; if (!st_map(0, 96, rt, ct)) return;
    Frags<4> F; int arow0, jc0; p4s_issue(ws, rt, ct, F, arow0, jc0);
    for (;;) {
        const int row = arow0 + r;
        const float rs = rsqrtf(sum16((const float*)(ws + OFF_SSQ1) + (size_t)row * 16) * (1.0f / 1024.0f) + EPS);
        f32x4 acc[4][4]; st_zero(acc); st_mma(acc, F);
        const bool more = st_map(it + 1, 96, rt, ct);
        int narow0 = 0, njc0 = 0; if (more) p4s_issue(ws, rt, ct, F, narow0, njc0);
        f32x4 lo0, lo1, hi0, hi1;
        if (mode == 2) { lo0 = acc[0][0]; lo1 = acc[0][1]; hi0 = acc[1][0]; hi1 = acc[1][1]; } else st_reduce(lds, acc, lo0, lo1, hi0, hi1);
        if (mode == 1) { asm volatile("" :: "v"(lo0[0] + lo1[0] + hi0[0] + hi1[0])); } else {
            LAS float* U = (LAS float*)lds;
            *(LAS f32x4*)(U + r * 68 + 8 * c) = (lo0 + hi0) * rs; *(LAS f32x4*)(U + r * 68 + 8 * c + 4) = (lo1 + hi1) * rs;
            __syncthreads();
            {   const int jc = jc0 + 4 * c, t = r & 3, q = (row - NP) >> 2;
                const f32x4 cg = *(LAS const f32x4*)(U + r * 68 + 4 * c), cv = *(LAS const f32x4*)(U + r * 68 + 32 + 4 * c);
                f32x4 x1g, x1v, x2g, x2v;
                if (t >= 1) { x1g = *(LAS const f32x4*)(U + (r - 1) * 68 + 4 * c); x1v = *(LAS const f32x4*)(U + (r - 1) * 68 + 32 + 4 * c); }
                else { x1g = *(const f32x4*)(st + (size_t)(q * 2 + 1) * 6144 + jc); x1v = *(const f32x4*)(st + (size_t)(q * 2 + 1) * 6144 + 3072 + jc); }
                if (t >= 2) { x2g = *(LAS const f32x4*)(U + (r - 2) * 68 + 4 * c); x2v = *(LAS const f32x4*)(U + (r - 2) * 68 + 32 + 4 * c); }
                else { x2g = *(const f32x4*)(st + (size_t)(q * 2 + t) * 6144 + jc); x2v = *(const f32x4*)(st + (size_t)(q * 2 + t) * 6144 + 3072 + jc); }
                const f32x4 og = *(const f32x4*)(cb + jc) + *(const f32x4*)(cw + jc) * x2g + *(const f32x4*)(cw + 6144 + jc) * x1g + *(const f32x4*)(cw + 12288 + jc) * cg;
                const f32x4 ov = *(const f32x4*)(cb + 3072 + jc) + *(const f32x4*)(cw + 3072 + jc) * x2v + *(const f32x4*)(cw + 6144 + 3072 + jc) * x1v + *(const f32x4*)(cw + 12288 + 3072 + jc) * cv;
                const float a0 = gelu_t(og[0]) * ov[0], a1 = gelu_t(og[1]) * ov[1], a2 = gelu_t(og[2]) * ov[2], a3 = gelu_t(og[3]) * ov[3];
                *(u32x2*)((bf16_t*)(ws + OFF_ACT) + (size_t)row * 3072 + jc) = (u32x2){cvt_pk_bf16(a0, a1), cvt_pk_bf16(a2, a3)};
                if (t >= 2) { float* op = p->out + O_FS + (size_t)(q * 2 + t - 2) * 6144 + jc; *(f32x4*)op = cg; *(f32x4*)(op + 3072) = cv; }
            }
            __syncthreads();
        }
        if (!more) break;
        arow0 = narow0; jc0 = njc0; ++it;
    }
}
#ifndef GP1_ALIGN
#define GP1_ALIGN true
#endif
#ifndef GP1_SP2
#define GP1_SP2 true
#endif
#ifndef GP3_ALIGN
#define GP3_ALIGN false
#endif
#ifndef GP3_SP2
#define GP3_SP2 true
#endif
#ifndef GP4_ALIGN
#define GP4_ALIGN true
#endif
#ifndef GP4_SP2
#define GP4_SP2 true
#endif
#ifndef GP5_ALIGN
#define GP5_ALIGN false
#endif
#ifndef GP5_SP2
#define GP5_SP2 true
#endif
#ifndef GPE_ALIGN
#define GPE_ALIGN false
#endif
#ifndef GPE_SP2
#define GPE_SP2 true
#endif
#ifndef GP6_ALIGN
#define GP6_ALIGN false
#endif
#ifndef GP6_SP2
#define GP6_SP2 true
#endif
#ifndef REP
#define REP 0
#endif
#if REP
__device__ __forceinline__ int rep_count(int bit) { int n = ((REP >> bit) & 1) ? 2 : 1; asm volatile("" : "+s"(n)); return n; }
#define REPEAT(bit) for (int nrep_ = rep_count(bit), rep_ = 0; rep_ < nrep_; ++rep_)
#else
#define REPEAT(bit)
#endif
template <class S> __device__ __forceinline__ void fill_tab_rstd(LAS float* tab, const S& sched, const float* ssq, float invn) {
    Unit u; const int r = threadIdx.x & 255;
    for (int i = threadIdx.x >> 8; sched.next(i, u); i += 2) {
        const float* sp = ssq + (size_t)(u.pm * 256 + r) * 16;
        tab[i * 256 + r] = rsqrtf(sum16(sp) * invn + EPS); }
    __syncthreads();
}

__global__ void __launch_bounds__(512) mega(Params p_) {
    KP p = (KP)__builtin_amdgcn_kernarg_segment_ptr();
#define FRESH_P() asm volatile("" : "+s"(p))
    extern __shared__ __attribute__((aligned(16))) unsigned char lds_raw[];
    LAS unsigned char* lds = (LAS unsigned char*)lds_raw;
    const int tid = threadIdx.x, G = gridDim.x, blk = blockIdx.x;
    volatile LAS unsigned* st = (volatile LAS unsigned*)(lds + LDS_X);
    if (tid < 4) st[tid] = 0u;
    __syncthreads();
    unsigned char* ws = p->ws;
    XcdBarrier bar = xcd_barrier_post((unsigned*)(ws + OFF_BAR), st);
    LAS float* tab = (LAS float*)(lds + LDS_X + 256);
#define GRID_BAR() do { if (p_.use_cg) cg::this_grid().sync(); else xcd_barrier(bar); } while (0)

    REPEAT(0) { p0_phase(p, lds); __syncthreads(); }
    GRID_BAR();
    FRESH_P(); ws = p->ws;
    {   pg8::Gemm g{(const bf16_t*)(ws + OFF_XB), (const bf16_t*)(ws + OFF_WIN), NP, 2048, 1024};
        pg8::StaticOrder S; S.init(NP, 2048, G, blk);
        EpiZ E{(bf16_t*)(ws + OFF_Z), (const float*)(ws + OFF_RSTD1), (float*)(ws + OFF_LNSTAT)};
        pg8::gemm_phase<EpiZ, pg8::StaticOrder, GP1_ALIGN, GP1_SP2>(lds, g, S, E);
        p1_small(p, lds);
    }
    GRID_BAR();
    FRESH_P(); ws = p->ws;
#if REP & 4
    { int lo = (PMODE == 1) ? 0 : 1056, hi = (PMODE == 1) ? 1024 : 1568; int sk = PSKIP; asm volatile("" : "+s"(lo), "+s"(hi), "+s"(sk)); p2_phase(p, lds, lo, hi, sk); __syncthreads(); }
#endif
    p2_phase(p, lds);
    GRID_BAR();
    FRESH_P(); ws = p->ws;
    {   pg8::StaticOrder S; S.init(NP, 1024, G, blk);
        LAS f32x2* tab2 = (LAS f32x2*)tab;
        {   Unit u; const float* sq = (const float*)(ws + OFF_SSQY);
            for (int i = 0; S.next(i, u); ++i)
                if (tid < 256) { const float* sp = sq + (size_t)(u.pm * 256 + tid) * 16;
                    const float sa = sum4(*(const f32x4*)sp) + sum4(*(const f32x4*)(sp + 4)), sb = sum4(*(const f32x4*)(sp + 8));
                    const float ra = rsqrtf(sa * (1.0f / 512.0f) + EPS), rb = rsqrtf(sb * (1.0f / 512.0f) + EPS);
                    tab2[i * 256 + tid] = (f32x2){ra / rb, rb}; }
            __syncthreads(); }
        pg8::Gemm g{(const bf16_t*)(ws + OFF_Y), (const bf16_t*)(ws + OFF_WOUT), NP, 1024, 1024};
        EpiH1 E{(const bf16_t*)(ws + OFF_XB), (bf16_t*)(ws + OFF_R3), (float*)(ws + OFF_SSQ1), tab2};
        REPEAT(3) { pg8::gemm_phase<EpiH1, pg8::StaticOrder, GP3_ALIGN, GP3_SP2>(lds, g, S, E); }
        p3_small(p, lds);
        p3_extra(p);
    }
    GRID_BAR();
    FRESH_P(); ws = p->ws;
    {   pg8::StaticOrder S; S.init(NP, 6144, G, blk);
        fill_tab_rstd(tab, S, (const float*)(ws + OFF_SSQ1), 1.0f / 1024.0f);
        pg8::Gemm g{(const bf16_t*)(ws + OFF_R3), (const bf16_t*)(ws + OFF_WUP), NP, 6144, 1024};
        EpiUp E{(bf16_t*)(ws + OFF_ACT), tab, p->in[25], p->in[26], (bf16_t*)(ws + OFF_HALO), p->out + O_FP, 0};
        pg8::gemm_phase<EpiUp, pg8::StaticOrder, GP4_ALIGN, GP4_SP2>(lds, g, S, E);
#if REP & 4096
        { int md = PMODE; asm volatile("" : "+s"(md)); p4_small(p, lds, md); }
#endif
        p4_small(p, lds);
    }
    GRID_BAR();
    FRESH_P(); ws = p->ws;
    {   pg8::StaticOrder S; S.init(NP, 1024, G, blk);
        {   Unit u; int last = -1;
            for (int i = 0; S.next(i, u); ++i) if (u.pm != last) { p4b_tile(p, u.pm); last = u.pm; }
            asm volatile("s_waitcnt vmcnt(0)" ::: "memory"); __syncthreads(); }
        pg8::Gemm g{(const bf16_t*)(ws + OFF_ACT), (const bf16_t*)(ws + OFF_WDN), NP, 1024, 3072};
        EpiH2 E{(bf16_t*)(ws + OFF_R3), (float*)(ws + OFF_SSQ2)};
        pg8::gemm_phase<EpiH2, pg8::StaticOrder, GP5_ALIGN, GP5_SP2>(lds, g, S, E);
#if REP & 8192
        { int md = 1; asm volatile("" : "+s"(md)); p5_small(p, lds, md); }
#endif
        p5_small(p, lds);
        pg8::Gemm g2{(const bf16_t*)(ws + OFF_PB), (const bf16_t*)(ws + OFF_WPLE), NP, 1024, 256};
        pg8::StaticOrder S2; S2.init(NP, 1024, G, blk);
        EpiE E2{(bf16_t*)(ws + OFF_E)};
        REPEAT(11) { pg8::gemm_phase<EpiE, pg8::StaticOrder, GPE_ALIGN, GPE_SP2>(lds, g2, S2, E2); }
        pe_small(p, lds);
    }
    GRID_BAR();
    FRESH_P(); ws = p->ws;
    {   pg8::StaticOrder S; S.init(NP, 1024, G, blk);
        fill_tab_rstd(tab, S, (const float*)(ws + OFF_SSQ2), 1.0f / 1024.0f);
        pg8::Gemm g{(const bf16_t*)(ws + OFF_R3), (const bf16_t*)(ws + OFF_WPG), NP, 1024, 1024};
        if (G == 256) {
            EpiGF E{(const bf16_t*)(ws + OFF_R3), (const bf16_t*)(ws + OFF_E), p->out + O_Y, p->in[31], (float*)(ws + OFF_SSQ3), (unsigned*)(ws + OFF_FLAG), tab};
            pg8::gemm_phase<EpiGF, pg8::StaticOrder, false, GP6_SP2>(lds, g, S, E);
        } else {
            EpiG E{(const bf16_t*)(ws + OFF_R3), (const bf16_t*)(ws + OFF_E), (bf16_t*)(ws + OFF_H3), (float*)(ws + OFF_SSQ3), tab};
            pg8::gemm_phase<EpiG, pg8::StaticOrder, GP6_ALIGN, GP6_SP2>(lds, g, S, E);
        }
        p6_small(p, lds, G == 256);
    }
    if (G != 256) {
        GRID_BAR();
        FRESH_P(); ws = p->ws;
        p7_phase(p, 0);
    }
}

extern "C" void kernel_launch(void* const* d_in, const int* in_sizes, int n_in, void* d_out, int out_size, void* d_ws, size_t ws_size, hipStream_t stream) {
    static int grid = 0;
    if (grid == 0) {
        if (n_in != 32 || out_size != (int)O_END || ws_size < WS_END) { fprintf(stderr, "kernel_launch: unexpected shapes (n_in %d out %d ws %zu, need ws %zu)\n", n_in, out_size, ws_size, (size_t)WS_END); grid = -1; return; }
        int dev = 0, cus = 0, per_cu = 0;
        if (hipGetDevice(&dev) != hipSuccess || hipDeviceGetAttribute(&cus, hipDeviceAttributeMultiprocessorCount, dev) != hipSuccess) { grid = -1; return; }
        if (hipFuncSetAttribute((const void*)mega, hipFuncAttributeMaxDynamicSharedMemorySize, LDS_BYTES) != hipSuccess) { fprintf(stderr, "kernel_launch: hipFuncSetAttribute failed\n"); grid = -1; return; }
        if (hipOccupancyMaxActiveBlocksPerMultiprocessor(&per_cu, (const void*)mega, 512, LDS_BYTES) != hipSuccess || per_cu < 1) { fprintf(stderr, "kernel_launch: occupancy query says %d\n", per_cu); (void)hipGetLastError(); grid = -1; return; }
        grid = cus;
    }
    if (grid < 0) return;
    (void)hipMemsetAsync(d_ws, 0, CTL_BYTES, stream);
    Params hp{};
    for (int i = 0; i < 32; ++i) hp.in[i] = (const float*)d_in[i];
    hp.out = (float*)d_out; hp.ws = (unsigned char*)d_ws; hp.use_cg = 0; hp.pad = 0;
    void* args[] = {&hp};
    hipError_t e = hipLaunchCooperativeKernel((const void*)mega, dim3(grid), dim3(512), args, LDS_BYTES, stream);
    if (e != hipSuccess) fprintf(stderr, "kernel_launch: cooperative launch failed: %s (grid %d)\n", hipGetErrorString(e), grid);
}
```

```cpp
#ifndef REP
#define REP 0
#endif
#ifndef PSKIP
#define PSKIP 0
#endif
#ifndef PMODE
#define PMODE 0
#endif
#include <hip/hip_runtime.h>
#include <hip/hip_cooperative_groups.h>
#include <cstdio>
namespace cg = cooperative_groups;
#define LAS __attribute__((address_space(3)))
typedef unsigned short bf16_t;
typedef short bf16x8 __attribute__((ext_vector_type(8)));
typedef float f32x4 __attribute__((ext_vector_type(4)));
typedef float f32x2 __attribute__((ext_vector_type(2)));
typedef unsigned u32x4 __attribute__((ext_vector_type(4)));
typedef unsigned u32x2 __attribute__((ext_vector_type(2)));

constexpr int D = 1024, NP = 16384, NS = 512, NT = 16896, SEQ = 2048, NBP = 8, NBS = 128;
constexpr int WA = 512, DFF = 3072, PLE = 256;
constexpr float EPS = 1e-6f;
constexpr size_t O_Y = 0;
constexpr size_t O_HP = 17301504, O_HS = 17305600, O_CP = 17371136, O_CS = 17383424, O_VS = 17580032, O_FP = 17842176, O_FS = 17940480, O_END = 19513344;
constexpr size_t OFF_BAR = 0, OFF_FLAG = 16384, CTL_BYTES = 32768;
constexpr size_t OFF_WIN = 32768;
constexpr size_t OFF_WOUT = OFF_WIN + (size_t)2048 * 1024 * 2;
constexpr size_t OFF_WUP = OFF_WOUT + (size_t)1024 * 1024 * 2;
constexpr size_t OFF_WDN = OFF_WUP + (size_t)6144 * 1024 * 2;
constexpr size_t OFF_WPG = OFF_WDN + (size_t)1024 * 3072 * 2;
constexpr size_t OFF_WPLE = OFF_WPG + (size_t)1024 * 1024 * 2;
constexpr size_t OFF_WG = OFF_WPLE + (size_t)1024 * 256 * 2;
constexpr size_t OFF_WSGU = OFF_WG + (size_t)8 * 128 * 64 * 2;
constexpr size_t OFF_RSTD1 = OFF_WSGU + (size_t)4 * 128 * 128 * 2;
constexpr size_t OFF_SP = OFF_RSTD1 + 98304;
constexpr size_t OFF_LNSTAT = OFF_RSTD1 + 131072;
constexpr size_t STAT_BYTES = (size_t)NT * 16 * 4;
constexpr size_t OFF_SSQY = OFF_LNSTAT + STAT_BYTES;
constexpr size_t OFF_SSQ1 = OFF_SSQY + STAT_BYTES;
constexpr size_t OFF_SSQ2 = OFF_SSQ1 + STAT_BYTES;
constexpr size_t OFF_SSQ3 = OFF_SSQ2 + STAT_BYTES;
constexpr size_t OFF_AGG = OFF_SSQ3 + STAT_BYTES;
constexpr size_t OFF_HALO = OFF_AGG + (size_t)1024 * 128 * 4;
constexpr size_t OFF_PB = OFF_HALO + (size_t)264 * 4 * 6144 * 4;
constexpr size_t OFF_R1 = OFF_PB + (size_t)NT * 256 * 2;
constexpr size_t OFF_XB = OFF_R1, OFF_Z = OFF_R1 + (size_t)NT * 1024 * 2, OFF_ACT = OFF_R1, OFF_H3 = OFF_R1;
constexpr size_t OFF_R3 = OFF_R1 + (size_t)NT * 3072 * 2;
constexpr size_t OFF_E = OFF_R3 + (size_t)NT * 1024 * 2, OFF_Y = OFF_E;
constexpr size_t WS_END = OFF_E + (size_t)NT * 1024 * 2;

constexpr int LDS_BYTES = 155648, LDS_X = 131072;

struct Params {
    const float* in[32];
    float* out;
    unsigned char* ws;
    int use_cg;
    int pad;
};

typedef const __attribute__((address_space(4))) Params* KP;

__device__ __forceinline__ unsigned cvt_pk_bf16(float lo, float hi) { unsigned r; asm volatile("v_cvt_pk_bf16_f32 %0, %1, %2" : "=v"(r) : "v"(lo), "v"(hi)); return r; }
__device__ __forceinline__ float bflo(unsigned w) { return __uint_as_float(w << 16); }
__device__ __forceinline__ float bfhi(unsigned w) { return __uint_as_float(w & 0xffff0000u); }
__device__ __forceinline__ float bf2f(bf16_t v) { return __uint_as_float((unsigned)v << 16); }
__device__ __forceinline__ float sigmoidf_(float x) { return __builtin_amdgcn_rcpf(1.0f + __builtin_amdgcn_exp2f(-1.4426950409f * x)); }
__device__ __forceinline__ float gelu_t(float x) {
    const float u = x * (-2.3022082f - 0.1029432f * x * x);
    return x * __builtin_amdgcn_rcpf(1.0f + __builtin_amdgcn_exp2f(u));
}
__device__ __forceinline__ f32x2 gelu2(f32x2 x) {
    const f32x2 u = x * ((x * x) * (-0.1029432f) + (-2.3022082f));
    f32x2 e; e.x = __builtin_amdgcn_exp2f(u.x); e.y = __builtin_amdgcn_exp2f(u.y);
    const f32x2 d = e + 1.0f;
    f32x2 r; r.x = __builtin_amdgcn_rcpf(d.x); r.y = __builtin_amdgcn_rcpf(d.y);
    return x * r;
}
__device__ __forceinline__ f32x4 gelu4(f32x4 v) { const f32x2 a = gelu2((f32x2){v[0], v[1]}), b = gelu2((f32x2){v[2], v[3]}); return (f32x4){a.x, a.y, b.x, b.y}; }
__device__ __forceinline__ float wave_sum(float v) {
#pragma unroll
    for (int o = 32; o >= 1; o >>= 1) v += __shfl_xor(v, o);
    return v;
}
template <int CTRL> __device__ __forceinline__ float dppf(float v) { return __int_as_float(__builtin_amdgcn_update_dpp(0, __float_as_int(v), CTRL, 0xf, 0xf, false)); }

#define XB_TMO      128
#define XB_XCNT(j)  (256  + 64 * (j))
#define XB_XSUB(j)  (1280 + 64 * (j))
#define XB_XGEN(j)  (2304 + 64 * (j))
#define XB_TOP      3328
#define XB_TOPGEN   3392
#define XCD_BAR_WORDS 3456
#define XB_SPIN_CAP (1u << 20)
__device__ __forceinline__ unsigned xb_ld(unsigned* p)              { return __hip_atomic_load(p, __ATOMIC_RELAXED, __HIP_MEMORY_SCOPE_AGENT); }
__device__ __forceinline__ unsigned xb_add(unsigned* p, unsigned v) { return __hip_atomic_fetch_add(p, v, __ATOMIC_RELAXED, __HIP_MEMORY_SCOPE_AGENT); }
__device__ __forceinline__ unsigned xb_xcc_id() { return (unsigned)__builtin_amdgcn_s_getreg((3 << 11) | 20) & 0xFu; }
#define XB_SPIN(cond, bar) do { unsigned _sp = 0; while (cond) { __builtin_amdgcn_s_sleep(1); \
    if ((++_sp & 255u) == 0u) { if (xb_ld(&(bar)[XB_TMO])) break; if (_sp > XB_SPIN_CAP) { atomicAdd(&(bar)[XB_TMO], 1u); break; } } } } while (0)
struct XcdBarrier { unsigned* bar; unsigned x; volatile LAS unsigned* st; };
__device__ __forceinline__ XcdBarrier xcd_barrier_post(unsigned* bar, volatile LAS unsigned* st) {
    XcdBarrier b; b.bar = bar; b.x = xb_xcc_id(); b.st = st;
    if (threadIdx.x == 0) (void)xb_add(&bar[XB_XCNT(b.x)], 1u);
    return b;
}
__device__ __forceinline__ void xcd_barrier_complete(unsigned* bar, unsigned x, unsigned& nloc, unsigned& nx) {
    const unsigned G = gridDim.x * gridDim.y * gridDim.z;
    unsigned sum, cnt, mine, sp = 0u;
    for (;;) {
        sum = 0u; cnt = 0u; mine = 0u;
#pragma unroll
        for (unsigned j = 0; j < 16; ++j) { const unsigned c = xb_ld(&bar[XB_XCNT(j)]); sum += c; cnt += (c > 0u) ? 1u : 0u; mine = (j == x) ? c : mine; }
        if (sum == G) break;
        __builtin_amdgcn_s_sleep(1);
        if ((++sp & 255u) == 0u) { if (xb_ld(&bar[XB_TMO])) break; if (sp > XB_SPIN_CAP) { atomicAdd(&bar[XB_TMO], 1u); break; } }
    }
    nloc = mine > 0u ? mine : 1u; nx = cnt > 0u ? cnt : 1u;
}
__device__ __forceinline__ void xcd_barrier(const XcdBarrier& b) {
    asm volatile("s_waitcnt vmcnt(0)" ::: "memory");
    __syncthreads();
    if (threadIdx.x == 0) {
        unsigned* bar = b.bar;
        __builtin_amdgcn_s_waitcnt(0);
        unsigned nloc = b.st[0], nx = b.st[1];
        if (nloc == 0u) { xcd_barrier_complete(bar, b.x, nloc, nx); b.st[0] = nloc; b.st[1] = nx; }
        const unsigned old = xb_add(&bar[XB_XSUB(b.x)], 1u);
        const unsigned gen = old / nloc;
        if (old + 1u == (gen + 1u) * nloc) {
            __builtin_amdgcn_fence(__ATOMIC_RELEASE, "agent");
            asm volatile("s_waitcnt vmcnt(0)" ::: "memory");
            const unsigned og = xb_add(&bar[XB_TOP], 1u);
            const unsigned tg = og / nx;
            if (og + 1u == (tg + 1u) * nx) xb_add(&bar[XB_TOPGEN], 1u);
            else XB_SPIN(xb_ld(&bar[XB_TOPGEN]) == tg, bar);
            __builtin_amdgcn_fence(__ATOMIC_ACQUIRE, "agent");
            xb_add(&bar[XB_XGEN(b.x)], 1u);
            asm volatile("s_waitcnt vmcnt(0)" ::: "memory");
        } else {
            XB_SPIN(xb_ld(&bar[XB_XGEN(b.x)]) == gen, bar);
            __builtin_amdgcn_fence(__ATOMIC_ACQUIRE, "agent");
            asm volatile("s_waitcnt vmcnt(0)" ::: "memory");
        }
    }
    __syncthreads();
}
namespace pg8 {
constexpr int BM = 256, BK = 64, HALF = 128, HTB = HALF * BK * 2, STAGE_BYTES = 8 * HTB, NXCD = 8, WGM = 8;
__device__ __forceinline__ int lds_byte(int r, int c) { const int st = (r >> 4) * 2 + (c >> 5), rr = r & 15, cc = c & 31, ob = rr * 64 + cc * 2; return st * 1024 + (ob ^ (((ob >> 9) & 1) << 5)); }
__device__ __forceinline__ void stage_rc(int b, int& R, int& C) { const int st = b / 1024, sb = b % 1024, swz = sb ^ (((sb >> 9) & 1) << 5); R = (st >> 1) * 16 + swz / 64; C = (st & 1) * 32 + (swz % 64) / 2; }
__device__ __forceinline__ int perm32(int rho) { const int n = rho >> 4, i = rho & 15; return 8 * (i >> 2) + 4 * n + (i & 3); }
struct Unit { int pm, pn; };
struct Gemm { const bf16_t* A; const bf16_t* Bt; int M, N, K; };
struct StaticOrder {
    int nM, nN, nwg, G, c;
    __device__ void init(int M, int N, int G_, int c_) { nM = M / BM; nN = N / BM; nwg = nM * nN; G = G_; c = c_; }
    __device__ bool next(int i, Unit& u) const {
        const long L = (long)i * G + c; if (L >= nwg) return false;
        int wgid = (int)L; { const int q = nwg / NXCD, r = nwg % NXCD, xcd = wgid % NXCD, off = wgid / NXCD; wgid = (xcd < r ? xcd * (q + 1) : r * (q + 1) + (xcd - r) * q) + off; }
        const int nig = WGM * nN, gid = wgid / nig, fm = gid * WGM, gsz = (nM - fm) < WGM ? (nM - fm) : WGM;
        u.pm = fm + ((wgid % nig) % gsz); u.pn = (wgid % nig) / gsz; return true;
    }
};

template <class Epi, class Sched, bool ALIGN_EPI = false, bool SP2 = false>
__device__ __forceinline__ void gemm_phase(LAS unsigned char* lds, const Gemm g, const Sched& S, const Epi& E) {
    int tid_ = threadIdx.x; asm volatile("" : "+v"(tid_));
    const int tid = tid_, wid = __builtin_amdgcn_readfirstlane(tid >> 6), lane = tid & 63, wr = wid >> 2, wc = wid & 3, fr = lane & 15, fq = lane >> 4;
    const int K = g.K, nt = K / BK;
    unsigned voffA[2], voffB[2];
#pragma unroll
    for (int i = 0; i < 2; ++i) { int R, C; stage_rc(tid * 16 + i * 8192, R, C); const int Rb = Epi::PERM ? ((R & ~31) + perm32(R & 31)) : R;
        const int Ra = Epi::APERM ? ((R & 64) + 4 * (R & 15) + ((R >> 4) & 3)) : R;
        voffA[i] = (unsigned)(Ra * K + C) * 2u; voffB[i] = (unsigned)(Rb * K + C) * 2u; }
    const size_t kstep = (size_t)(BK * 2);
    const size_t hstep = (size_t)HALF * K * 2;
    const size_t tstep = 2 * hstep;
    const unsigned ldsw = (unsigned)wid * 1024u;
    const int aoff = lds_byte(wr * 64 + fr, fq * 8), boff = lds_byte(wc * 32 + fr, fq * 8);
#define PG8_SA(b, h) (((b) * 2 + (h)) * HTB)
#define PG8_SB(b, h) ((4 + (b) * 2 + (h)) * HTB)
#define PG8_STAGE(bufoff, gbase, voff) do { _Pragma("unroll") for (int _i = 0; _i < 2; ++_i) \
        __builtin_amdgcn_global_load_lds((const unsigned*)((const char*)(gbase) + (voff)[_i]), (LAS unsigned*)(lds + (bufoff) + ldsw + _i * 8192), 16, 0, 0); } while (0)
#define PG8_LDA(dst, b, h) do { _Pragma("unroll") for (int m = 0; m < 4; ++m) _Pragma("unroll") for (int k = 0; k < 2; ++k) dst[m][k] = *(const LAS bf16x8*)(lds + PG8_SA(b, h) + aoff + m * 2048 + k * 1024); } while (0)
#define PG8_LDB(dst, b, h) do { _Pragma("unroll") for (int n = 0; n < 2; ++n) _Pragma("unroll") for (int k = 0; k < 2; ++k) dst[n][k] = *(const LAS bf16x8*)(lds + PG8_SB(b, h) + boff + n * 2048 + k * 1024); } while (0)
#define PG8_MMA(ai, bj, At, Bt) do { __builtin_amdgcn_s_setprio(1); _Pragma("unroll") for (int m = 0; m < 4; ++m) _Pragma("unroll") for (int n = 0; n < 2; ++n) _Pragma("unroll") for (int k = 0; k < 2; ++k) \
        acc[ai][bj][m][n] = __builtin_amdgcn_mfma_f32_16x16x32_bf16(Bt[n][k], At[m][k], acc[ai][bj][m][n], 0, 0, 0); __builtin_amdgcn_s_setprio(0); } while (0)
#define PG8_WAIT_V(n) asm volatile("s_waitcnt vmcnt(" #n ")" ::: "memory")
#define PG8_WAIT_L(n) asm volatile("s_waitcnt lgkmcnt(" #n ")" ::: "memory")
#define PG8_BAR __builtin_amdgcn_s_barrier()
#define PG8_SCHED __builtin_amdgcn_sched_barrier(0)
    Unit cur, nxt; int ui = 0;
    if (!S.next(0, cur)) return;
    f32x4 acc[2][2][4][2];
#pragma unroll
    for (int a = 0; a < 2; ++a)
#pragma unroll
        for (int b = 0; b < 2; ++b)
#pragma unroll
            for (int m = 0; m < 4; ++m)
#pragma unroll
                for (int n = 0; n < 2; ++n) acc[a][b][m][n] = (f32x4){0.f, 0.f, 0.f, 0.f};
    bf16x8 At[4][2], B0[2][2], B1[2][2];
    const char* cA = (const char*)g.A + (size_t)cur.pm * tstep; const char* cB = (const char*)g.Bt + (size_t)cur.pn * tstep;
    if constexpr (SP2) {
        PG8_STAGE(PG8_SB(0, 0), cB, voffB); PG8_STAGE(PG8_SB(0, 1), cB + hstep, voffB); PG8_STAGE(PG8_SA(0, 0), cA, voffA); PG8_STAGE(PG8_SA(0, 1), cA + hstep, voffA);
        if (wr == 1) PG8_BAR;
        PG8_WAIT_V(2); PG8_BAR;
        PG8_STAGE(PG8_SB(1, 0), cB + kstep, voffB); PG8_STAGE(PG8_SA(1, 0), cA + kstep, voffA); PG8_STAGE(PG8_SB(1, 1), cB + hstep + kstep, voffB);
        PG8_WAIT_V(6); PG8_BAR;
    } else {
        PG8_STAGE(PG8_SB(0, 0), cB, voffB); PG8_STAGE(PG8_SA(0, 0), cA, voffA); PG8_STAGE(PG8_SB(0, 1), cB + hstep, voffB); PG8_STAGE(PG8_SA(0, 1), cA + hstep, voffA);
        if (wr == 1) PG8_BAR;
        PG8_WAIT_V(4); PG8_BAR;
        PG8_STAGE(PG8_SB(1, 0), cB + kstep, voffB); PG8_STAGE(PG8_SA(1, 0), cA + kstep, voffA); PG8_STAGE(PG8_SB(1, 1), cB + hstep + kstep, voffB);
        PG8_WAIT_V(6); PG8_BAR;
    }
    for (;;) {
        const bool has_next = S.next(ui + 1, nxt);
        const char* nA = has_next ? (const char*)g.A + (size_t)nxt.pm * tstep : cA; const char* nB = has_next ? (const char*)g.Bt + (size_t)nxt.pn * tstep : cB;
        for (int t = 0; t < nt; t += 2) {
            const bool last = (t == nt - 2);
            const char* a1 = cA + (size_t)(t + 1) * kstep;
            const char* a2 = last ? nA : cA + (size_t)(t + 2) * kstep; const char* b2 = last ? nB : cB + (size_t)(t + 2) * kstep;
            const char* a3 = a2 + kstep; const char* b3 = b2 + kstep;
            if constexpr (Epi::HAS_MID) { if (t == (nt >> 1)) E.mid(acc, cur, ui, wr, fr); }
            if constexpr (SP2) {
            PG8_LDB(B0, 0, 0); PG8_LDB(B1, 0, 1); PG8_SCHED; PG8_LDA(At, 0, 0); PG8_STAGE(PG8_SA(1, 1), a1 + hstep, voffA);
            PG8_WAIT_V(8); PG8_WAIT_L(0); PG8_BAR; PG8_MMA(0, 0, At, B0); PG8_MMA(0, 1, At, B1); PG8_BAR; PG8_SCHED;
            PG8_LDA(At, 0, 1); PG8_STAGE(PG8_SB(0, 0), b2, voffB); PG8_STAGE(PG8_SB(0, 1), b2 + hstep, voffB); PG8_STAGE(PG8_SA(0, 0), a2, voffA);
            PG8_WAIT_V(8); PG8_WAIT_L(0); PG8_BAR; PG8_MMA(1, 0, At, B0); PG8_MMA(1, 1, At, B1); PG8_BAR; PG8_SCHED;
            PG8_LDB(B0, 1, 0); PG8_LDB(B1, 1, 1); PG8_SCHED; PG8_LDA(At, 1, 0); PG8_STAGE(PG8_SA(0, 1), a2 + hstep, voffA);
            PG8_WAIT_V(8); PG8_WAIT_L(0); PG8_BAR; PG8_MMA(0, 0, At, B0); PG8_MMA(0, 1, At, B1); PG8_BAR; PG8_SCHED;
            PG8_LDA(At, 1, 1); PG8_STAGE(PG8_SB(1, 0), b3, voffB); PG8_STAGE(PG8_SB(1, 1), b3 + hstep, voffB); PG8_STAGE(PG8_SA(1, 0), a3, voffA);
            PG8_WAIT_V(8); PG8_WAIT_L(0); PG8_BAR; PG8_MMA(1, 0, At, B0); PG8_MMA(1, 1, At, B1); PG8_BAR; PG8_SCHED;
            } else {
            PG8_LDB(B0, 0, 0); PG8_SCHED; PG8_LDA(At, 0, 0); PG8_STAGE(PG8_SA(1, 1), a1 + hstep, voffA);
            PG8_WAIT_L(8); PG8_BAR; PG8_WAIT_L(0); PG8_MMA(0, 0, At, B0); PG8_BAR; PG8_SCHED;
            PG8_LDB(B1, 0, 1); PG8_STAGE(PG8_SB(0, 0), b2, voffB);
            PG8_BAR; PG8_WAIT_L(0); PG8_MMA(0, 1, At, B1); PG8_BAR;
            PG8_LDA(At, 0, 1); PG8_STAGE(PG8_SA(0, 0), a2, voffA);
            PG8_BAR; PG8_WAIT_L(0); PG8_MMA(1, 0, At, B0); PG8_BAR; PG8_SCHED;
            PG8_STAGE(PG8_SB(0, 1), b2 + hstep, voffB);
            PG8_WAIT_V(6); PG8_BAR; PG8_MMA(1, 1, At, B1); PG8_BAR;
            PG8_LDB(B0, 1, 0); PG8_SCHED; PG8_LDA(At, 1, 0); PG8_STAGE(PG8_SA(0, 1), a2 + hstep, voffA);
            PG8_WAIT_L(8); PG8_BAR; PG8_WAIT_L(0); PG8_MMA(0, 0, At, B0); PG8_BAR; PG8_SCHED;
            PG8_LDB(B1, 1, 1); PG8_STAGE(PG8_SB(1, 0), b3, voffB);
            PG8_BAR; PG8_WAIT_L(0); PG8_MMA(0, 1, At, B1); PG8_BAR;
            PG8_LDA(At, 1, 1); PG8_STAGE(PG8_SA(1, 0), a3, voffA);
            PG8_BAR; PG8_WAIT_L(0); PG8_MMA(1, 0, At, B0); PG8_BAR; PG8_SCHED;
            PG8_STAGE(PG8_SB(1, 1), b3 + hstep, voffB);
            PG8_WAIT_V(6); PG8_BAR; PG8_MMA(1, 1, At, B1); PG8_BAR;
            }
        }
        if constexpr (ALIGN_EPI) { if (wr == 0) PG8_BAR; }
        if constexpr (!Epi::AFTER_DRAIN) E(acc, cur, ui, wr, wc, fr, fq);
        if (!has_next) break;
#pragma unroll
        for (int a = 0; a < 2; ++a)
#pragma unroll
            for (int b = 0; b < 2; ++b)
#pragma unroll
                for (int m = 0; m < 4; ++m)
#pragma unroll
                    for (int n = 0; n < 2; ++n) acc[a][b][m][n] = (f32x4){0.f, 0.f, 0.f, 0.f};
        cur = nxt; cA = nA; cB = nB; ++ui;
        if constexpr (ALIGN_EPI) { if (wr == 1) PG8_BAR; }
    }
    PG8_WAIT_V(0);
    if constexpr (!ALIGN_EPI) { if (wr == 0) PG8_BAR; }
    PG8_BAR;
    if constexpr (Epi::AFTER_DRAIN) E.fused(acc, cur, ui, wr, wc, fr, fq, lds);
#undef PG8_SA
#undef PG8_SB
#undef PG8_STAGE
#undef PG8_LDA
#undef PG8_LDB
#undef PG8_MMA
#undef PG8_WAIT_V
#undef PG8_WAIT_L
#undef PG8_BAR
#undef PG8_SCHED
}
}
using pg8::Unit;
typedef f32x4 Acc[2][2][4][2];

__device__ __forceinline__ u32x4 pack8(f32x4 a, f32x4 b) { u32x4 w; w.x = cvt_pk_bf16(a[0], a[1]); w.y = cvt_pk_bf16(a[2], a[3]); w.z = cvt_pk_bf16(b[0], b[1]); w.w = cvt_pk_bf16(b[2], b[3]); return w; }
__device__ __forceinline__ void unpack8(u32x4 w, f32x4& a, f32x4& b) { a = (f32x4){bflo(w.x), bfhi(w.x), bflo(w.y), bfhi(w.y)}; b = (f32x4){bflo(w.z), bfhi(w.z), bflo(w.w), bfhi(w.w)}; }
__device__ __forceinline__ float red_fq(float v) { v += __shfl_xor(v, 16); v += __shfl_xor(v, 32); return v; }
__device__ __forceinline__ float red8(float v) { v += __shfl_xor(v, 1); v += __shfl_xor(v, 2); v += __shfl_xor(v, 4); return v; }
__device__ __forceinline__ float sq4(f32x4 a) { return a[0] * a[0] + a[1] * a[1] + a[2] * a[2] + a[3] * a[3]; }
__device__ __forceinline__ float sum4(f32x4 a) { return (a[0] + a[1]) + (a[2] + a[3]); }
__device__ __forceinline__ float sum16(const float* sp) { return (sum4(*(const f32x4*)sp) + sum4(*(const f32x4*)(sp + 4))) + (sum4(*(const f32x4*)(sp + 8)) + sum4(*(const f32x4*)(sp + 12))); }

__device__ __forceinline__ void seg_z(int kind, float rs, f32x4& v0, f32x4& v1, float& s1, float& s2) {
    v0 *= rs; v1 *= rs;
    if (kind != 0) { v0 = gelu4(v0); v1 = gelu4(v1); }
    if (kind == 3) { s1 += sum4(v0) + sum4(v1); s2 += sq4(v0) + sq4(v1); }
}
struct EpiZ {
    static constexpr bool PERM = true, HAS_MID = false, AFTER_DRAIN = false, APERM = false;
    bf16_t* Z; const float* rstd1; float* lnstat;
    __device__ __forceinline__ void operator()(const Acc& acc, const Unit& u, int ui, int wr, int wc, int fr, int fq) const {
        const int row0 = u.pm * 256 + wr * 64 + fr, col0 = u.pn * 256 + wc * 32 + 8 * fq, kind = u.pn >> 1;
#pragma unroll
        for (int ai = 0; ai < 2; ++ai)
#pragma unroll
            for (int m = 0; m < 4; ++m) {
                const int row = row0 + ai * 128 + m * 16; const float rs = rstd1[row];
                float s1 = 0.f, s2 = 0.f;
#pragma unroll
                for (int bj = 0; bj < 2; ++bj) {
                    f32x4 v0 = acc[ai][bj][m][0], v1 = acc[ai][bj][m][1];
                    seg_z(kind, rs, v0, v1, s1, s2);
                    *(u32x4*)(Z + (size_t)row * 2048 + col0 + bj * 128) = pack8(v0, v1);
                }
                if (kind == 3) { s1 = red_fq(s1); s2 = red_fq(s2);
                    if (fq == 0) *(f32x2*)(lnstat + (size_t)row * 16 + (((u.pn - 6) * 4 + wc) * 2)) = (f32x2){s1, s2}; }
            }
    }
};
struct EpiE {
    static constexpr bool PERM = true, HAS_MID = false, AFTER_DRAIN = false, APERM = false;
    bf16_t* O;
    __device__ __forceinline__ void operator()(const Acc& acc, const Unit& u, int ui, int wr, int wc, int fr, int fq) const {
        const int row0 = u.pm * 256 + wr * 64 + fr, col0 = u.pn * 256 + wc * 32 + 8 * fq;
#pragma unroll
        for (int ai = 0; ai < 2; ++ai)
#pragma unroll
            for (int m = 0; m < 4; ++m)
#pragma unroll
                for (int bj = 0; bj < 2; ++bj)
                    *(u32x4*)(O + (size_t)(row0 + ai * 128 + m * 16) * 1024 + col0 + bj * 128) = pack8(acc[ai][bj][m][0], acc[ai][bj][m][1]);
    }
};
struct EpiH1 {
    static constexpr bool PERM = true, HAS_MID = true, AFTER_DRAIN = false, APERM = false;
    const bf16_t* Xb; bf16_t* Hb; float* ssq; const LAS f32x2* tab;
    __device__ __forceinline__ void mid(Acc& acc, const Unit& u, int ui, int wr, int fr) const {
#pragma unroll
        for (int ai = 0; ai < 2; ++ai)
#pragma unroll
            for (int m = 0; m < 4; ++m) { const float r = tab[ui * 256 + ai * 128 + wr * 64 + m * 16 + fr].x;
#pragma unroll
                for (int bj = 0; bj < 2; ++bj)
#pragma unroll
                    for (int n = 0; n < 2; ++n) acc[ai][bj][m][n] *= r; }
    }
    __device__ __forceinline__ void operator()(const Acc& acc, const Unit& u, int ui, int wr, int wc, int fr, int fq) const {
        const int rt0 = wr * 64 + fr, col0 = u.pn * 256 + wc * 32 + 8 * fq;
#pragma unroll
        for (int ai = 0; ai < 2; ++ai)
#pragma unroll
            for (int m = 0; m < 4; ++m) {
                const int rt = rt0 + ai * 128 + m * 16, row = u.pm * 256 + rt; const float rs = tab[ui * 256 + rt].y;
                float ss = 0.f;
#pragma unroll
                for (int bj = 0; bj < 2; ++bj) { const size_t o = (size_t)row * 1024 + col0 + bj * 128;
                    f32x4 x0, x1; unpack8(*(const u32x4*)(Xb + o), x0, x1);
                    const f32x4 h0 = x0 + acc[ai][bj][m][0] * rs, h1 = x1 + acc[ai][bj][m][1] * rs;
                    ss += sq4(h0) + sq4(h1);
                    *(u32x4*)(Hb + o) = pack8(h0, h1); }
                ss = red_fq(ss);
                if (fq == 0) ssq[(size_t)row * 16 + u.pn * 4 + wc] = ss;
            }
    }
};
struct EpiH2 {
    static constexpr bool PERM = true, HAS_MID = false, AFTER_DRAIN = false, APERM = false;
    bf16_t* Hb; float* ssq;
    __device__ __forceinline__ void operator()(const Acc& acc, const Unit& u, int ui, int wr, int wc, int fr, int fq) const {
        const int row0 = u.pm * 256 + wr * 64 + fr, col0 = u.pn * 256 + wc * 32 + 8 * fq;
#pragma unroll
        for (int ai = 0; ai < 2; ++ai)
#pragma unroll
            for (int m = 0; m < 4; ++m) {
                const int row = row0 + ai * 128 + m * 16; float ss = 0.f;
#pragma unroll
                for (int bj = 0; bj < 2; ++bj) { bf16_t* hp = Hb + (size_t)row * 1024 + col0 + bj * 128;
                    f32x4 x0, x1; unpack8(*(const u32x4*)hp, x0, x1);
                    const f32x4 h0 = x0 + acc[ai][bj][m][0], h1 = x1 + acc[ai][bj][m][1];
                    ss += sq4(h0) + sq4(h1);
                    *(u32x4*)hp = pack8(h0, h1); }
                ss = red_fq(ss);
                if (fq == 0) ssq[(size_t)row * 16 + u.pn * 4 + wc] = ss;
            }
    }
};
struct EpiG {
    static constexpr bool PERM = true, HAS_MID = false, AFTER_DRAIN = false, APERM = false;
    const bf16_t* Hb; const bf16_t* E; bf16_t* H3; float* ssq; const LAS float* tab;
    __device__ __forceinline__ void operator()(const Acc& acc, const Unit& u, int ui, int wr, int wc, int fr, int fq) const {
        const int rt0 = wr * 64 + fr, col0 = u.pn * 256 + wc * 32 + 8 * fq;
#pragma unroll
        for (int ai = 0; ai < 2; ++ai)
#pragma unroll
            for (int m = 0; m < 4; ++m) {
                const int rt = rt0 + ai * 128 + m * 16, row = u.pm * 256 + rt; const float rs = tab[ui * 256 + rt]; float ss = 0.f;
#pragma unroll
                for (int bj = 0; bj < 2; ++bj) { const size_t o = (size_t)row * 1024 + col0 + bj * 128;
                    f32x4 e0, e1, x0, x1; unpack8(*(const u32x4*)(E + o), e0, e1); unpack8(*(const u32x4*)(Hb + o), x0, x1);
                    f32x4 g0 = acc[ai][bj][m][0] * rs, g1 = acc[ai][bj][m][1] * rs;
#pragma unroll
                    for (int e = 0; e < 4; ++e) { g0[e] = sigmoidf_(g0[e]); g1[e] = sigmoidf_(g1[e]); }
                    const f32x4 h0 = x0 + e0 * g0, h1 = x1 + e1 * g1;
                    ss += sq4(h0) + sq4(h1);
                    *(u32x4*)(H3 + o) = pack8(h0, h1); }
                ss = red_fq(ss);
                if (fq == 0) ssq[(size_t)row * 16 + u.pn * 4 + wc] = ss;
            }
    }
};
struct EpiGF {
    static constexpr bool PERM = true, HAS_MID = false, AFTER_DRAIN = true, APERM = false;
    const bf16_t* Hb; const bf16_t* E; float* Y; const float* gfin; float* X; unsigned* cnt; const LAS float* tab;
    __device__ __forceinline__ void operator()(const Acc& acc, const Unit& u, int ui, int wr, int wc, int fr, int fq) const {}
    __device__ __forceinline__ void fused(Acc& acc, const Unit& u, int ui, int wr, int wc, int fr, int fq, LAS unsigned char* lds) const {
        const int rt0 = wr * 64 + fr, col0 = u.pn * 256 + wc * 32 + 8 * fq, tid = threadIdx.x;
        LAS float* Pw = (LAS float*)lds;
        LAS float* Rs = (LAS float*)lds + 1024;
#pragma unroll
        for (int ai = 0; ai < 2; ++ai)
#pragma unroll
            for (int m = 0; m < 4; ++m) {
                const int rt = rt0 + ai * 128 + m * 16, row = u.pm * 256 + rt; const float rs = tab[ui * 256 + rt]; float ss = 0.f;
#pragma unroll
                for (int bj = 0; bj < 2; ++bj) { const size_t o = (size_t)row * 1024 + col0 + bj * 128;
                    f32x4 e0, e1, x0, x1; unpack8(*(const u32x4*)(E + o), e0, e1); unpack8(*(const u32x4*)(Hb + o), x0, x1);
                    f32x4 g0 = acc[ai][bj][m][0] * rs, g1 = acc[ai][bj][m][1] * rs;
#pragma unroll
                    for (int e = 0; e < 4; ++e) { g0[e] = sigmoidf_(g0[e]); g1[e] = sigmoidf_(g1[e]); }
                    const f32x4 h0 = x0 + e0 * g0, h1 = x1 + e1 * g1;
                    ss += sq4(h0) + sq4(h1);
                    acc[ai][bj][m][0] = h0; acc[ai][bj][m][1] = h1; }
                ss = red_fq(ss);
                if (fq == 0) Pw[rt * 4 + wc] = ss;
            }
        __syncthreads();
        if (tid < 256) { const f32x4 q = *(const LAS f32x4*)(Pw + tid * 4);
            __hip_atomic_store((unsigned*)(X + ((size_t)u.pm * 4 + u.pn) * 256 + tid), __float_as_uint(sum4(q)), __ATOMIC_RELAXED, __HIP_MEMORY_SCOPE_AGENT); }
        asm volatile("s_waitcnt vmcnt(0)" ::: "memory");
        __syncthreads();
        if (tid == 0) { __hip_atomic_fetch_add(cnt + u.pm * 16, 1u, __ATOMIC_RELAXED, __HIP_MEMORY_SCOPE_AGENT); unsigned sp = 0;
            while (__hip_atomic_load(cnt + u.pm * 16, __ATOMIC_RELAXED, __HIP_MEMORY_SCOPE_AGENT) < 4u) { __builtin_amdgcn_s_sleep(1); if (++sp > (1u << 22)) break; } }
        __syncthreads();
        if (tid < 256) { float s = 0.f;
#pragma unroll
            for (int k = 0; k < 4; ++k) s += __uint_as_float(__hip_atomic_load((const unsigned*)(X + ((size_t)u.pm * 4 + k) * 256 + tid), __ATOMIC_RELAXED, __HIP_MEMORY_SCOPE_AGENT));
            Rs[tid] = rsqrtf(s * (1.0f / 1024.0f) + EPS); }
        __syncthreads();
        f32x4 gv[2][2];
#pragma unroll
        for (int bj = 0; bj < 2; ++bj) { gv[bj][0] = *(const f32x4*)(gfin + col0 + bj * 128); gv[bj][1] = *(const f32x4*)(gfin + col0 + bj * 128 + 4); }
#pragma unroll
        for (int ai = 0; ai < 2; ++ai)
#pragma unroll
            for (int m = 0; m < 4; ++m) {
                const int rt = rt0 + ai * 128 + m * 16, row = u.pm * 256 + rt; const float rs = Rs[rt];
#pragma unroll
                for (int bj = 0; bj < 2; ++bj) { float* yp = Y + (size_t)row * 1024 + col0 + bj * 128;
                    *(f32x4*)yp = acc[ai][bj][m][0] * rs * gv[bj][0]; *(f32x4*)(yp + 4) = acc[ai][bj][m][1] * rs * gv[bj][1]; }
            }
        __syncthreads();
    }
};
template <int C> __device__ __forceinline__ f32x4 dpp4(f32x4 v) { return (f32x4){dppf<C>(v[0]), dppf<C>(v[1]), dppf<C>(v[2]), dppf<C>(v[3])}; }
__device__ __forceinline__ f32x4 sel4(bool c, f32x4 a, f32x4 b) { return c ? a : b; }
template <int C> __device__ __forceinline__ float dppo(float old, float v) { return __int_as_float(__builtin_amdgcn_update_dpp(__float_as_int(old), __float_as_int(v), C, 0xf, 0xf, false)); }
template <int C> __device__ __forceinline__ f32x4 dppo4(f32x4 o, f32x4 v) { return (f32x4){dppo<C>(o[0], v[0]), dppo<C>(o[1], v[1]), dppo<C>(o[2], v[2]), dppo<C>(o[3], v[3])}; }
template <int C> __device__ __forceinline__ float dppz(float v) { return __int_as_float(__builtin_amdgcn_update_dpp(0, __float_as_int(v), C, 0xf, 0xf, true)); }
template <int C> __device__ __forceinline__ f32x4 dppz4(f32x4 v) { return (f32x4){dppz<C>(v[0]), dppz<C>(v[1]), dppz<C>(v[2]), dppz<C>(v[3])}; }
struct EpiUp {
    static constexpr bool PERM = true, HAS_MID = false, AFTER_DRAIN = false, APERM = true;
    bf16_t* ACT; const LAS float* tab; const float* cw; const float* cb; bf16_t* halo; float* ofp; int mode;
    __device__ __forceinline__ void operator()(const Acc& acc, const Unit& u, int ui, int wr, int wc, int fr, int fq) const {
        const int jc0 = u.pn * 128 + wc * 32 + 8 * fq;
        u32x2 held[2][4];
#pragma unroll
        for (int n = 0; n < 2; ++n) {
            const int jc = jc0 + 4 * n;
            const f32x4 w0g = *(const f32x4*)(cw + jc), w1g = *(const f32x4*)(cw + 6144 + jc), w2g = *(const f32x4*)(cw + 12288 + jc), bg = *(const f32x4*)(cb + jc);
            const f32x4 w0v = *(const f32x4*)(cw + 3072 + jc), w1v = *(const f32x4*)(cw + 6144 + 3072 + jc), w2v = *(const f32x4*)(cw + 12288 + 3072 + jc), bv = *(const f32x4*)(cb + 3072 + jc);
#pragma unroll
            for (int ai = 0; ai < 2; ++ai) {
                const int rt0 = ai * 128 + wr * 64 + 4 * fr, row0 = u.pm * 256 + rt0, g = row0 >> 6;
                const f32x4 rs = *(const LAS f32x4*)(tab + ui * 256 + rt0);
                f32x4 cg[4], cv[4];
#pragma unroll
                for (int m = 0; m < 4; ++m) { cg[m] = acc[ai][0][m][n] * rs[m]; cv[m] = acc[ai][1][m][n] * rs[m]; }
                const f32x4 pg3 = dppz4<0x111>(cg[3]), pg2 = dppz4<0x111>(cg[2]), pv3 = dppz4<0x111>(cv[3]), pv2 = dppz4<0x111>(cv[2]);
#pragma unroll
                for (int m = 0; m < 4; ++m) {
                    const f32x4 xg1 = m == 0 ? pg3 : cg[m - 1], xg2 = m == 0 ? pg2 : (m == 1 ? pg3 : cg[m - 2]);
                    const f32x4 xv1 = m == 0 ? pv3 : cv[m - 1], xv2 = m == 0 ? pv2 : (m == 1 ? pv3 : cv[m - 2]);
                    const f32x4 og = bg + w0g * xg2 + w1g * xg1 + w2g * cg[m], ov = bv + w0v * xv2 + w1v * xv1 + w2v * cv[m];
                    const f32x4 av = gelu4(og) * ov;
                    const u32x2 pk = (u32x2){cvt_pk_bf16(av[0], av[1]), cvt_pk_bf16(av[2], av[3])};
                    if (n == 0) held[ai][m] = pk;
                    else if (!(m < 2 && fr == 0)) *(u32x4*)(ACT + (size_t)(row0 + m) * 3072 + jc0) = (u32x4){held[ai][m].x, held[ai][m].y, pk.x, pk.y};
                }
                if (fr == 0) {
#pragma unroll
                    for (int m = 0; m < 2; ++m) { bf16_t* hp = halo + (size_t)(g * 4 + m) * 6144 + jc;
                        *(u32x2*)hp = (u32x2){cvt_pk_bf16(cg[m][0], cg[m][1]), cvt_pk_bf16(cg[m][2], cg[m][3])}; *(u32x2*)(hp + 3072) = (u32x2){cvt_pk_bf16(cv[m][0], cv[m][1]), cvt_pk_bf16(cv[m][2], cv[m][3])}; } }
                if (fr == 15) {
#pragma unroll
                    for (int m = 2; m < 4; ++m) { bf16_t* hp = halo + (size_t)(g * 4 + m) * 6144 + jc;
                        *(u32x2*)hp = (u32x2){cvt_pk_bf16(cg[m][0], cg[m][1]), cvt_pk_bf16(cg[m][2], cg[m][3])}; *(u32x2*)(hp + 3072) = (u32x2){cvt_pk_bf16(cv[m][0], cv[m][1]), cvt_pk_bf16(cv[m][2], cv[m][3])};
                        const int row = row0 + m;
                        if ((row & 2047) >= 2046) { float* op = ofp + (size_t)((row >> 11) * 2 + (row & 2047) - 2046) * 6144 + jc; *(f32x4*)op = cg[m]; *(f32x4*)(op + 3072) = cv[m]; } } }
            }
        }
    }
};

template <int UN> struct Frags { bf16x8 a[UN][4], b[UN][4]; };
struct TileP { const bf16_t* ap; const bf16_t* bp[4]; int lda; };
__device__ __forceinline__ TileP st_tile(const bf16_t* A, int lda, int arow0, const bf16_t* Bt, int ldb, int b0, int b1, int b2, int b3, int K) {
    int tid_ = threadIdx.x; asm volatile("" : "+v"(tid_));
    const int wave = tid_ >> 6, lane = tid_ & 63, fr = lane & 15, fq = lane >> 4, kw = K >> 3;
    TileP t; t.lda = lda; t.ap = A + (size_t)(arow0 + fr) * lda + wave * kw + 8 * fq;
    const bf16_t* bb = Bt + (size_t)fr * ldb + wave * kw + 8 * fq;
    t.bp[0] = bb + (size_t)b0 * ldb; t.bp[1] = bb + (size_t)b1 * ldb; t.bp[2] = bb + (size_t)b2 * ldb; t.bp[3] = bb + (size_t)b3 * ldb;
    return t;
}
template <int UN> __device__ __forceinline__ void st_load(Frags<UN>& F, const TileP& t, int s0) {
#pragma unroll
    for (int s = 0; s < UN; ++s)
#pragma unroll
        for (int i = 0; i < 4; ++i) { F.a[s][i] = *(const bf16x8*)(t.ap + (size_t)(16 * i) * t.lda + (s0 + s) * 32); F.b[s][i] = *(const bf16x8*)(t.bp[i] + (s0 + s) * 32); }
}
template <int UN> __device__ __forceinline__ void st_mma(f32x4 (&acc)[4][4], const Frags<UN>& F) {
#pragma unroll
    for (int s = 0; s < UN; ++s)
#pragma unroll
        for (int i = 0; i < 4; ++i)
#pragma unroll
            for (int j = 0; j < 4; ++j) acc[i][j] = __builtin_amdgcn_mfma_f32_16x16x32_bf16(F.b[s][j], F.a[s][i], acc[i][j], 0, 0, 0);
}
__device__ __forceinline__ void st_zero(f32x4 (&acc)[4][4]) {
#pragma unroll
    for (int i = 0; i < 4; ++i)
#pragma unroll
        for (int j = 0; j < 4; ++j) acc[i][j] = (f32x4){0.f, 0.f, 0.f, 0.f};
}
__device__ __forceinline__ void st_reduce(LAS unsigned char* lds, const f32x4 (&acc)[4][4], f32x4& lo0, f32x4& lo1, f32x4& hi0, f32x4& hi1) {
    int tid_ = threadIdx.x; asm volatile("" : "+v"(tid_));
    const int tid = tid_, wave = tid >> 6, lane = tid & 63, fr = lane & 15, fq = lane >> 4;
    LAS float* P = (LAS float*)lds + wave * 4096;
#pragma unroll
    for (int i = 0; i < 4; ++i)
#pragma unroll
        for (int j = 0; j < 4; ++j) { const int r = 16 * i + fr, ch = (4 * j + fq) ^ fr; *(LAS f32x4*)(P + r * 64 + ch * 4) = acc[i][j]; }
    __syncthreads();
    {   const int r = tid >> 3, c = tid & 7; LAS const float* Q = (LAS const float*)lds + r * 64;
        const int c0 = ((2 * c) ^ (r & 15)) * 4, c1 = ((2 * c + 1) ^ (r & 15)) * 4;
        lo0 = (f32x4){0.f, 0.f, 0.f, 0.f}; lo1 = lo0; hi0 = lo0; hi1 = lo0;
#pragma unroll
        for (int w = 0; w < 4; ++w) { lo0 += *(LAS const f32x4*)(Q + w * 4096 + c0); lo1 += *(LAS const f32x4*)(Q + w * 4096 + c1);
            hi0 += *(LAS const f32x4*)(Q + (w + 4) * 4096 + c0); hi1 += *(LAS const f32x4*)(Q + (w + 4) * 4096 + c1); } }
    __syncthreads();
}
struct XpT { const float* src; const float* scale; bf16_t* dst; };
__device__ __forceinline__ XpT xp_desc(KP p, unsigned char* ws, int tt) {
    const int lane = threadIdx.x & 63, w = threadIdx.x >> 6;
    const float* src; int ldsrc, k0, scol0, lddst, drow0; const float* scale; bf16_t* dst;
    if (tt < 512) { const int kt = tt >> 5, nt = tt & 31; src = p->in[8]; ldsrc = 2048; k0 = kt * 64; scol0 = nt * 64; scale = p->in[7] + k0; dst = (bf16_t*)(ws + OFF_WIN); lddst = 1024; drow0 = nt * 64; }
    else if (tt < 768) { const int t2 = tt - 512, kt = t2 >> 4, nt = t2 & 15; src = p->in[22]; ldsrc = 1024; k0 = kt * 64; scol0 = nt * 64; scale = k0 < 512 ? p->in[16] + k0 : p->in[21] + (k0 - 512); dst = (bf16_t*)(ws + OFF_WOUT); lddst = 1024; drow0 = nt * 64; }
    else if (tt < 2304) { const int t2 = tt - 768, kt = t2 / 96, nt = t2 % 96, n0 = nt * 64; src = p->in[24]; ldsrc = 6144; k0 = kt * 64; scol0 = ((n0 & 255) >> 7) * 3072 + (n0 >> 8) * 128 + (n0 & 127); scale = p->in[23] + k0; dst = (bf16_t*)(ws + OFF_WUP); lddst = 1024; drow0 = n0; }
    else if (tt < 3072) { const int t2 = tt - 2304, kt = t2 >> 4, nt = t2 & 15; src = p->in[27]; ldsrc = 1024; k0 = kt * 64; scol0 = nt * 64; scale = nullptr; dst = (bf16_t*)(ws + OFF_WDN); lddst = 3072; drow0 = nt * 64; }
    else if (tt < 3328) { const int t2 = tt - 3072, kt = t2 >> 4, nt = t2 & 15; src = p->in[29]; ldsrc = 1024; k0 = kt * 64; scol0 = nt * 64; scale = p->in[28] + k0; dst = (bf16_t*)(ws + OFF_WPG); lddst = 1024; drow0 = nt * 64; }
    else { const int t2 = tt - 3328, kt = t2 >> 4, nt = t2 & 15; src = p->in[30]; ldsrc = 1024; k0 = kt * 64; scol0 = nt * 64; scale = nullptr; dst = (bf16_t*)(ws + OFF_WPLE); lddst = 256; drow0 = nt * 64; }
    XpT t; t.src = src + (size_t)(k0 + 8 * w) * ldsrc + scol0 + lane; t.scale = scale ? scale + 8 * w : nullptr; t.dst = dst + (size_t)(drow0 + lane) * lddst + k0 + 8 * w;
    return t;
}
__device__ __forceinline__ int xp_ld(int tt) { return tt < 512 ? 2048 : (tt >= 768 && tt < 2304) ? 6144 : 1024; }
__device__ __forceinline__ void xp_pair(KP p, unsigned char* ws, int tt, int t1, bool two) {
    const XpT A = xp_desc(p, ws, tt), B = xp_desc(p, ws, two ? t1 : tt);
    const int la = xp_ld(tt), lb = xp_ld(two ? t1 : tt);
    float va[8], vb[8];
#pragma unroll
    for (int e = 0; e < 8; ++e) { va[e] = __builtin_nontemporal_load(A.src + (size_t)e * la); vb[e] = __builtin_nontemporal_load(B.src + (size_t)e * lb); }
    if (A.scale) {
#pragma unroll
        for (int e = 0; e < 8; ++e) va[e] *= A.scale[e]; }
    if (B.scale) {
#pragma unroll
        for (int e = 0; e < 8; ++e) vb[e] *= B.scale[e]; }
    *(u32x4*)A.dst = (u32x4){cvt_pk_bf16(va[0], va[1]), cvt_pk_bf16(va[2], va[3]), cvt_pk_bf16(va[4], va[5]), cvt_pk_bf16(va[6], va[7])};
    if (two) *(u32x4*)B.dst = (u32x4){cvt_pk_bf16(vb[0], vb[1]), cvt_pk_bf16(vb[2], vb[3]), cvt_pk_bf16(vb[4], vb[5]), cvt_pk_bf16(vb[6], vb[7])};
}
__device__ __forceinline__ void p0_phase(KP p, LAS unsigned char* lds) {
    const int tid = threadIdx.x, lane = tid & 63, wave = tid >> 6, G = gridDim.x, blk = blockIdx.x;
    unsigned char* ws = p->ws;
    {   bf16_t* Xb = (bf16_t*)(ws + OFF_XB); float* rstd1 = (float*)(ws + OFF_RSTD1);
        for (int r0 = (blk * 8 + wave) * 2; r0 < NT; r0 += G * 16) {
            f32x4 v[2][4]; float ss[2];
#pragma unroll
            for (int h = 0; h < 2; ++h) { const int r = r0 + h; const float* src = r < NP ? p->in[0] + (size_t)r * D : p->in[1] + (size_t)(r - NP) * D;
#pragma unroll
                for (int i = 0; i < 4; ++i) v[h][i] = __builtin_nontemporal_load((const f32x4*)(src + i * 256 + lane * 4)); }
#pragma unroll
            for (int h = 0; h < 2; ++h) { ss[h] = 0.f;
#pragma unroll
                for (int i = 0; i < 4; ++i) ss[h] += sq4(v[h][i]);
                ss[h] = wave_sum(ss[h]);
                if (lane == 0) rstd1[r0 + h] = rsqrtf(ss[h] * (1.0f / 1024.0f) + EPS);
#pragma unroll
                for (int i = 0; i < 4; ++i) *(u32x2*)(Xb + (size_t)(r0 + h) * D + i * 256 + lane * 4) = (u32x2){cvt_pk_bf16(v[h][i][0], v[h][i][1]), cvt_pk_bf16(v[h][i][2], v[h][i][3])}; }
        } }
    {   for (int ti = blk; ti < 768; ti += 2 * G) { const int t1 = ti + G; const bool two = t1 < 768; xp_pair(p, ws, ti, two ? t1 : ti, two); } }
    {   u32x4* ag = (u32x4*)(ws + OFF_AGG); for (int i = blk * 512 + tid; i < 32768; i += G * 512) ag[i] = (u32x4){0u, 0u, 0u, 0u}; }
    {   bf16_t* Wg = (bf16_t*)(ws + OFF_WG); bf16_t* Ws = (bf16_t*)(ws + OFF_WSGU);
        if (blk == 0) ((float*)(ws + OFF_SP))[tid] = log1pf(expf(-p->in[15][tid]));
        for (int idx = blk * 512 + tid; idx < 65536; idx += G * 512) {
            const int hd = idx >> 13, n = (idx >> 6) & 127, k = idx & 63;
            const float v = n < 64 ? p->in[11][(hd * 64 + k) * 64 + n] : p->in[13][(hd * 64 + k) * 64 + (n - 64)];
            Wg[idx] = (bf16_t)(cvt_pk_bf16(v, 0.f) & 0xffffu);
            const int t = (idx >> 7) & 127, s = idx & 127;
            const float w = s <= t ? p->in[19][idx] : 0.f;
            Ws[idx] = (bf16_t)(cvt_pk_bf16(w, 0.f) & 0xffffu);
        } }
}

__device__ __forceinline__ float ald_f(const float* p) { return __uint_as_float(__hip_atomic_load((const unsigned*)p, __ATOMIC_RELAXED, __HIP_MEMORY_SCOPE_AGENT)); }
__device__ __forceinline__ void ast_f(float* p, float v) { __hip_atomic_store((unsigned*)p, __float_as_uint(v), __ATOMIC_RELAXED, __HIP_MEMORY_SCOPE_AGENT); }

__device__ __forceinline__ void p2_taskA(KP p, LAS unsigned char* lds, int task, int skip = 0) {
    int tid_ = threadIdx.x; asm volatile("" : "+v"(tid_));
    const int tid = tid_, lane = tid & 63, wave = tid >> 6;
    unsigned char* ws = p->ws;
    const bool samp = task >= 1024;
    const int hd = task & 7;
    const int c = samp ? 0 : (task >> 6), b = samp ? 0 : ((task >> 3) & 7), sc = samp ? ((task - 1024) >> 3) : 0;
    const int R0 = samp ? NP + sc * 128 : b * 2048 + c * 128;
    const bf16_t* Z = (const bf16_t*)(ws + OFF_Z);
    LAS bf16_t* xcb = (LAS bf16_t*)lds;
    LAS float* aS = (LAS float*)(lds + 18432);
    LAS float* uS = (LAS float*)(lds + 18432 + 34816);
    LAS float* Pseg = (LAS float*)(lds + 88064);
    LAS float* Sseg = Pseg + 512;
    LAS float* hin = Sseg + 512;
    const bf16_t* gap_ = Z + (size_t)(R0 + (tid >> 2)) * 2048 + 512 + hd * 64 + (tid & 3) * 16;
    const u32x4 gaw0 = *(const u32x4*)gap_, gaw1 = *(const u32x4*)(gap_ + 8);
    if (!(skip & 1))
    {   const int t = tid >> 2, cgp = tid & 3, ch0 = hd * 64 + cgp * 16;
        f32x4 xc[4];
#pragma unroll
        for (int i = 0; i < 4; ++i) xc[i] = *(const f32x4*)(p->in[10] + ch0 + 4 * i);
#pragma unroll
        for (int j = 0; j < 4; ++j) {
            f32x4 xv[4] = {{0.f, 0.f, 0.f, 0.f}, {0.f, 0.f, 0.f, 0.f}, {0.f, 0.f, 0.f, 0.f}, {0.f, 0.f, 0.f, 0.f}};
            const bf16_t* src = nullptr; const float* srcf = nullptr;
            if (!samp) { const int pos = c * 128 + t - 3 + j; if (pos >= 0) src = Z + (size_t)(b * 2048 + pos) * 2048 + ch0; }
            else { const int q = sc * 32 + (t >> 2), idx = (t & 3) + j; if (idx < 3) srcf = p->in[5] + ((size_t)q * 3 + idx) * 512 + ch0; else src = Z + (size_t)(NP + 4 * q + idx - 3) * 2048 + ch0; }
            if (src) { const u32x4 w0 = *(const u32x4*)src, w1 = *(const u32x4*)(src + 8); unpack8(w0, xv[0], xv[1]); unpack8(w1, xv[2], xv[3]); }
            else if (srcf) {
#pragma unroll
                for (int i = 0; i < 4; ++i) xv[i] = __builtin_nontemporal_load((const f32x4*)(srcf + 4 * i)); }
#pragma unroll
            for (int i = 0; i < 4; ++i) xc[i] += *(const f32x4*)(p->in[9] + j * 512 + ch0 + 4 * i) * xv[i];
            if (j == 3) {
                float* op = nullptr;
                if (!samp) { if (c == 15 && t >= 125) op = p->out + O_CP + (size_t)(b * 3 + t - 125) * 512 + ch0; }
                else { const int q = sc * 32 + (t >> 2), pos = t & 3; if (pos >= 1) op = p->out + O_CS + (size_t)(q * 3 + pos - 1) * 512 + ch0; }
                if (op) {
#pragma unroll
                    for (int i = 0; i < 4; ++i) *(f32x4*)(op + 4 * i) = xv[i]; }
            }
        }
        *(LAS u32x4*)(xcb + t * 72 + cgp * 16) = pack8(xc[0], xc[1]);
        *(LAS u32x4*)(xcb + t * 72 + cgp * 16 + 8) = pack8(xc[2], xc[3]);
    }
    __syncthreads();
    if (!(skip & 2))
    {   const int fr = lane & 15, fq = lane >> 4;
        bf16x8 af[2];
#pragma unroll
        for (int ks = 0; ks < 2; ++ks) af[ks] = *(const LAS bf16x8*)(xcb + (16 * wave + fr) * 72 + 32 * ks + 8 * fq);
        LAS const bf16_t* WgL = (LAS const bf16_t*)(lds + 98304);
        f32x4 acc[8];
#pragma unroll
        for (int nb = 0; nb < 8; ++nb) { acc[nb] = (f32x4){0.f, 0.f, 0.f, 0.f};
#pragma unroll
            for (int ks = 0; ks < 2; ++ks) { const bf16x8 bb = *(const LAS bf16x8*)(WgL + (16 * nb + fr) * 72 + 32 * ks + 8 * fq);
                acc[nb] = __builtin_amdgcn_mfma_f32_16x16x32_bf16(af[ks], bb, acc[nb], 0, 0, 0); } }
#pragma unroll
        for (int nb = 0; nb < 4; ++nb) {
            const int ch = 16 * nb + fr, chg = hd * 64 + ch;
            const float ba = p->in[12][chg], bx = p->in[14][chg], sp = ((const float*)(ws + OFF_SP))[chg];
#pragma unroll
            for (int j = 0; j < 4; ++j) {
                const int tok = 16 * wave + 4 * fq + j;
                const float rg = sigmoidf_(acc[nb][j] + ba), ig = sigmoidf_(acc[nb + 4][j] + bx);
                const float la = -8.0f * rg * sp;
                const float a = __builtin_amdgcn_exp2f(1.4426950409f * la);
                float mult = __builtin_amdgcn_sqrtf((1.0f - a) * (1.0f + a));
                if (!samp && c == 0 && tok == 0) mult = 1.0f;
                const float xcv = bf2f(xcb[tok * 72 + ch]);
                aS[tok * 68 + ch] = a; uS[tok * 68 + ch] = xcv * ig * mult;
            }
        }
    }
    __syncthreads();
    if (samp) {
        const int ch = lane;
#pragma unroll
        for (int s4 = 0; s4 < 4; ++s4) {
            const int q = sc * 32 + wave * 4 + s4;
            float h = __builtin_nontemporal_load(p->in[4] + (size_t)q * 512 + hd * 64 + ch);
#pragma unroll
            for (int i = 0; i < 4; ++i) { const int tok = 16 * wave + 4 * s4 + i; h = aS[tok * 68 + ch] * h + uS[tok * 68 + ch]; uS[tok * 68 + ch] = h; }
            p->out[O_HS + (size_t)q * 512 + hd * 64 + ch] = h;
        }
        __syncthreads();
    } else {
        {   const int ch = lane; float P = 1.f, S = 0.f;
#pragma unroll
            for (int i = 0; i < 16; ++i) { const int o = (16 * wave + i) * 68 + ch; const float a = aS[o]; S = a * S + uS[o]; P *= a; uS[o] = S; aS[o] = P; }
            Pseg[wave * 64 + ch] = P; Sseg[wave * 64 + ch] = S; }
        __syncthreads();
        if (wave == 0) {
            const int ch = lane;
            float Pc = 1.f, Sc = 0.f;
#pragma unroll
            for (int s = 0; s < 8; ++s) { const float P = Pseg[s * 64 + ch]; Sc = P * Sc + Sseg[s * 64 + ch]; Pc *= P; }
            unsigned long long* AGG = (unsigned long long*)(ws + OFF_AGG);
            if (c < 15 && !(skip & 3)) __hip_atomic_store(AGG + (size_t)task * 64 + ch, ((unsigned long long)__float_as_uint(Sc) << 32) | (unsigned long long)(__float_as_uint(Pc) | 0x80000000u), __ATOMIC_RELAXED, __HIP_MEMORY_SCOPE_AGENT);
            float h = 0.f;
            if (c > 0 && !(skip & 4)) {
                unsigned long long gv[15];
#pragma unroll
                for (int j = 0; j < 15; ++j) gv[j] = 1ull;
                unsigned sp = 0;
                for (;;) {
                    bool miss = false;
#pragma unroll
                    for (int j = 0; j < 15; ++j) if (j < c) { gv[j] = __hip_atomic_load(AGG + (size_t)(j * 64 + b * 8 + hd) * 64 + ch, __ATOMIC_RELAXED, __HIP_MEMORY_SCOPE_AGENT); }
#pragma unroll
                    for (int j = 0; j < 15; ++j) miss |= (gv[j] == 0ull);
                    if (__builtin_amdgcn_ballot_w64(miss) == 0ull) break;
                    __builtin_amdgcn_s_sleep(2); if (++sp > (1u << 20)) break;
                }
#pragma unroll
                for (int j = 0; j < 15; ++j) if (j < c) h = __uint_as_float((unsigned)gv[j] & 0x7fffffffu) * h + __uint_as_float((unsigned)(gv[j] >> 32));
            }
#pragma unroll
            for (int s = 0; s < 8; ++s) { hin[s * 64 + ch] = h; h = Pseg[s * 64 + ch] * h + Sseg[s * 64 + ch]; }
            if (c == 15) p->out[O_HP + (size_t)b * 512 + hd * 64 + ch] = h;
        }
        __syncthreads();
    }
    if (!(skip & 8))
    {   const int t = tid >> 2, part = tid & 3, row = R0 + t;
        f32x4 g[4]; unpack8(gaw0, g[0], g[1]); unpack8(gaw1, g[2], g[3]);
        float ss = 0.f;
#pragma unroll
        for (int i = 0; i < 4; ++i) { f32x4 h = *(const LAS f32x4*)(uS + t * 68 + part * 16 + 4 * i);
            if (!samp) h += *(const LAS f32x4*)(aS + t * 68 + part * 16 + 4 * i) * *(const LAS f32x4*)(hin + (t >> 4) * 64 + part * 16 + 4 * i);
            g[i] *= h; ss += sq4(g[i]); }
        ss += __shfl_xor(ss, 1); ss += __shfl_xor(ss, 2);
        if (part == 0) ((float*)(ws + OFF_SSQY))[(size_t)row * 16 + hd] = ss;
        bf16_t* yp = (bf16_t*)(ws + OFF_Y) + (size_t)row * 1024 + hd * 64 + part * 16;
        *(u32x4*)yp = pack8(g[0], g[1]); *(u32x4*)(yp + 8) = pack8(g[2], g[3]);
    }
    __syncthreads();
}

__device__ __forceinline__ void p2_taskB(KP p, LAS unsigned char* lds, int idx) {
    int tid_ = threadIdx.x; asm volatile("" : "+v"(tid_));
    const int tid = tid_, lane = tid & 63, wave = tid >> 6;
    unsigned char* ws = p->ws;
    const int chunk = idx >> 2, hb = idx & 3, R0 = chunk * 128;
    const bf16_t* Z = (const bf16_t*)(ws + OFF_Z);
    LAS bf16_t* vnT = (LAS bf16_t*)lds;
    {   const int s = tid >> 2, dg = tid & 3;
        float m_, r_;
        {   const float* lp = (const float*)(ws + OFF_LNSTAT) + (size_t)(R0 + s) * 16;
            float s1 = 0.f, s2 = 0.f;
#pragma unroll
            for (int i = 0; i < 4; ++i) { const f32x4 v = *(const f32x4*)(lp + 4 * i); s1 += v[0] + v[2]; s2 += v[1] + v[3]; }
            m_ = s1 * (1.0f / 512.0f); r_ = rsqrtf(s2 * (1.0f / 512.0f) - m_ * m_ + EPS); }
        const bf16_t* gp = Z + (size_t)(R0 + s) * 2048 + 1536 + hb * 128 + dg * 32;
#pragma unroll
        for (int q8 = 0; q8 < 4; ++q8) {
            f32x4 g0, g1; unpack8(*(const u32x4*)(gp + 8 * q8), g0, g1);
            const int d0 = dg * 32 + 8 * q8;
            const f32x4 lg0 = *(const f32x4*)(p->in[17] + hb * 128 + d0), lg1 = *(const f32x4*)(p->in[17] + hb * 128 + d0 + 4);
            const f32x4 lb0 = *(const f32x4*)(p->in[18] + hb * 128 + d0), lb1 = *(const f32x4*)(p->in[18] + hb * 128 + d0 + 4);
            g0 = (g0 - m_) * r_ * lg0 + lb0; g1 = (g1 - m_) * r_ * lg1 + lb1;
#pragma unroll
            for (int e = 0; e < 4; ++e) { vnT[(d0 + e) * 136 + s] = (bf16_t)(cvt_pk_bf16(g0[e], 0.f) & 0xffffu); vnT[(d0 + 4 + e) * 136 + s] = (bf16_t)(cvt_pk_bf16(g1[e], 0.f) & 0xffffu); }
        } }
    __syncthreads();
    {   const int fr = lane & 15, fq = lane >> 4, t = 16 * wave + fr, row = R0 + t;
        const bf16_t* W = (const bf16_t*)(ws + OFF_WSGU) + hb * 16384;
        f32x4 acc[8]; u32x2 gwv[8];
        const float bs = p->in[20][hb * 128 + t];
#pragma unroll
        for (int nb = 0; nb < 8; ++nb) { acc[nb] = (f32x4){0.f, 0.f, 0.f, 0.f}; gwv[nb] = *(const u32x2*)(Z + (size_t)row * 2048 + 1024 + hb * 128 + 16 * nb + 4 * fq); }
        for (int ks = 0; ks <= (wave >> 1); ++ks) {
            const bf16x8 wf = *(const bf16x8*)(W + t * 128 + 32 * ks + 8 * fq);
#pragma unroll
            for (int nb = 0; nb < 8; ++nb) { const bf16x8 vf = *(const LAS bf16x8*)(vnT + (16 * nb + fr) * 136 + 32 * ks + 8 * fq);
                acc[nb] = __builtin_amdgcn_mfma_f32_16x16x32_bf16(vf, wf, acc[nb], 0, 0, 0); } }
        float ss = 0.f;
#pragma unroll
        for (int nb = 0; nb < 8; ++nb) { const int d0 = hb * 128 + 16 * nb + 4 * fq; const u32x2 gw = gwv[nb];
            f32x4 v = (f32x4){bflo(gw.x), bfhi(gw.x), bflo(gw.y), bfhi(gw.y)} * (acc[nb] + bs);
            ss += sq4(v);
            *(u32x2*)((bf16_t*)(ws + OFF_Y) + (size_t)row * 1024 + 512 + d0) = (u32x2){cvt_pk_bf16(v[0], v[1]), cvt_pk_bf16(v[2], v[3])}; }
        ss = red_fq(ss);
        if (fq == 0) ((float*)(ws + OFF_SSQY))[(size_t)row * 16 + 8 + hb] = ss;
    }
    __syncthreads();
}
__device__ __forceinline__ void p2_taskBs(KP p, int q) {
    const int lane = threadIdx.x & 63, hb = lane >> 4;
    unsigned char* ws = p->ws;
    const bf16_t* Z = (const bf16_t*)(ws + OFF_Z);
    const f32x4 lg0 = *(const f32x4*)(p->in[17] + 8 * lane), lg1 = *(const f32x4*)(p->in[17] + 8 * lane + 4), lb0 = *(const f32x4*)(p->in[18] + 8 * lane), lb1 = *(const f32x4*)(p->in[18] + 8 * lane + 4);
    f32x4 vn[4][2];
#pragma unroll
    for (int t = 0; t < 4; ++t) {
        const int row = NP + 4 * q + t;
        const float* lp = (const float*)(ws + OFF_LNSTAT) + (size_t)row * 16;
        float s1 = 0.f, s2 = 0.f;
#pragma unroll
        for (int i = 0; i < 4; ++i) { const f32x4 v = *(const f32x4*)(lp + 4 * i); s1 += v[0] + v[2]; s2 += v[1] + v[3]; }
        const float mean = s1 * (1.0f / 512.0f), var = s2 * (1.0f / 512.0f) - mean * mean, r_ = rsqrtf(var + EPS);
        f32x4 g0, g1; unpack8(*(const u32x4*)(Z + (size_t)row * 2048 + 1536 + 8 * lane), g0, g1);
        vn[t][0] = (g0 - mean) * r_ * lg0 + lb0; vn[t][1] = (g1 - mean) * r_ * lg1 + lb1;
        float* op = p->out + O_VS + (size_t)(q * 4 + t) * 512 + 8 * lane;
        *(f32x4*)op = vn[t][0]; *(f32x4*)(op + 4) = vn[t][1];
    }
#pragma unroll
    for (int t = 0; t < 4; ++t) {
        const int row = NP + 4 * q + t;
        const float bs = p->in[20][hb * 128 + t];
        f32x4 m0 = {bs, bs, bs, bs}, m1 = m0;
#pragma unroll
        for (int s = 0; s <= t; ++s) { const float w = p->in[19][(size_t)(hb * 128 + t) * 128 + s]; m0 += w * vn[s][0]; m1 += w * vn[s][1]; }
        f32x4 g0, g1; unpack8(*(const u32x4*)(Z + (size_t)row * 2048 + 1024 + 8 * lane), g0, g1);
        g0 *= m0; g1 *= m1;
        float ss = sq4(g0) + sq4(g1);
        ss += __shfl_xor(ss, 1); ss += __shfl_xor(ss, 2); ss += __shfl_xor(ss, 4); ss += __shfl_xor(ss, 8);
        if ((lane & 15) == 0) ((float*)(ws + OFF_SSQY))[(size_t)row * 16 + 8 + hb] = ss;
        *(u32x4*)((bf16_t*)(ws + OFF_Y) + (size_t)row * 1024 + 512 + 8 * lane) = pack8(g0, g1);
    }
}
__device__ __forceinline__ void p2_phase(KP p, LAS unsigned char* lds, int lo = 0, int hi = 1584, int skip = 0) {
    int cur_hd = -1;
    for (int task = blockIdx.x; task < 1584; task += gridDim.x) {
        if (task < lo || task >= hi) continue;
        if (task < 1056 && (task & 7) != cur_hd) {
            cur_hd = task & 7;
            const bf16_t* Wg = (const bf16_t*)(p->ws + OFF_WG) + cur_hd * 8192;
            __syncthreads();
            for (int i = threadIdx.x; i < 1024; i += 512) { const int n = i >> 3, k8 = i & 7; *(LAS u32x4*)((LAS bf16_t*)(lds + 98304) + n * 72 + k8 * 8) = *(const u32x4*)(Wg + n * 64 + k8 * 8); }
            __syncthreads();
        }
        if (task < 1056) p2_taskA(p, lds, task, skip);
        else if (task < 1568) p2_taskB(p, lds, task - 1056);
        else p2_taskBs(p, (task - 1568) * 8 + (threadIdx.x >> 6));
    }
    if (lo == 0 && hi == 1584) {
        const int nb = (int)gridDim.x > 64 ? (int)gridDim.x - 32 : (int)gridDim.x, b0 = (int)gridDim.x > 64 ? (int)blockIdx.x - 32 : (int)blockIdx.x;
        if (b0 >= 0) for (int ti = b0; ti < 2304; ti += 2 * nb) { const int t1 = ti + nb; const bool two = t1 < 2304; xp_pair(p, p->ws, 768 + ti, 768 + (two ? t1 : ti), two); }
    }
}


__device__ __forceinline__ void p3_extra(KP p) {
    unsigned char* ws = p->ws; const int tid = threadIdx.x;
    const bool half = gridDim.x == 256; const int e = half ? (int)blockIdx.x - 128 : (int)blockIdx.x, ne = half ? 128 : (int)gridDim.x;
    if (e < 0) return;
    {   bf16_t* Pb = (bf16_t*)(ws + OFF_PB);
        for (size_t i0 = ((size_t)e * 512 + tid) * 4; i0 < (size_t)NT * 256; i0 += (size_t)ne * 512 * 16) {
            f32x4 v[4];
#pragma unroll
            for (int h = 0; h < 4; ++h) { const size_t idx = i0 + (size_t)h * ne * 512 * 4;
                if (idx < (size_t)NT * 256) v[h] = __builtin_nontemporal_load((const f32x4*)(idx < (size_t)NP * 256 ? p->in[2] + idx : p->in[3] + (idx - (size_t)NP * 256))); }
#pragma unroll
            for (int h = 0; h < 4; ++h) { const size_t idx = i0 + (size_t)h * ne * 512 * 4;
                if (idx < (size_t)NT * 256) *(u32x2*)(Pb + idx) = (u32x2){cvt_pk_bf16(v[h][0], v[h][1]), cvt_pk_bf16(v[h][2], v[h][3])}; }
        } }
    for (int ti = e; ti < 320; ti += 2 * ne) { const int t1 = ti + ne; const bool two = t1 < 320; xp_pair(p, ws, 3072 + ti, 3072 + (two ? t1 : ti), two); }
}
__device__ __forceinline__ f32x4 ld_bf4(const bf16_t* q) { const u32x2 w = *(const u32x2*)q; return (f32x4){bflo(w.x), bfhi(w.x), bflo(w.y), bfhi(w.y)}; }
__device__ __forceinline__ void p4b_tile(KP p, int pm) {
    unsigned char* ws = p->ws;
    const bf16_t* halo = (const bf16_t*)(ws + OFF_HALO); bf16_t* ACT = (bf16_t*)(ws + OFF_ACT);
    const float* cw = p->in[25]; const float* cb = p->in[26];
    for (int jj = threadIdx.x; jj < 768; jj += 512) {
        const int j = jj * 4;
        const f32x4 bg = *(const f32x4*)(cb + j), w0g = *(const f32x4*)(cw + j), w1g = *(const f32x4*)(cw + 6144 + j), w2g = *(const f32x4*)(cw + 12288 + j);
        const f32x4 bv = *(const f32x4*)(cb + 3072 + j), w0v = *(const f32x4*)(cw + 3072 + j), w1v = *(const f32x4*)(cw + 6144 + 3072 + j), w2v = *(const f32x4*)(cw + 12288 + 3072 + j);
#pragma unroll
        for (int gl = 0; gl < 4; ++gl) {
            const int g = pm * 4 + gl; const bool first = (g & 31) == 0;
            const f32x4 z4 = {0.f, 0.f, 0.f, 0.f};
            const bf16_t* hb = halo + (size_t)(g * 4) * 6144 + j; const bf16_t* tb = halo + (size_t)((g - 1) * 4 + 2) * 6144 + j;
            const f32x4 h0g = ld_bf4(hb), h1g = ld_bf4(hb + 6144), h0v = ld_bf4(hb + 3072), h1v = ld_bf4(hb + 6144 + 3072);
            const f32x4 t0g = first ? z4 : ld_bf4(tb), t1g = first ? z4 : ld_bf4(tb + 6144), t0v = first ? z4 : ld_bf4(tb + 3072), t1v = first ? z4 : ld_bf4(tb + 6144 + 3072);
            {   const f32x4 og = bg + w0g * t0g + w1g * t1g + w2g * h0g, ov = bv + w0v * t0v + w1v * t1v + w2v * h0v;
                *(u32x2*)(ACT + (size_t)(g * 64) * 3072 + j) = (u32x2){cvt_pk_bf16(gelu_t(og[0]) * ov[0], gelu_t(og[1]) * ov[1]), cvt_pk_bf16(gelu_t(og[2]) * ov[2], gelu_t(og[3]) * ov[3])}; }
            {   const f32x4 og = bg + w0g * t1g + w1g * h0g + w2g * h1g, ov = bv + w0v * t1v + w1v * h0v + w2v * h1v;
                *(u32x2*)(ACT + (size_t)(g * 64 + 1) * 3072 + j) = (u32x2){cvt_pk_bf16(gelu_t(og[0]) * ov[0], gelu_t(og[1]) * ov[1]), cvt_pk_bf16(gelu_t(og[2]) * ov[2], gelu_t(og[3]) * ov[3])}; }
        }
    }
}
__device__ __forceinline__ void p7_phase(KP p, int row_lo) {
    const int lane = threadIdx.x & 63, wave = threadIdx.x >> 6;
    const float* ssq = (const float*)(p->ws + OFF_SSQ3); const bf16_t* H3 = (const bf16_t*)(p->ws + OFF_H3);
    f32x4 gf[4];
#pragma unroll
    for (int i = 0; i < 2; ++i) { gf[2 * i] = *(const f32x4*)(p->in[31] + i * 512 + lane * 8); gf[2 * i + 1] = *(const f32x4*)(p->in[31] + i * 512 + lane * 8 + 4); }
    for (int r = row_lo + blockIdx.x * 8 + wave; r < NT; r += gridDim.x * 8) {
        const float rs = rsqrtf(sum16(ssq + (size_t)r * 16) * (1.0f / 1024.0f) + EPS);
        float* op = p->out + (size_t)r * 1024;
#pragma unroll
        for (int i = 0; i < 2; ++i) { f32x4 a, b; unpack8(*(const u32x4*)(H3 + (size_t)r * 1024 + i * 512 + lane * 8), a, b);
            *(f32x4*)(op + i * 512 + lane * 8) = a * rs * gf[2 * i]; *(f32x4*)(op + i * 512 + lane * 8 + 4) = b * rs * gf[2 * i + 1]; }
    }
}

__device__ __forceinline__ bool st_map(int i, int nct, int& rt, int& ct) {
    const int b = blockIdx.x;
    if (gridDim.x == 256) {
        const int xcd = b & 7, slot = b >> 3, cl = slot >> 3;
        rt = slot & 7;
        if (nct >= 32) { ct = i * 32 + xcd * 4 + cl; return ct < nct; }
        ct = xcd * 2 + cl; return i == 0 && cl < 2;
    }
    const int idx = i * gridDim.x + b; rt = idx & 7; ct = idx >> 3; return ct < nct;
}
#define ST_IDX(nct_) const int r = threadIdx.x >> 3, c = threadIdx.x & 7; (void)r; (void)c; int rt, ct; for (int it_ = 0; st_map(it_, (nct_), rt, ct); ++it_)
__device__ __forceinline__ void p1_small(KP p, LAS unsigned char* lds) {
    unsigned char* ws = p->ws;
    ST_IDX(32) {
        const int arow0 = NP + 64 * rt;
        const TileP T = st_tile((const bf16_t*)(ws + OFF_XB), 1024, arow0, (const bf16_t*)(ws + OFF_WIN), 1024, 64 * ct, 64 * ct + 16, 64 * ct + 32, 64 * ct + 48, 1024);
        Frags<4> F; st_load(F, T, 0);
        const int row = arow0 + r, col = 64 * ct + 8 * c, kind = ct >> 3;
        const float rs = ((const float*)(ws + OFF_RSTD1))[row];
        f32x4 acc[4][4]; st_zero(acc); st_mma(acc, F);
        f32x4 lo0, lo1, hi0, hi1; st_reduce(lds, acc, lo0, lo1, hi0, hi1);
        f32x4 v0 = lo0 + hi0, v1 = lo1 + hi1; float s1 = 0.f, s2 = 0.f;
        seg_z(kind, rs, v0, v1, s1, s2);
        *(u32x4*)((bf16_t*)(ws + OFF_Z) + (size_t)row * 2048 + col) = pack8(v0, v1);
        if (kind == 3) { s1 = red8(s1); s2 = red8(s2); if (c == 0) *(f32x2*)((float*)(ws + OFF_LNSTAT) + (size_t)row * 16 + (ct - 24) * 2) = (f32x2){s1, s2}; }
    }
}
__device__ __forceinline__ void p3_small(KP p, LAS unsigned char* lds) {
    unsigned char* ws = p->ws;
    ST_IDX(16) {
        const int arow0 = NP + 64 * rt;
        const TileP T = st_tile((const bf16_t*)(ws + OFF_Y), 1024, arow0, (const bf16_t*)(ws + OFF_WOUT), 1024, 64 * ct, 64 * ct + 16, 64 * ct + 32, 64 * ct + 48, 1024);
        Frags<4> F; st_load(F, T, 0);
        const int row = arow0 + r; const float* sp = (const float*)(ws + OFF_SSQY) + (size_t)row * 16;
        const f32x4 q0 = *(const f32x4*)sp, q1 = *(const f32x4*)(sp + 4), q2 = *(const f32x4*)(sp + 8);
        const size_t o = (size_t)row * 1024 + 64 * ct + 8 * c;
        const u32x4 xw = *(const u32x4*)((const bf16_t*)(ws + OFF_XB) + o);
        f32x4 acc[4][4]; st_zero(acc); st_mma(acc, F);
        f32x4 lo0, lo1, hi0, hi1; st_reduce(lds, acc, lo0, lo1, hi0, hi1);
        const float ra = rsqrtf((sum4(q0) + sum4(q1)) * (1.0f / 512.0f) + EPS), rb = rsqrtf(sum4(q2) * (1.0f / 512.0f) + EPS);
        f32x4 x0, x1; unpack8(xw, x0, x1);
        const f32x4 h0 = x0 + lo0 * ra + hi0 * rb, h1 = x1 + lo1 * ra + hi1 * rb;
        *(u32x4*)((bf16_t*)(ws + OFF_R3) + o) = pack8(h0, h1);
        const float ss = red8(sq4(h0) + sq4(h1));
        if (c == 0) ((float*)(ws + OFF_SSQ1))[(size_t)row * 16 + ct] = ss;
    }
}
__device__ __forceinline__ void p5_small(KP p, LAS unsigned char* lds, int mode = 0) {
    unsigned char* ws = p->ws;
    int tid_ = threadIdx.x; asm volatile("" : "+v"(tid_));
    const int tid = tid_, wave = tid >> 6, lane = tid & 63, fr = lane & 15, fq = lane >> 4;
    for (int idx = blockIdx.x; idx < 256; idx += gridDim.x) {
        int rt, ct;
        if (gridDim.x == 256) { const int xcd = idx & 7, slot = idx >> 3; rt = slot & 15; ct = xcd * 2 + (slot >> 4); } else { rt = idx & 15; ct = idx >> 4; }
        const int arow0 = NP + 32 * rt;
        const bf16_t* ap = (const bf16_t*)(ws + OFF_ACT) + (size_t)(arow0 + fr) * 3072 + wave * 384 + 8 * fq;
        const bf16_t* bp = (const bf16_t*)(ws + OFF_WDN) + (size_t)(64 * ct + fr) * 3072 + wave * 384 + 8 * fq;
        bf16x8 a0[2][2], b0[2][4], a1[2][2], b1[2][4];
#define P5S_LOAD(A_, B_, s0) do { _Pragma("unroll") for (int s = 0; s < 2; ++s) { _Pragma("unroll") for (int i = 0; i < 2; ++i) A_[s][i] = *(const bf16x8*)(ap + (size_t)(16 * i) * 3072 + ((s0) + s) * 32); \
            _Pragma("unroll") for (int j = 0; j < 4; ++j) B_[s][j] = *(const bf16x8*)(bp + (size_t)(16 * j) * 3072 + ((s0) + s) * 32); } } while (0)
#define P5S_MMA(A_, B_) do { _Pragma("unroll") for (int s = 0; s < 2; ++s) _Pragma("unroll") for (int i = 0; i < 2; ++i) _Pragma("unroll") for (int j = 0; j < 4; ++j) \
            acc[i][j] = __builtin_amdgcn_mfma_f32_16x16x32_bf16(B_[s][j], A_[s][i], acc[i][j], 0, 0, 0); } while (0)
        P5S_LOAD(a0, b0, 0); P5S_LOAD(a1, b1, 2);
        const int r = tid >> 4, c4 = tid & 15, row = arow0 + r;
        bf16_t* hp = (bf16_t*)(ws + OFF_R3) + (size_t)row * 1024 + 64 * ct + 4 * c4;
        const u32x2 xw = *(const u32x2*)hp;
        f32x4 acc[2][4];
#pragma unroll
        for (int i = 0; i < 2; ++i)
#pragma unroll
            for (int j = 0; j < 4; ++j) acc[i][j] = (f32x4){0.f, 0.f, 0.f, 0.f};
#pragma unroll
        for (int s0 = 0; s0 < 12; s0 += 4) { P5S_MMA(a0, b0); if (s0 + 4 < 12) P5S_LOAD(a0, b0, s0 + 4); P5S_MMA(a1, b1); if (s0 + 6 < 12) P5S_LOAD(a1, b1, s0 + 6); }
#undef P5S_LOAD
#undef P5S_MMA
        LAS float* P = (LAS float*)lds + wave * 2048;
#pragma unroll
        for (int i = 0; i < 2; ++i)
#pragma unroll
            for (int j = 0; j < 4; ++j) { const int rr = 16 * i + fr, ch = (4 * j + fq) ^ fr; *(LAS f32x4*)(P + rr * 64 + ch * 4) = acc[i][j]; }
        __syncthreads();
        f32x4 sum = {0.f, 0.f, 0.f, 0.f};
        {   LAS const float* Q = (LAS const float*)lds + r * 64 + ((c4 ^ (r & 15)) * 4);
#pragma unroll
            for (int w = 0; w < 8; ++w) sum += *(LAS const f32x4*)(Q + w * 2048); }
        __syncthreads();
        const f32x4 h = (f32x4){bflo(xw.x), bfhi(xw.x), bflo(xw.y), bfhi(xw.y)} + sum;
        float ss = sq4(h); ss += __shfl_xor(ss, 1); ss += __shfl_xor(ss, 2); ss += __shfl_xor(ss, 4); ss += __shfl_xor(ss, 8);
        if (mode) { asm volatile("" :: "v"(ss), "v"(h[0])); continue; }
        *(u32x2*)hp = (u32x2){cvt_pk_bf16(h[0], h[1]), cvt_pk_bf16(h[2], h[3])};
        if (c4 == 0) ((float*)(ws + OFF_SSQ2))[(size_t)row * 16 + ct] = ss;
    }
}
__device__ __forceinline__ void p6_small(KP p, LAS unsigned char* lds, bool fuse) {
    unsigned char* ws = p->ws;
    ST_IDX(16) {
        const int arow0 = NP + 64 * rt;
        const TileP T = st_tile((const bf16_t*)(ws + OFF_R3), 1024, arow0, (const bf16_t*)(ws + OFF_WPG), 1024, 64 * ct, 64 * ct + 16, 64 * ct + 32, 64 * ct + 48, 1024);
        Frags<4> F; st_load(F, T, 0);
        const int row = arow0 + r; const float* sp = (const float*)(ws + OFF_SSQ2) + (size_t)row * 16;
        const f32x4 q0 = *(const f32x4*)sp, q1 = *(const f32x4*)(sp + 4), q2 = *(const f32x4*)(sp + 8), q3 = *(const f32x4*)(sp + 12);
        const size_t o = (size_t)row * 1024 + 64 * ct + 8 * c;
        const u32x4 ew = *(const u32x4*)((const bf16_t*)(ws + OFF_E) + o), xw = *(const u32x4*)((const bf16_t*)(ws + OFF_R3) + o);
        f32x4 acc[4][4]; st_zero(acc); st_mma(acc, F);
        f32x4 lo0, lo1, hi0, hi1; st_reduce(lds, acc, lo0, lo1, hi0, hi1);
        const float rs = rsqrtf(((sum4(q0) + sum4(q1)) + (sum4(q2) + sum4(q3))) * (1.0f / 1024.0f) + EPS);
        f32x4 e0, e1, x0, x1; unpack8(ew, e0, e1); unpack8(xw, x0, x1);
        f32x4 g0 = (lo0 + hi0) * rs, g1 = (lo1 + hi1) * rs;
#pragma unroll
        for (int e = 0; e < 4; ++e) { g0[e] = sigmoidf_(g0[e]); g1[e] = sigmoidf_(g1[e]); }
        const f32x4 h0 = x0 + e0 * g0, h1 = x1 + e1 * g1;
        const float ss = red8(sq4(h0) + sq4(h1));
        if (!fuse) {
            *(u32x4*)((bf16_t*)(ws + OFF_H3) + o) = pack8(h0, h1);
            if (c == 0) ((float*)(ws + OFF_SSQ3))[(size_t)row * 16 + ct] = ss;
        } else {
            float* X2 = (float*)(ws + OFF_SSQ3) + 65536 + (size_t)rt * 1024;
            unsigned* cnt2 = (unsigned*)(ws + OFF_FLAG) + 1016 + rt;
            if (c == 0) __hip_atomic_store((unsigned*)(X2 + ct * 64 + r), __float_as_uint(ss), __ATOMIC_RELAXED, __HIP_MEMORY_SCOPE_AGENT);
            asm volatile("s_waitcnt vmcnt(0)" ::: "memory");
            __syncthreads();
            if (threadIdx.x == 0) { __hip_atomic_fetch_add(cnt2, 1u, __ATOMIC_RELAXED, __HIP_MEMORY_SCOPE_AGENT); unsigned sp = 0;
                while (__hip_atomic_load(cnt2, __ATOMIC_RELAXED, __HIP_MEMORY_SCOPE_AGENT) < 16u) { __builtin_amdgcn_s_sleep(1); if (++sp > (1u << 22)) break; } }
            __syncthreads();
            float tot = __uint_as_float(__hip_atomic_load((const unsigned*)(X2 + (2 * c) * 64 + r), __ATOMIC_RELAXED, __HIP_MEMORY_SCOPE_AGENT))
                      + __uint_as_float(__hip_atomic_load((const unsigned*)(X2 + (2 * c + 1) * 64 + r), __ATOMIC_RELAXED, __HIP_MEMORY_SCOPE_AGENT));
            tot = red8(tot);
            const float r4 = rsqrtf(tot * (1.0f / 1024.0f) + EPS);
            const int col = 64 * ct + 8 * c;
            float* yp = p->out + O_Y + (size_t)row * 1024 + col;
            *(f32x4*)yp = h0 * r4 * *(const f32x4*)(p->in[31] + col); *(f32x4*)(yp + 4) = h1 * r4 * *(const f32x4*)(p->in[31] + col + 4);
        }
    }
}
__device__ __forceinline__ void p4s_issue(unsigned char* ws, int rt, int s96, Frags<4>& F, int& arow0, int& jc0) {
    const int pn = s96 >> 2, s = s96 & 3, nb = 256 * pn + 32 * s;
    arow0 = NP + 64 * rt; jc0 = 128 * pn + 32 * s;
    const TileP T = st_tile((const bf16_t*)(ws + OFF_R3), 1024, arow0, (const bf16_t*)(ws + OFF_WUP), 1024, nb, nb + 16, nb + 128, nb + 144, 1024);
    st_load(F, T, 0);
}
__device__ __forceinline__ void pe_small(KP p, LAS unsigned char* lds) {
    unsigned char* ws = p->ws;
    ST_IDX(16) {
        const int arow0 = NP + 64 * rt;
        const TileP T = st_tile((const bf16_t*)(ws + OFF_PB), 256, arow0, (const bf16_t*)(ws + OFF_WPLE), 256, 64 * ct, 64 * ct + 16, 64 * ct + 32, 64 * ct + 48, 256);
        Frags<1> F; st_load(F, T, 0);
        f32x4 acc[4][4]; st_zero(acc); st_mma(acc, F);
        f32x4 lo0, lo1, hi0, hi1; st_reduce(lds, acc, lo0, lo1, hi0, hi1);
        *(u32x4*)((bf16_t*)(ws + OFF_E) + (size_t)(arow0 + r) * 1024 + 64 * ct + 8 * c) = pack8(lo0 + hi0, lo1 + hi1);
    }
}
__device__ __forceinline__ void p4_small(KP p, LAS unsigned char* lds, int mode = 0) {
    unsigned char* ws = p->ws; const int r = threadIdx.x >> 3, c = threadIdx.x & 7;
    const float* cw = p->in[25]; const float* cb = p->in[26]; const float* st = p->in[6];
    int it = 0, rt, ct; if (!st_map(0, 96, rt, ct)) return;
    Frags<4> F; int arow0, jc0; p4s_issue(ws, rt, ct, F, arow0, jc0);
    for (;;) {
        const int row = arow0 + r;
        const float rs = rsqrtf(sum16((const float*)(ws + OFF_SSQ1) + (size_t)row * 16) * (1.0f / 1024.0f) + EPS);
        f32x4 acc[4][4]; st_zero(acc); st_mma(acc, F);
        const bool more = st_map(it + 1, 96, rt, ct);
        int narow0 = 0, njc0 = 0; if (more) p4s_issue(ws, rt, ct, F, narow0, njc0);
        f32x4 lo0, lo1, hi0, hi1;
        if (mode == 2) { lo0 = acc[0][0]; lo1 = acc[0][1]; hi0 = acc[1][0]; hi1 = acc[1][1]; } else st_reduce(lds, acc, lo0, lo1, hi0, hi1);
        if (mode == 1) { asm volatile("" :: "v"(lo0[0] + lo1[0] + hi0[0] + hi1[0])); } else {
            LAS float* U = (LAS float*)lds;
            *(LAS f32x4*)(U + r * 68 + 8 * c) = (lo0 + hi0) * rs; *(LAS f32x4*)(U + r * 68 + 8 * c + 4) = (lo1 + hi1) * rs;
            __syncthreads();
            {   const int jc = jc0 + 4 * c, t = r & 3, q = (row - NP) >> 2;
                const f32x4 cg = *(LAS const f32x4*)(U + r * 68 + 4 * c), cv = *(LAS const f32x4*)(U + r * 68 + 32 + 4 * c);
                f32x4 x1g, x1v, x2g, x2v;
                if (t >= 1) { x1g = *(LAS const f32x4*)(U + (r - 1) * 68 + 4 * c); x1v = *(LAS const f32x4*)(U + (r - 1) * 68 + 32 + 4 * c); }
                else { x1g = __builtin_nontemporal_load((const f32x4*)(st + (size_t)(q * 2 + 1) * 6144 + jc)); x1v = __builtin_nontemporal_load((const f32x4*)(st + (size_t)(q * 2 + 1) * 6144 + 3072 + jc)); }
                if (t >= 2) { x2g = *(LAS const f32x4*)(U + (r - 2) * 68 + 4 * c); x2v = *(LAS const f32x4*)(U + (r - 2) * 68 + 32 + 4 * c); }
                else { x2g = __builtin_nontemporal_load((const f32x4*)(st + (size_t)(q * 2 + t) * 6144 + jc)); x2v = __builtin_nontemporal_load((const f32x4*)(st + (size_t)(q * 2 + t) * 6144 + 3072 + jc)); }
                const f32x4 og = *(const f32x4*)(cb + jc) + *(const f32x4*)(cw + jc) * x2g + *(const f32x4*)(cw + 6144 + jc) * x1g + *(const f32x4*)(cw + 12288 + jc) * cg;
                const f32x4 ov = *(const f32x4*)(cb + 3072 + jc) + *(const f32x4*)(cw + 3072 + jc) * x2v + *(const f32x4*)(cw + 6144 + 3072 + jc) * x1v + *(const f32x4*)(cw + 12288 + 3072 + jc) * cv;
                const float a0 = gelu_t(og[0]) * ov[0], a1 = gelu_t(og[1]) * ov[1], a2 = gelu_t(og[2]) * ov[2], a3 = gelu_t(og[3]) * ov[3];
                *(u32x2*)((bf16_t*)(ws + OFF_ACT) + (size_t)row * 3072 + jc) = (u32x2){cvt_pk_bf16(a0, a1), cvt_pk_bf16(a2, a3)};
                if (t >= 2) { float* op = p->out + O_FS + (size_t)(q * 2 + t - 2) * 6144 + jc; *(f32x4*)op = cg; *(f32x4*)(op + 3072) = cv; }
            }
            __syncthreads();
        }
        if (!more) break;
        arow0 = narow0; jc0 = njc0; ++it;
    }
}
#ifndef GP1_ALIGN
#define GP1_ALIGN true
#endif
#ifndef GP1_SP2
#define GP1_SP2 true
#endif
#ifndef GP3_ALIGN
#define GP3_ALIGN false
#endif
#ifndef GP3_SP2
#define GP3_SP2 true
#endif
#ifndef GP4_ALIGN
#define GP4_ALIGN true
#endif
#ifndef GP4_SP2
#define GP4_SP2 true
#endif
#ifndef GP5_ALIGN
#define GP5_ALIGN false
#endif
#ifndef GP5_SP2
#define GP5_SP2 true
#endif
#ifndef GPE_ALIGN
#define GPE_ALIGN false
#endif
#ifndef GPE_SP2
#define GPE_SP2 true
#endif
#ifndef GP6_ALIGN
#define GP6_ALIGN false
#endif
#ifndef GP6_SP2
#define GP6_SP2 true
#endif
#ifndef REP
#define REP 0
#endif
#if REP
__device__ __forceinline__ int rep_count(int bit) { int n = ((REP >> bit) & 1) ? 2 : 1; asm volatile("" : "+s"(n)); return n; }
#define REPEAT(bit) for (int nrep_ = rep_count(bit), rep_ = 0; rep_ < nrep_; ++rep_)
#else
#define REPEAT(bit)
#endif
template <class S> __device__ __forceinline__ void fill_tab_rstd(LAS float* tab, const S& sched, const float* ssq, float invn) {
    Unit u; const int r = threadIdx.x & 255;
    for (int i = threadIdx.x >> 8; sched.next(i, u); i += 2) {
        const float* sp = ssq + (size_t)(u.pm * 256 + r) * 16;
        tab[i * 256 + r] = rsqrtf(sum16(sp) * invn + EPS); }
    __syncthreads();
}

__global__ void __launch_bounds__(512) mega(Params p_) {
    KP p = (KP)__builtin_amdgcn_kernarg_segment_ptr();
#define FRESH_P() asm volatile("" : "+s"(p))
    extern __shared__ __attribute__((aligned(16))) unsigned char lds_raw[];
    LAS unsigned char* lds = (LAS unsigned char*)lds_raw;
    const int tid = threadIdx.x, G = gridDim.x, blk = blockIdx.x;
    volatile LAS unsigned* st = (volatile LAS unsigned*)(lds + LDS_X);
    if (tid < 4) st[tid] = 0u;
    __syncthreads();
    unsigned char* ws = p->ws;
    XcdBarrier bar = xcd_barrier_post((unsigned*)(ws + OFF_BAR), st);
    LAS float* tab = (LAS float*)(lds + LDS_X + 256);
#define GRID_BAR() do { if (p_.use_cg) cg::this_grid().sync(); else xcd_barrier(bar); } while (0)

    REPEAT(0) { p0_phase(p, lds); __syncthreads(); }
    GRID_BAR();
    FRESH_P(); ws = p->ws;
    {   pg8::Gemm g{(const bf16_t*)(ws + OFF_XB), (const bf16_t*)(ws + OFF_WIN), NP, 2048, 1024};
        pg8::StaticOrder S; S.init(NP, 2048, G, blk);
        EpiZ E{(bf16_t*)(ws + OFF_Z), (const float*)(ws + OFF_RSTD1), (float*)(ws + OFF_LNSTAT)};
        pg8::gemm_phase<EpiZ, pg8::StaticOrder, GP1_ALIGN, GP1_SP2>(lds, g, S, E);
        p1_small(p, lds);
    }
    GRID_BAR();
    FRESH_P(); ws = p->ws;
#if REP & 4
    { int lo = (PMODE == 1) ? 0 : 1056, hi = (PMODE == 1) ? 1024 : 1568; int sk = PSKIP; asm volatile("" : "+s"(lo), "+s"(hi), "+s"(sk)); p2_phase(p, lds, lo, hi, sk); __syncthreads(); }
#endif
    p2_phase(p, lds);
    GRID_BAR();
    FRESH_P(); ws = p->ws;
    {   pg8::StaticOrder S; S.init(NP, 1024, G, blk);
        LAS f32x2* tab2 = (LAS f32x2*)tab;
        {   Unit u; const float* sq = (const float*)(ws + OFF_SSQY);
            for (int i = 0; S.next(i, u); ++i)
                if (tid < 256) { const float* sp = sq + (size_t)(u.pm * 256 + tid) * 16;
                    const float sa = sum4(*(const f32x4*)sp) + sum4(*(const f32x4*)(sp + 4)), sb = sum4(*(const f32x4*)(sp + 8));
                    const float ra = rsqrtf(sa * (1.0f / 512.0f) + EPS), rb = rsqrtf(sb * (1.0f / 512.0f) + EPS);
                    tab2[i * 256 + tid] = (f32x2){ra / rb, rb}; }
            __syncthreads(); }
        pg8::Gemm g{(const bf16_t*)(ws + OFF_Y), (const bf16_t*)(ws + OFF_WOUT), NP, 1024, 1024};
        EpiH1 E{(const bf16_t*)(ws + OFF_XB), (bf16_t*)(ws + OFF_R3), (float*)(ws + OFF_SSQ1), tab2};
        REPEAT(3) { pg8::gemm_phase<EpiH1, pg8::StaticOrder, GP3_ALIGN, GP3_SP2>(lds, g, S, E); }
        p3_small(p, lds);
        p3_extra(p);
    }
    GRID_BAR();
    FRESH_P(); ws = p->ws;
    {   pg8::StaticOrder S; S.init(NP, 6144, G, blk);
        fill_tab_rstd(tab, S, (const float*)(ws + OFF_SSQ1), 1.0f / 1024.0f);
        pg8::Gemm g{(const bf16_t*)(ws + OFF_R3), (const bf16_t*)(ws + OFF_WUP), NP, 6144, 1024};
        EpiUp E{(bf16_t*)(ws + OFF_ACT), tab, p->in[25], p->in[26], (bf16_t*)(ws + OFF_HALO), p->out + O_FP, 0};
        pg8::gemm_phase<EpiUp, pg8::StaticOrder, GP4_ALIGN, GP4_SP2>(lds, g, S, E);
#if REP & 4096
        { int md = PMODE; asm volatile("" : "+s"(md)); p4_small(p, lds, md); }
#endif
        p4_small(p, lds);
    }
    GRID_BAR();
    FRESH_P(); ws = p->ws;
    {   pg8::StaticOrder S; S.init(NP, 1024, G, blk);
        {   Unit u; int last = -1;
            for (int i = 0; S.next(i, u); ++i) if (u.pm != last) { p4b_tile(p, u.pm); last = u.pm; }
            asm volatile("s_waitcnt vmcnt(0)" ::: "memory"); __syncthreads(); }
        pg8::Gemm g{(const bf16_t*)(ws + OFF_ACT), (const bf16_t*)(ws + OFF_WDN), NP, 1024, 3072};
        EpiH2 E{(bf16_t*)(ws + OFF_R3), (float*)(ws + OFF_SSQ2)};
        pg8::gemm_phase<EpiH2, pg8::StaticOrder, GP5_ALIGN, GP5_SP2>(lds, g, S, E);
#if REP & 8192
        { int md = 1; asm volatile("" : "+s"(md)); p5_small(p, lds, md); }
#endif
        p5_small(p, lds);
        pg8::Gemm g2{(const bf16_t*)(ws + OFF_PB), (const bf16_t*)(ws + OFF_WPLE), NP, 1024, 256};
        pg8::StaticOrder S2; S2.init(NP, 1024, G, blk);
        EpiE E2{(bf16_t*)(ws + OFF_E)};
        REPEAT(11) { pg8::gemm_phase<EpiE, pg8::StaticOrder, GPE_ALIGN, GPE_SP2>(lds, g2, S2, E2); }
        pe_small(p, lds);
    }
    GRID_BAR();
    FRESH_P(); ws = p->ws;
    {   pg8::StaticOrder S; S.init(NP, 1024, G, blk);
        fill_tab_rstd(tab, S, (const float*)(ws + OFF_SSQ2), 1.0f / 1024.0f);
        pg8::Gemm g{(const bf16_t*)(ws + OFF_R3), (const bf16_t*)(ws + OFF_WPG), NP, 1024, 1024};
        if (G == 256) {
            EpiGF E{(const bf16_t*)(ws + OFF_R3), (const bf16_t*)(ws + OFF_E), p->out + O_Y, p->in[31], (float*)(ws + OFF_SSQ3), (unsigned*)(ws + OFF_FLAG), tab};
            pg8::gemm_phase<EpiGF, pg8::StaticOrder, false, GP6_SP2>(lds, g, S, E);
        } else {
            EpiG E{(const bf16_t*)(ws + OFF_R3), (const bf16_t*)(ws + OFF_E), (bf16_t*)(ws + OFF_H3), (float*)(ws + OFF_SSQ3), tab};
            pg8::gemm_phase<EpiG, pg8::StaticOrder, GP6_ALIGN, GP6_SP2>(lds, g, S, E);
        }
        p6_small(p, lds, G == 256);
    }
    if (G != 256) {
        GRID_BAR();
        FRESH_P(); ws = p->ws;
        p7_phase(p, 0);
    }
}

extern "C" void kernel_launch(void* const* d_in, const int* in_sizes, int n_in, void* d_out, int out_size, void* d_ws, size_t ws_size, hipStream_t stream) {
    static int grid = 0;
    if (grid == 0) {
        if (n_in != 32 || out_size != (int)O_END || ws_size < WS_END) { fprintf(stderr, "kernel_launch: unexpected shapes (n_in %d out %d ws %zu, need ws %zu)\n", n_in, out_size, ws_size, (size_t)WS_END); grid = -1; return; }
        int dev = 0, cus = 0, per_cu = 0;
        if (hipGetDevice(&dev) != hipSuccess || hipDeviceGetAttribute(&cus, hipDeviceAttributeMultiprocessorCount, dev) != hipSuccess) { grid = -1; return; }
        if (hipFuncSetAttribute((const void*)mega, hipFuncAttributeMaxDynamicSharedMemorySize, LDS_BYTES) != hipSuccess) { fprintf(stderr, "kernel_launch: hipFuncSetAttribute failed\n"); grid = -1; return; }
        if (hipOccupancyMaxActiveBlocksPerMultiprocessor(&per_cu, (const void*)mega, 512, LDS_BYTES) != hipSuccess || per_cu < 1) { fprintf(stderr, "kernel_launch: occupancy query says %d\n", per_cu); (void)hipGetLastError(); grid = -1; return; }
        grid = cus;
    }
    if (grid < 0) return;
    (void)hipMemsetAsync(d_ws, 0, CTL_BYTES, stream);
    Params hp{};
    for (int i = 0; i < 32; ++i) hp.in[i] = (const float*)d_in[i];
    hp.out = (float*)d_out; hp.ws = (unsigned char*)d_ws; hp.use_cg = 0; hp.pad = 0;
    void* args[] = {&hp};
    hipError_t e = hipLaunchCooperativeKernel((const void*)mega, dim3(grid), dim3(512), args, LDS_BYTES, stream);
    if (e != hipSuccess) fprintf(stderr, "kernel_launch: cooperative launch failed: %s (grid %d)\n", hipGetErrorString(e), grid);
}
```
